# Optimizing an MI355X kernel written in HIP

```python
import math
import jax, jax.numpy as jnp
from jax import lax
import numpy as np


D_MODEL = 1024
BATCH = 2
SEQ = 8192
DEPTH = 2

CHUNK = 64
Q_BLOCK = 128
EPS = 1e-6
NEG = -1e30

FOX_HEADS = 4
FOX_DIM = 64
DIFF_HEADS = 4
DIFF_QK = 64
DIFF_V = 2 * DIFF_QK
MLA_HEADS = 4
MLA_NOPE = 64
MLA_ROPE = 32
MLA_V = 64
MLA_Q_RANK = 256
MLA_KV_RANK = 128
ROPE_THETA = 10000.0
D_FF = 2816
CONV_W = 3

MIX_WIDTH = FOX_HEADS * FOX_DIM + DIFF_HEADS * DIFF_V + MLA_HEADS * MLA_V
IN_SIZES = (FOX_HEADS * FOX_DIM, FOX_HEADS * FOX_DIM, FOX_HEADS * FOX_DIM, FOX_HEADS,
            DIFF_HEADS * 2 * DIFF_QK, DIFF_HEADS * 2 * DIFF_QK, DIFF_HEADS * DIFF_V,
            MLA_Q_RANK, MLA_KV_RANK, MLA_ROPE)
IN_COLS = sum(IN_SIZES)

kernel_name = 'hybrid_fox_diff_mla_convffn'


def rmsnorm(x, g):
    xf = x.astype(jnp.float32)
    y = xf * lax.rsqrt(jnp.mean(xf * xf, axis=-1, keepdims=True) + EPS)
    return (y * g.astype(jnp.float32)).astype(x.dtype)


def to_heads(t, h):
    b, s, _ = t.shape
    return t.reshape(b, s, h, -1).transpose(0, 2, 1, 3)


def merge_heads(t):
    b, h, s, d = t.shape
    return t.transpose(0, 2, 1, 3).reshape(b, s, h * d)


def rope(x, pos):
    half = x.shape[-1] // 2
    inv = 1.0 / (ROPE_THETA ** (jnp.arange(half, dtype=jnp.float32) / half))
    ang = pos[:, None] * inv[None, :]
    cos, sin = jnp.cos(ang), jnp.sin(ang)
    xf = x.astype(jnp.float32)
    x1, x2 = xf[..., :half], xf[..., half:]
    return jnp.concatenate([x1 * cos - x2 * sin, x1 * sin + x2 * cos], axis=-1).astype(x.dtype)


def block_attention(q, k, v, bias_fn, scale):
    b, h, s, _ = q.shape
    dv = v.shape[-1]
    ki = jnp.arange(s)

    def one(blk):
        start = blk * Q_BLOCK
        qb = lax.dynamic_slice_in_dim(q, start, Q_BLOCK, axis=2)
        qi = start + jnp.arange(Q_BLOCK)
        sc = jnp.einsum('bhqd,bhkd->bhqk', qb, k).astype(jnp.float32) * scale
        p = jax.nn.softmax(sc + bias_fn(qi, ki), axis=-1).astype(v.dtype)
        return jnp.einsum('bhqk,bhkd->bhqd', p, v)

    out = lax.map(one, jnp.arange(s // Q_BLOCK))
    return out.transpose(1, 2, 0, 3, 4).reshape(b, h, s, dv)


def chunk_mask(qi, ki):
    return (ki[None, :] // CHUNK) <= (qi[:, None] // CHUNK)


def fox_group(q, k, v, f_logit, f_bias):
    q, k, v = to_heads(q, FOX_HEADS), to_heads(k, FOX_HEADS), to_heads(v, FOX_HEADS)
    logf = jax.nn.log_sigmoid((f_logit + f_bias).astype(jnp.float32))
    cum = jnp.cumsum(logf, axis=1).transpose(0, 2, 1)

    def bias(qi, ki):
        cq = jnp.take(cum, qi, axis=2)
        d = cq[..., :, None] - cum[..., None, :]
        return jnp.where((ki[None, :] <= qi[:, None])[None, None], d, NEG)

    return merge_heads(block_attention(q, k, v, bias, FOX_DIM ** -0.5))


def diff_group(q, k, v, lq1, lk1, lq2, lk2, norm_g, lam_init):
    q, k, v = to_heads(q, DIFF_HEADS), to_heads(k, DIFF_HEADS), to_heads(v, DIFF_HEADS)
    q1, q2 = q[..., :DIFF_QK], q[..., DIFF_QK:]
    k1, k2 = k[..., :DIFF_QK], k[..., DIFF_QK:]
    slopes = 2.0 ** (-8.0 * jnp.arange(1, DIFF_HEADS + 1, dtype=jnp.float32) / DIFF_HEADS)

    def bias(qi, ki):
        dist = jnp.abs(qi[:, None] - ki[None, :]).astype(jnp.float32)
        alibi = -slopes[:, None, None] * dist[None]
        return jnp.where(chunk_mask(qi, ki)[None], alibi, NEG)[None]

    scale = DIFF_QK ** -0.5
    o1 = block_attention(q1, k1, v, bias, scale)
    o2 = block_attention(q2, k2, v, bias, scale)
    lam = (jnp.exp(jnp.sum(lq1.astype(jnp.float32) * lk1.astype(jnp.float32)))
           - jnp.exp(jnp.sum(lq2.astype(jnp.float32) * lk2.astype(jnp.float32))) + lam_init)
    o = o1 - lam.astype(o1.dtype) * o2
    o = rmsnorm(o, norm_g) * (1.0 - lam_init)
    return merge_heads(o)


def mla_group(c_q, c_kv, k_rope_raw, q_norm_g, w_uq, kv_norm_g, w_ukv, pos):
    q = to_heads(rmsnorm(c_q, q_norm_g) @ w_uq, MLA_HEADS)
    q = jnp.concatenate([q[..., :MLA_NOPE], rope(q[..., MLA_NOPE:], pos)], axis=-1)
    kv = to_heads(rmsnorm(c_kv, kv_norm_g) @ w_ukv, MLA_HEADS)
    k_nope, v = kv[..., :MLA_NOPE], kv[..., MLA_NOPE:]
    k_r = rope(k_rope_raw[:, None], pos)
    k = jnp.concatenate([k_nope, jnp.broadcast_to(k_r, k_nope.shape[:3] + (MLA_ROPE,))], axis=-1)

    def bias(qi, ki):
        return jnp.where(chunk_mask(qi, ki), 0.0, NEG)[None, None]

    return merge_heads(block_attention(q, k, v, bias, (MLA_NOPE + MLA_ROPE) ** -0.5))


def causal_dwconv(u, w, b):
    s = u.shape[1]
    up = jnp.pad(u, ((0, 0), (CONV_W - 1, 0), (0, 0)))
    y = b
    for j in range(CONV_W):
        y = y + up[:, j:j + s, :] * w[j]
    return y


def setup_inputs(seed: int = 0) -> dict:
    key = jax.random.key(seed)
    ks = jax.random.split(key, 24)
    n = jax.random.normal
    f32 = jnp.float32
    return {
        'x': n(ks[0], (BATCH, SEQ, D_MODEL), f32),
        'ln1_g': 1.0 + 0.02 * n(ks[1], (DEPTH, D_MODEL), f32),
        'w_in': n(ks[2], (DEPTH, D_MODEL, IN_COLS), f32) * D_MODEL ** -0.5,
        'fgate_b': 2.0 + 0.5 * n(ks[3], (DEPTH, FOX_HEADS), f32),
        'lam_q1': 0.1 * n(ks[4], (DEPTH, DIFF_QK), f32),
        'lam_k1': 0.1 * n(ks[5], (DEPTH, DIFF_QK), f32),
        'lam_q2': 0.1 * n(ks[6], (DEPTH, DIFF_QK), f32),
        'lam_k2': 0.1 * n(ks[7], (DEPTH, DIFF_QK), f32),
        'diff_norm_g': 1.0 + 0.02 * n(ks[8], (DEPTH, DIFF_V), f32),
        'q_norm_g': 1.0 + 0.02 * n(ks[9], (DEPTH, MLA_Q_RANK), f32),
        'w_uq': n(ks[10], (DEPTH, MLA_Q_RANK, MLA_HEADS * (MLA_NOPE + MLA_ROPE)), f32) * MLA_Q_RANK ** -0.5,
        'kv_norm_g': 1.0 + 0.02 * n(ks[11], (DEPTH, MLA_KV_RANK), f32),
        'w_ukv': n(ks[12], (DEPTH, MLA_KV_RANK, MLA_HEADS * (MLA_NOPE + MLA_V)), f32) * MLA_KV_RANK ** -0.5,
        'w_o': n(ks[13], (DEPTH, MIX_WIDTH, D_MODEL), f32) * MIX_WIDTH ** -0.5,
        'ln2_g': 1.0 + 0.02 * n(ks[14], (DEPTH, D_MODEL), f32),
        'w_up': n(ks[15], (DEPTH, D_MODEL, 2 * D_FF), f32) * D_MODEL ** -0.5,
        'conv_w': n(ks[16], (DEPTH, CONV_W, 2 * D_FF), f32) * CONV_W ** -0.5,
        'conv_b': 0.02 * n(ks[17], (DEPTH, 2 * D_FF), f32),
        'w_down': n(ks[18], (DEPTH, D_FF, D_MODEL), f32) * D_FF ** -0.5,
        'final_g': 1.0 + 0.02 * n(ks[19], (D_MODEL,), f32),
    }


def reference(x, ln1_g, w_in, fgate_b, lam_q1, lam_k1, lam_q2, lam_k2, diff_norm_g,
              q_norm_g, w_uq, kv_norm_g, w_ukv, w_o, ln2_g, w_up, conv_w, conv_b,
              w_down, final_g):
    pos = jnp.arange(x.shape[1], dtype=jnp.float32)
    split_points = np.cumsum(IN_SIZES)[:-1].tolist()
    for i in range(DEPTH):
        lam_init = 0.8 - 0.6 * math.exp(-0.3 * i)
        h = rmsnorm(x, ln1_g[i]) @ w_in[i]
        (fq, fk, fv, ff, dq, dk, dv, c_q, c_kv, k_r) = jnp.split(h, split_points, axis=-1)
        o_fox = fox_group(fq, fk, fv, ff, fgate_b[i])
        o_diff = diff_group(dq, dk, dv, lam_q1[i], lam_k1[i], lam_q2[i], lam_k2[i],
                            diff_norm_g[i], lam_init)
        o_mla = mla_group(c_q, c_kv, k_r, q_norm_g[i], w_uq[i], kv_norm_g[i], w_ukv[i], pos)
        x = x + jnp.concatenate([o_fox, o_diff, o_mla], axis=-1) @ w_o[i]
        up = causal_dwconv(rmsnorm(x, ln2_g[i]) @ w_up[i], conv_w[i], conv_b[i])
        g, u = up[..., :D_FF], up[..., D_FF:]
        x = x + (jax.nn.silu(g) * u) @ w_down[i]
    return rmsnorm(x, final_g)
```

```cpp
#include <hip/hip_runtime.h>
#include <cstdio>
#include <cstdint>

typedef float f32x16 __attribute__((ext_vector_type(16)));
typedef float f32x4 __attribute__((ext_vector_type(4)));

constexpr int BATCH = 2, SEQ = 8192, DM = 1024, DEPTH = 2;
constexpr int IN_COLS = 2724, DFF = 2816, NUP = 2 * DFF;
constexpr int C_FQ = 0, C_FK = 256, C_FV = 512, C_FF = 768, C_DQ = 772, C_DK = 1284, C_DV = 1796, C_CQ = 2308, C_CKV = 2564, C_KR = 2692;
constexpr float EPS = 1e-6f;
constexpr float NEGV = -1e30f;

__global__ __launch_bounds__(256) void k_rmsnorm(const float* x, int ldx, const float* g, float* y, int ldy, int n, float post) {
    const int row = blockIdx.x * 4 + (threadIdx.x >> 6), lane = threadIdx.x & 63;
    const float* xr = x + (size_t)row * ldx;
    float v[16];
    float s = 0.f;
    const int per = n / 64;
#pragma unroll
    for (int i = 0; i < 16; ++i) if (i < per) { v[i] = xr[lane + 64 * i]; s += v[i] * v[i]; }
#pragma unroll
    for (int o = 32; o; o >>= 1) s += __shfl_xor(s, o);
    const float r = 1.0f / sqrtf(s / (float)n + EPS);
    float* yr = y + (size_t)row * ldy;
#pragma unroll
    for (int i = 0; i < 16; ++i) if (i < per) yr[lane + 64 * i] = v[i] * r * g[lane + 64 * i] * post;
}

__global__ __launch_bounds__(256) void k_gemm(const float* A, int lda, const float* B, int ldb, float* C, int ldc, int N, int K, const float* R, int ldr) {
    const int w = threadIdx.x >> 6, l = threadIdx.x & 63;
    const int row0 = blockIdx.y * 64 + (w >> 1) * 32, col0 = blockIdx.x * 64 + (w & 1) * 32;
    const int r = l & 31, hf = l >> 5;
    const int col = col0 + r; const bool cok = col < N;
    f32x16 acc;
#pragma unroll
    for (int i = 0; i < 16; ++i) acc[i] = 0.f;
    const float* ap = A + (size_t)(row0 + r) * lda + 4 * hf;
    const float* bp = B + (size_t)(4 * hf) * ldb + (cok ? col : 0);
    for (int k = 0; k < K; k += 8) {
        const f32x4 a = *(const f32x4*)(ap + k);
        float b0 = bp[(size_t)(k + 0) * ldb], b1 = bp[(size_t)(k + 1) * ldb], b2 = bp[(size_t)(k + 2) * ldb], b3 = bp[(size_t)(k + 3) * ldb];
        if (!cok) { b0 = b1 = b2 = b3 = 0.f; }
        acc = __builtin_amdgcn_mfma_f32_32x32x2f32(a[0], b0, acc, 0, 0, 0);
        acc = __builtin_amdgcn_mfma_f32_32x32x2f32(a[1], b1, acc, 0, 0, 0);
        acc = __builtin_amdgcn_mfma_f32_32x32x2f32(a[2], b2, acc, 0, 0, 0);
        acc = __builtin_amdgcn_mfma_f32_32x32x2f32(a[3], b3, acc, 0, 0, 0);
    }
    if (cok) {
#pragma unroll
        for (int i = 0; i < 16; ++i) {
            const int rr = row0 + (i & 3) + 8 * (i >> 2) + 4 * hf;
            float v = acc[i];
            if (R) v += R[(size_t)rr * ldr + col];
            C[(size_t)rr * ldc + col] = v;
        }
    }
}

__global__ __launch_bounds__(256) void k_fox_cum(const float* H, int ldh, const float* fb, float* cum) {
    const int h = blockIdx.x, tid = threadIdx.x;
    __shared__ double part[256];
    double loc[32]; double s = 0.0;
    const double b = (double)fb[h];
#pragma unroll
    for (int i = 0; i < 32; ++i) {
        const int t = tid * 32 + i;
        const double z = (double)H[(size_t)t * ldh + C_FF + h] + b;
        const double ls = fmin(z, 0.0) - log1p(exp(-fabs(z)));
        s += ls; loc[i] = s;
    }
    part[tid] = s;
    __syncthreads();
    double pre = 0.0;
    for (int j = 0; j < tid; ++j) pre += part[j];
#pragma unroll
    for (int i = 0; i < 32; ++i) cum[(size_t)h * SEQ + tid * 32 + i] = (float)(pre + loc[i]);
}

__device__ __forceinline__ void rope_cs(int t, int j, float& c, float& s) {
    const float inv = (float)(1.0 / pow(10000.0, (double)j / 16.0));
    const float ang = (float)t * inv;
    c = (float)cos((double)ang); s = (float)sin((double)ang);
}
__global__ void k_rope_q(float* qm) {
    const int idx = blockIdx.x * blockDim.x + threadIdx.x;
    const int j = idx & 15, h = (idx >> 4) & 3, t = idx >> 6;
    float c, s; rope_cs(t, j, c, s);
    float* p = qm + (size_t)t * 384 + h * 96 + 64;
    const float x1 = p[j], x2 = p[j + 16];
    p[j] = x1 * c - x2 * s; p[j + 16] = x1 * s + x2 * c;
}
__global__ void k_build_kmla(const float* kvm, const float* H, int ldh, float* kmla) {
    const int idx = blockIdx.x * blockDim.x + threadIdx.x;
    const int d = idx % 96, h = (idx / 96) & 3, t = idx / 384;
    float v;
    if (d < 64) v = kvm[(size_t)t * 512 + h * 128 + d];
    else {
        const int jj = d - 64, j = jj & 15;
        float c, s; rope_cs(t, j, c, s);
        const float x1 = H[(size_t)t * ldh + C_KR + j], x2 = H[(size_t)t * ldh + C_KR + j + 16];
        v = (jj < 16) ? (x1 * c - x2 * s) : (x1 * s + x2 * c);
    }
    kmla[idx] = v;
}

template <int DK, int DV, int MODE>
__global__ __launch_bounds__(256) void k_attn(const float* Q, int ldq, int hq, const float* K, int ldk, int hk, const float* V, int ldv, int hv, float* O, int ldo, int ho,
                                              const float* cum, float scale, int slope_div) {
    constexpr int KP = DK + 4, VP = DV + 4, PP = 68, DVT = DV / 8;
    __shared__ __attribute__((aligned(16))) float Ks[64 * KP];
    __shared__ __attribute__((aligned(16))) float Vs[64 * VP];
    __shared__ __attribute__((aligned(16))) float Ps[32 * PP];
    const int tid = threadIdx.x, qi = tid >> 3, part = tid & 7;
    const int head = blockIdx.y;
    const int q0 = blockIdx.x * 32, qg = q0 + qi;
    Q += (size_t)head * hq; K += (size_t)head * hk; V += (size_t)(MODE == 1 ? (head >> 1) : head) * hv; O += (size_t)head * ho;
    float slope = 0.f;
    if (MODE == 1) slope = exp2f(-8.0f * (float)((head >> 1) + 1) / 4.0f);
    const float* cumh = (MODE == 0) ? cum + (size_t)head * SEQ : nullptr;
    float q[DK];
#pragma unroll
    for (int d = 0; d < DK; d += 4) { const f32x4 t4 = *(const f32x4*)(Q + (size_t)qg * ldq + d); q[d] = t4[0]; q[d + 1] = t4[1]; q[d + 2] = t4[2]; q[d + 3] = t4[3]; }
    float o[DVT];
#pragma unroll
    for (int d = 0; d < DVT; ++d) o[d] = 0.f;
    float m = -3.0e38f, lsum = 0.f;
    const float cq = (MODE == 0) ? cumh[qg] : 0.f;
    const int ntile = q0 / 64 + 1;
    for (int j = 0; j < ntile; ++j) {
        const int k0 = j * 64;
        __syncthreads();
        for (int i = tid; i < 64 * DK / 4; i += 256) { const int rr = i / (DK / 4), c4 = i % (DK / 4); *(f32x4*)(Ks + rr * KP + c4 * 4) = *(const f32x4*)(K + (size_t)(k0 + rr) * ldk + c4 * 4); }
        for (int i = tid; i < 64 * DV / 4; i += 256) { const int rr = i / (DV / 4), c4 = i % (DV / 4); *(f32x4*)(Vs + rr * VP + c4 * 4) = *(const f32x4*)(V + (size_t)(k0 + rr) * ldv + c4 * 4); }
        __syncthreads();
        float tmax = -3.0e38f;
#pragma unroll 1
        for (int i = 0; i < 8; ++i) {
            const int kk = part + 8 * i, kg = k0 + kk;
            float a = 0.f;
#pragma unroll
            for (int d = 0; d < DK; d += 4) { const f32x4 kv = *(const f32x4*)(Ks + kk * KP + d); a += q[d] * kv[0]; a += q[d + 1] * kv[1]; a += q[d + 2] * kv[2]; a += q[d + 3] * kv[3]; }
            float bias;
            if (MODE == 0) bias = (kg <= qg) ? (cq - cumh[kg]) : NEGV;
            else if (MODE == 1) bias = ((kg >> 6) <= (qg >> 6)) ? (-slope * fabsf((float)(qg - kg))) : NEGV;
            else bias = ((kg >> 6) <= (qg >> 6)) ? 0.f : NEGV;
            const float sv = a * scale + bias;
            Ps[qi * PP + kk] = sv;
            tmax = fmaxf(tmax, sv);
        }
        tmax = fmaxf(tmax, __shfl_xor(tmax, 1)); tmax = fmaxf(tmax, __shfl_xor(tmax, 2)); tmax = fmaxf(tmax, __shfl_xor(tmax, 4));
        const float mn = fmaxf(m, tmax);
        const float alpha = expf(m - mn);
        m = mn;
        float ps = 0.f;
#pragma unroll 1
        for (int i = 0; i < 8; ++i) { const int kk = part + 8 * i; const float p = expf(Ps[qi * PP + kk] - mn); ps += p; Ps[qi * PP + kk] = p; }
        lsum = lsum * alpha + ps;
#pragma unroll
        for (int d = 0; d < DVT; ++d) o[d] *= alpha;
        __syncthreads();
        for (int kk = 0; kk < 64; ++kk) {
            const float p = Ps[qi * PP + kk];
#pragma unroll
            for (int d = 0; d < DVT; d += 4) { const f32x4 vv = *(const f32x4*)(Vs + kk * VP + part * DVT + d); o[d] += p * vv[0]; o[d + 1] += p * vv[1]; o[d + 2] += p * vv[2]; o[d + 3] += p * vv[3]; }
        }
    }
    lsum += __shfl_xor(lsum, 1); lsum += __shfl_xor(lsum, 2); lsum += __shfl_xor(lsum, 4);
    const float inv = 1.0f / lsum;
#pragma unroll
    for (int d = 0; d < DVT; ++d) O[(size_t)qg * ldo + part * DVT + d] = o[d] * inv;
}

__global__ __launch_bounds__(256) void k_diff_combine(const float* o12, const float* lq1, const float* lk1, const float* lq2, const float* lk2, const float* ng, float lam_init, float* AO) {
    const int wv = blockIdx.x * 4 + (threadIdx.x >> 6), lane = threadIdx.x & 63;
    const int t = wv >> 2, h = wv & 3;
    float s1 = lq1[lane] * lk1[lane], s2 = lq2[lane] * lk2[lane];
#pragma unroll
    for (int o = 32; o; o >>= 1) { s1 += __shfl_xor(s1, o); s2 += __shfl_xor(s2, o); }
    const float lam = expf(s1) - expf(s2) + lam_init;
    const float* p1 = o12 + (size_t)t * 1024 + (h * 2) * 128;
    const float* p2 = p1 + 128;
    const float a = p1[lane] - lam * p2[lane], b = p1[lane + 64] - lam * p2[lane + 64];
    float ss = a * a + b * b;
#pragma unroll
    for (int o = 32; o; o >>= 1) ss += __shfl_xor(ss, o);
    const float r = 1.0f / sqrtf(ss / 128.0f + EPS);
    float* out = AO + (size_t)t * 1024 + 256 + h * 128;
    out[lane] = a * r * ng[lane] * (1.0f - lam_init);
    out[lane + 64] = b * r * ng[lane + 64] * (1.0f - lam_init);
}

__global__ void k_conv_act(const float* up, int lead, int t0, const float* cw, const float* cb, float* act, int nrows) {
    const size_t idx = (size_t)blockIdx.x * blockDim.x + threadIdx.x;
    if (idx >= (size_t)nrows * DFF) return;
    const int c = (int)(idx % DFF), r = (int)(idx / DFF);
    const int t = t0 + r;
    float G = cb[c], U = cb[DFF + c];
#pragma unroll
    for (int j = 0; j < 3; ++j) {
        const int tt = t - 2 + j;
        if (tt >= 0) {
            const float* row = up + (size_t)(r + lead - 2 + j) * NUP;
            G += row[c] * cw[j * NUP + c];
            U += row[DFF + c] * cw[j * NUP + DFF + c];
        }
    }
    const float sg = G / (1.0f + expf(-G));
    act[idx] = sg * U;
}

static void gemm(hipStream_t st, const float* A, int lda, const float* B, int ldb, float* C, int ldc, int rows, int N, int K, const float* R, int ldr) {
    dim3 grid((N + 63) / 64, rows / 64);
    hipLaunchKernelGGL(k_gemm, grid, dim3(256), 0, st, A, lda, B, ldb, C, ldc, N, K, R, ldr);
}

extern "C" void kernel_launch(void* const* d_in, const int* in_sizes, int n_in, void* d_out, int out_size, void* d_ws, size_t ws_size, hipStream_t stream) {
    const float* x_in = (const float*)d_in[0];
    const float* ln1_g = (const float*)d_in[1];
    const float* w_in = (const float*)d_in[2];
    const float* fgate_b = (const float*)d_in[3];
    const float* lam_q1 = (const float*)d_in[4];
    const float* lam_k1 = (const float*)d_in[5];
    const float* lam_q2 = (const float*)d_in[6];
    const float* lam_k2 = (const float*)d_in[7];
    const float* diff_norm_g = (const float*)d_in[8];
    const float* q_norm_g = (const float*)d_in[9];
    const float* w_uq = (const float*)d_in[10];
    const float* kv_norm_g = (const float*)d_in[11];
    const float* w_ukv = (const float*)d_in[12];
    const float* w_o = (const float*)d_in[13];
    const float* ln2_g = (const float*)d_in[14];
    const float* w_up = (const float*)d_in[15];
    const float* conv_w = (const float*)d_in[16];
    const float* conv_b = (const float*)d_in[17];
    const float* w_down = (const float*)d_in[18];
    const float* final_g = (const float*)d_in[19];
    float* out = (float*)d_out;
    char* ws = (char*)d_ws;
    const size_t MiB = 1u << 20;
    float* xn = (float*)(ws + 0 * MiB);
    float* H = (float*)(ws + 32 * MiB);
    float* qm = (float*)(ws + 118 * MiB);
    float* kvm = (float*)(ws + 130 * MiB);
    float* kmla = (float*)(ws + 146 * MiB);
    float* cum = (float*)(ws + 158 * MiB);
    float* AO = (float*)(ws + 159 * MiB);
    float* o12 = (float*)(ws + 191 * MiB);
    float* cqn = (float*)(ws + 223 * MiB);
    float* ckvn = (float*)(ws + 231 * MiB);
    float* upc = (float*)(ws + 32 * MiB);
    float* act = (float*)(ws + 122 * MiB);

    for (int layer = 0; layer < DEPTH; ++layer) {
        const float lam_init = 0.8f - 0.6f * expf(-0.3f * (float)layer);
        const float* Win = w_in + (size_t)layer * DM * IN_COLS;
        const float* Wuq = w_uq + (size_t)layer * 256 * 384;
        const float* Wukv = w_ukv + (size_t)layer * 128 * 512;
        const float* Wo = w_o + (size_t)layer * DM * DM;
        const float* Wup = w_up + (size_t)layer * DM * NUP;
        const float* Wdn = w_down + (size_t)layer * DFF * DM;
        for (int b = 0; b < BATCH; ++b) {
            const float* xsrc = (layer == 0 ? x_in : out) + (size_t)b * SEQ * DM;
            float* xdst = out + (size_t)b * SEQ * DM;
            hipLaunchKernelGGL(k_rmsnorm, dim3(SEQ / 4), dim3(256), 0, stream, xsrc, DM, ln1_g + layer * DM, xn, DM, DM, 1.0f);
            gemm(stream, xn, DM, Win, IN_COLS, H, IN_COLS, SEQ, IN_COLS, DM, nullptr, 0);
            hipLaunchKernelGGL(k_fox_cum, dim3(4), dim3(256), 0, stream, H, IN_COLS, fgate_b + layer * 4, cum);
            hipLaunchKernelGGL(k_rmsnorm, dim3(SEQ / 4), dim3(256), 0, stream, H + C_CQ, IN_COLS, q_norm_g + layer * 256, cqn, 256, 256, 1.0f);
            hipLaunchKernelGGL(k_rmsnorm, dim3(SEQ / 4), dim3(256), 0, stream, H + C_CKV, IN_COLS, kv_norm_g + layer * 128, ckvn, 128, 128, 1.0f);
            gemm(stream, cqn, 256, Wuq, 384, qm, 384, SEQ, 384, 256, nullptr, 0);
            gemm(stream, ckvn, 128, Wukv, 512, kvm, 512, SEQ, 512, 128, nullptr, 0);
            hipLaunchKernelGGL(k_rope_q, dim3(SEQ * 64 / 256), dim3(256), 0, stream, qm);
            hipLaunchKernelGGL(k_build_kmla, dim3(SEQ * 384 / 256), dim3(256), 0, stream, kvm, H, IN_COLS, kmla);
            hipLaunchKernelGGL((k_attn<64, 64, 0>), dim3(SEQ / 32, 4), dim3(256), 0, stream, H + C_FQ, IN_COLS, 64, H + C_FK, IN_COLS, 64, H + C_FV, IN_COLS, 64, AO, DM, 64, cum, 0.125f, 0);
            hipLaunchKernelGGL((k_attn<64, 128, 1>), dim3(SEQ / 32, 8), dim3(256), 0, stream, H + C_DQ, IN_COLS, 64, H + C_DK, IN_COLS, 64, H + C_DV, IN_COLS, 128, o12, DM, 128, nullptr, 0.125f, 0);
            hipLaunchKernelGGL(k_diff_combine, dim3(SEQ * 4 / 4), dim3(256), 0, stream, o12, lam_q1 + layer * 64, lam_k1 + layer * 64, lam_q2 + layer * 64, lam_k2 + layer * 64, diff_norm_g + layer * 128, lam_init, AO);
            hipLaunchKernelGGL((k_attn<96, 64, 2>), dim3(SEQ / 32, 4), dim3(256), 0, stream, qm, 384, 96, kmla, 384, 96, kvm + 64, 512, 128, AO + 768, DM, 64, nullptr, 0.10206207261596577f, 0);
            gemm(stream, AO, DM, Wo, DM, xdst, DM, SEQ, DM, DM, xsrc, DM);
            hipLaunchKernelGGL(k_rmsnorm, dim3(SEQ / 4), dim3(256), 0, stream, xdst, DM, ln2_g + layer * DM, xn, DM, DM, 1.0f);
            for (int c = 0; c < 2; ++c) {
                const int r0 = c * 4096, lead = c ? 64 : 0;
                gemm(stream, xn + (size_t)(r0 - lead) * DM, DM, Wup, NUP, upc, NUP, 4096 + lead, NUP, DM, nullptr, 0);
                hipLaunchKernelGGL(k_conv_act, dim3((4096 * DFF + 255) / 256), dim3(256), 0, stream, upc, lead, r0, conv_w + (size_t)layer * 3 * NUP, conv_b + (size_t)layer * NUP, act, 4096);
                gemm(stream, act, DFF, Wdn, DM, xdst + (size_t)r0 * DM, DM, 4096, DM, DFF, xdst + (size_t)r0 * DM, DM);
            }
        }
    }
    hipLaunchKernelGGL(k_rmsnorm, dim3(BATCH * SEQ / 4), dim3(256), 0, stream, out, DM, final_g, out, DM, DM, 1.0f);
}
```

```cpp
#include <hip/hip_runtime.h>
#include <cstdio>
#include <cstdint>

constexpr int BATCH = 2, SEQ = 8192, DM = 1024, DEPTH = 2, MTOK = BATCH * SEQ;
constexpr int IN_COLS = 2724, DFF = 2816, NUP = 2 * DFF;
constexpr int HN = 2816;
constexpr int H_FQ = 0, H_FK = 256, H_FV = 512, H_DQ = 768, H_DK = 1280, H_DV = 1792, H_CQ = 2304, H_CKV = 2560, H_KR = 2688, H_FF = 2720;
constexpr float EPS = 1e-6f;
constexpr float LOG2E = 1.4426950408889634f;
constexpr float NEGV = -1e30f;

constexpr size_t MiB = 1u << 20;
constexpr size_t WS_CTL = 0;
constexpr size_t WS_W = 1 * MiB, WS_WL = 25 * MiB;
constexpr size_t W_IN = 0, W_UQ = 5632 * 1024, W_UKV = W_UQ + 256 * 1024, W_O = 6 * MiB, W_UP = 8 * MiB, W_DN = 19 * MiB;
constexpr size_t WS_XB = 51 * MiB;
constexpr size_t WS_SM = 83 * MiB;
constexpr size_t SM_RSTD1 = 0;
constexpr size_t SM_SSQ = 64 * 1024, SM_SSKV = 192 * 1024, SM_SS2 = 320 * 1024, SM_SS1N = 448 * 1024;
constexpr size_t SM_LOGF = 576 * 1024, SM_CUM = 832 * 1024;
constexpr size_t SM_ZERO_BEG = SM_SSQ, SM_ZERO_END = SM_LOGF;
constexpr size_t WS_HB = 85 * MiB;
constexpr size_t WS_QM = 173 * MiB;
constexpr size_t WS_KVM = 185 * MiB;
constexpr size_t WS_KR = 201 * MiB;
constexpr size_t WS_AO = 202 * MiB;
constexpr size_t WS_END = 234 * MiB;

#define LAS __attribute__((address_space(3)))
typedef unsigned short bf16;
typedef float f32x16 __attribute__((ext_vector_type(16)));
typedef unsigned v4u __attribute__((ext_vector_type(4)));
typedef unsigned v2u __attribute__((ext_vector_type(2)));
__device__ __forceinline__ unsigned f2bf(float f) { unsigned u = __builtin_bit_cast(unsigned, f); return (u + 0x7fffu + ((u >> 16) & 1u)) >> 16; }
__device__ __forceinline__ unsigned pk2(float lo, float hi) { return f2bf(lo) | (f2bf(hi) << 16); }
__device__ __forceinline__ float bf2f(unsigned b) { return __builtin_bit_cast(float, (b & 0xffffu) << 16); }
__device__ __forceinline__ float bflo(unsigned w) { return __builtin_bit_cast(float, w << 16); }
__device__ __forceinline__ float bfhi(unsigned w) { return __builtin_bit_cast(float, w & 0xffff0000u); }

namespace pg8 {
#define PG8_LAS __attribute__((address_space(3)))
typedef unsigned short bf16_t;
typedef short bf16x8 __attribute__((ext_vector_type(8)));
typedef float f32x4 __attribute__((ext_vector_type(4)));
typedef unsigned u32x4 __attribute__((ext_vector_type(4)));
constexpr int BM = 256, BK = 64, HALF = 128, HTB = HALF * BK * 2  , STAGE_BYTES = 8 * HTB, NXCD = 8, WGM = 8;

__host__ __device__ __forceinline__ int lds_byte(int r, int c) { const int st = (r >> 4) * 2 + (c >> 5), rr = r & 15, cc = c & 31, ob = rr * 64 + cc * 2; return st * 1024 + (ob ^ (((ob >> 9) & 1) << 5)); }
__host__ __device__ __forceinline__ void stage_rc(int b, int& R, int& C) { const int st = b / 1024, sb = b % 1024, swz = sb ^ (((sb >> 9) & 1) << 5); R = (st >> 1) * 16 + swz / 64; C = (st & 1) * 32 + (swz % 64) / 2; }
__host__ __device__ __forceinline__ int perm32(int rho) { const int n = rho >> 4, i = rho & 15; return 8 * (i >> 2) + 4 * n + (i & 3); }

struct Unit { int pm, pn; };
struct Gemm { const bf16_t* A; const bf16_t* Bt; int M, N, K, lda; };

struct StaticOrder {
    int nM, nN, nwg, G, c;
    __host__ __device__ void init(int M, int N, int G_, int c_) { nM = M / BM; nN = N / BM; nwg = nM * nN; G = G_; c = c_; }
    __host__ __device__ bool next(int i, Unit& u) const {
        const long L = (long)i * G + c; if (L >= nwg) return false;
        int wgid = (int)L; { const int q = nwg / NXCD, r = nwg % NXCD, xcd = wgid % NXCD, off = wgid / NXCD; wgid = (xcd < r ? xcd * (q + 1) : r * (q + 1) + (xcd - r) * q) + off; }
        const int nig = WGM * nN, gid = wgid / nig, fm = gid * WGM, gsz = (nM - fm) < WGM ? (nM - fm) : WGM;
        u.pm = fm + ((wgid % nig) % gsz); u.pn = (wgid % nig) / gsz; return true;
    }
    __device__ __forceinline__ int arow(const Unit& u) const { return u.pm * BM; }
    __device__ __forceinline__ int arperm(int R) const { return R; }
    __device__ __forceinline__ int ahalf() const { return HALF; }
    __device__ __forceinline__ void a_ready(const Unit&) const {}
    __device__ __forceinline__ void done(const Unit&) const {}
};

__device__ __forceinline__ unsigned cvt_pk_bf16(float lo, float hi) { unsigned r; asm volatile("v_cvt_pk_bf16_f32 %0, %1, %2" : "=v"(r) : "v"(lo), "v"(hi)); return r; }
typedef float f32x2 __attribute__((ext_vector_type(2)));
__device__ __forceinline__ void glds16_s(unsigned voff, const void* sbase, unsigned ldsdst) {
    unsigned keep; ldsdst = __builtin_amdgcn_readfirstlane(ldsdst);
    { const unsigned long long p_ = (unsigned long long)sbase; sbase = (const void*)(((unsigned long long)(unsigned)__builtin_amdgcn_readfirstlane((unsigned)(p_ >> 32)) << 32) | (unsigned)__builtin_amdgcn_readfirstlane((unsigned)p_)); }
    asm volatile("s_mov_b32 %0, m0\n\ts_mov_b32 m0, %3\n\ts_nop 2\n\tglobal_load_lds_dwordx4 %1, %2\n\ts_mov_b32 m0, %0" : "=&s"(keep) : "v"(voff), "s"(sbase), "s"(ldsdst) : "memory");
}
template <class Epi, class Sched, bool ALIGN_EPI = false, bool SP2 = false>
__device__ __forceinline__ void gemm_phase(PG8_LAS unsigned char* lds, const Gemm g, const Sched& S, const Epi& E) {
    int tid_l = threadIdx.x; asm volatile("" : "+v"(tid_l));
    const int tid = tid_l, wid = __builtin_amdgcn_readfirstlane(tid >> 6), lane = tid & 63, wr = wid >> 2, wc = wid & 3, fr = lane & 15, fq = lane >> 4;
    const int K = g.K, nt = K / BK;
    unsigned voffA[2], voffB[2];
#pragma unroll
    for (int i = 0; i < 2; ++i) { int R, C; stage_rc(tid * 16 + i * 8192, R, C); const int Rb = Epi::PERM ? ((R & ~31) + perm32(R & 31)) : R;
        voffA[i] = (unsigned)(S.arperm(R) * g.lda + C) * 2u; voffB[i] = (unsigned)(Rb * K + C) * 2u; }
    const unsigned kstep = (unsigned)(BK * 2);
    const unsigned hstep = (unsigned)HALF * K * 2; const unsigned hstepA = (unsigned)S.ahalf() * g.lda * 2;
    const unsigned tstep = 2 * hstep;
    const unsigned ldsw = (unsigned)wid * 1024u;
    const int aoff = lds_byte(wr * 64 + fr, fq * 8), boff = lds_byte(wc * 32 + fr, fq * 8);
#define PG8_SA(b, h) (((b) * 2 + (h)) * HTB)
#define PG8_SB(b, h) ((4 + (b) * 2 + (h)) * HTB)
#define PG8_STAGE(bufoff, gbase, voff) do { _Pragma("unroll") for (int _i = 0; _i < 2; ++_i) \
        glds16_s((voff)[_i], (const char*)(gbase), (unsigned)(uintptr_t)(lds + (bufoff) + ldsw + _i * 8192)); } while (0)
#define PG8_LDA(dst, b, h) do { _Pragma("unroll") for (int m = 0; m < 4; ++m) _Pragma("unroll") for (int k = 0; k < 2; ++k) dst[m][k] = *(const PG8_LAS bf16x8*)(lds + PG8_SA(b, h) + aoff + m * 2048 + k * 1024); } while (0)
#define PG8_LDB(dst, b, h) do { _Pragma("unroll") for (int n = 0; n < 2; ++n) _Pragma("unroll") for (int k = 0; k < 2; ++k) dst[n][k] = *(const PG8_LAS bf16x8*)(lds + PG8_SB(b, h) + boff + n * 2048 + k * 1024); } while (0)
#define PG8_MMA(ai, bj, At, Bt) do { __builtin_amdgcn_s_setprio(1); _Pragma("unroll") for (int m = 0; m < 4; ++m) _Pragma("unroll") for (int n = 0; n < 2; ++n) _Pragma("unroll") for (int k = 0; k < 2; ++k) \
        acc[ai][bj][m][n] = __builtin_amdgcn_mfma_f32_16x16x32_bf16(Bt[n][k], At[m][k], acc[ai][bj][m][n], 0, 0, 0); __builtin_amdgcn_s_setprio(0); } while (0)
#define PG8_WAIT_V(n) asm volatile("s_waitcnt vmcnt(" #n ")" ::: "memory")
#define PG8_WAIT_L(n) asm volatile("s_waitcnt lgkmcnt(" #n ")" ::: "memory")
#define PG8_BAR __builtin_amdgcn_s_barrier()
#define PG8_SCHED __builtin_amdgcn_sched_barrier(0)
    Unit cur, nxt; int ui = 0;
    if (!S.next(0, cur)) return;
    f32x4 acc[2][2][4][2];
#pragma unroll
    for (int a = 0; a < 2; ++a)
#pragma unroll
        for (int b = 0; b < 2; ++b)
#pragma unroll
            for (int m = 0; m < 4; ++m)
#pragma unroll
                for (int n = 0; n < 2; ++n) acc[a][b][m][n] = (f32x4){0.f, 0.f, 0.f, 0.f};
    bf16x8 At[4][2], B0[2][2], B1[2][2];
    const char* cA = (const char*)g.A + (size_t)S.arow(cur) * g.lda * 2; const char* cB = (const char*)g.Bt + (size_t)cur.pn * tstep;
    S.a_ready(cur);
    if constexpr (SP2) {
        PG8_STAGE(PG8_SB(0, 0), cB, voffB); PG8_STAGE(PG8_SB(0, 1), cB + hstep, voffB); PG8_STAGE(PG8_SA(0, 0), cA, voffA); PG8_STAGE(PG8_SA(0, 1), cA + hstepA, voffA);
        if (wr == 1) PG8_BAR;
        PG8_WAIT_V(2); PG8_BAR;
        PG8_STAGE(PG8_SB(1, 0), cB + kstep, voffB); PG8_STAGE(PG8_SA(1, 0), cA + kstep, voffA); PG8_STAGE(PG8_SB(1, 1), cB + hstep + kstep, voffB);
        PG8_WAIT_V(6); PG8_BAR;
    } else {
        PG8_STAGE(PG8_SB(0, 0), cB, voffB); PG8_STAGE(PG8_SA(0, 0), cA, voffA); PG8_STAGE(PG8_SB(0, 1), cB + hstep, voffB); PG8_STAGE(PG8_SA(0, 1), cA + hstepA, voffA);
        if (wr == 1) PG8_BAR;
        PG8_WAIT_V(4); PG8_BAR;
        PG8_STAGE(PG8_SB(1, 0), cB + kstep, voffB); PG8_STAGE(PG8_SA(1, 0), cA + kstep, voffA); PG8_STAGE(PG8_SB(1, 1), cB + hstep + kstep, voffB);
        PG8_WAIT_V(6); PG8_BAR;
    }
    for (;;) {
        const bool has_next = S.next(ui + 1, nxt);
        const char* nA = has_next ? (const char*)g.A + (size_t)S.arow(nxt) * g.lda * 2 : cA; const char* nB = has_next ? (const char*)g.Bt + (size_t)nxt.pn * tstep : cB;
        for (int t = 0; t < nt; t += 2) {
            const bool last = (t == nt - 2);
            const char* a1 = cA + (size_t)(t + 1) * kstep;
            const char* a2 = last ? nA : cA + (size_t)(t + 2) * kstep; const char* b2 = last ? nB : cB + (size_t)(t + 2) * kstep;
            const char* a3 = a2 + kstep; const char* b3 = b2 + kstep;
            if (last && has_next) S.a_ready(nxt);
            if constexpr (SP2) {
            PG8_LDB(B0, 0, 0); PG8_LDB(B1, 0, 1); PG8_SCHED; PG8_LDA(At, 0, 0); PG8_STAGE(PG8_SA(1, 1), a1 + hstepA, voffA);
            PG8_WAIT_V(8); PG8_WAIT_L(0); PG8_BAR; PG8_MMA(0, 0, At, B0); PG8_MMA(0, 1, At, B1); PG8_BAR; PG8_SCHED;
            PG8_LDA(At, 0, 1); PG8_STAGE(PG8_SB(0, 0), b2, voffB); PG8_STAGE(PG8_SB(0, 1), b2 + hstep, voffB); PG8_STAGE(PG8_SA(0, 0), a2, voffA);
            PG8_WAIT_V(8); PG8_WAIT_L(0); PG8_BAR; PG8_MMA(1, 0, At, B0); PG8_MMA(1, 1, At, B1); PG8_BAR; PG8_SCHED;
            PG8_LDB(B0, 1, 0); PG8_LDB(B1, 1, 1); PG8_SCHED; PG8_LDA(At, 1, 0); PG8_STAGE(PG8_SA(0, 1), a2 + hstepA, voffA);
            PG8_WAIT_V(8); PG8_WAIT_L(0); PG8_BAR; PG8_MMA(0, 0, At, B0); PG8_MMA(0, 1, At, B1); PG8_BAR; PG8_SCHED;
            PG8_LDA(At, 1, 1); PG8_STAGE(PG8_SB(1, 0), b3, voffB); PG8_STAGE(PG8_SB(1, 1), b3 + hstep, voffB); PG8_STAGE(PG8_SA(1, 0), a3, voffA);
            PG8_WAIT_V(8); PG8_WAIT_L(0); PG8_BAR; PG8_MMA(1, 0, At, B0); PG8_MMA(1, 1, At, B1); PG8_BAR; PG8_SCHED;
            } else {
            PG8_LDB(B0, 0, 0); PG8_SCHED; PG8_LDA(At, 0, 0); PG8_STAGE(PG8_SA(1, 1), a1 + hstepA, voffA);
            PG8_WAIT_L(8); PG8_BAR; PG8_WAIT_L(0); PG8_MMA(0, 0, At, B0); PG8_BAR; PG8_SCHED;
            PG8_LDB(B1, 0, 1); PG8_STAGE(PG8_SB(0, 0), b2, voffB);
            PG8_BAR; PG8_WAIT_L(0); PG8_MMA(0, 1, At, B1); PG8_BAR;
            PG8_LDA(At, 0, 1); PG8_STAGE(PG8_SA(0, 0), a2, voffA);
            PG8_BAR; PG8_WAIT_L(0); PG8_MMA(1, 0, At, B0); PG8_BAR; PG8_SCHED;
            PG8_STAGE(PG8_SB(0, 1), b2 + hstep, voffB);
            PG8_WAIT_V(6); PG8_BAR; PG8_MMA(1, 1, At, B1); PG8_BAR;
            PG8_LDB(B0, 1, 0); PG8_SCHED; PG8_LDA(At, 1, 0); PG8_STAGE(PG8_SA(0, 1), a2 + hstepA, voffA);
            PG8_WAIT_L(8); PG8_BAR; PG8_WAIT_L(0); PG8_MMA(0, 0, At, B0); PG8_BAR; PG8_SCHED;
            PG8_LDB(B1, 1, 1); PG8_STAGE(PG8_SB(1, 0), b3, voffB);
            PG8_BAR; PG8_WAIT_L(0); PG8_MMA(0, 1, At, B1); PG8_BAR;
            PG8_LDA(At, 1, 1); PG8_STAGE(PG8_SA(1, 0), a3, voffA);
            PG8_BAR; PG8_WAIT_L(0); PG8_MMA(1, 0, At, B0); PG8_BAR; PG8_SCHED;
            PG8_STAGE(PG8_SB(1, 1), b3 + hstep, voffB);
            PG8_WAIT_V(6); PG8_BAR; PG8_MMA(1, 1, At, B1); PG8_BAR;
            }
        }
        if constexpr (ALIGN_EPI) { if (wr == 0) PG8_BAR; }
        if constexpr (!Epi::AFTER_DRAIN) { E(acc, cur, wr, wc, fr, fq); S.done(cur); }
        if (!has_next) break;
#pragma unroll
        for (int a = 0; a < 2; ++a)
#pragma unroll
            for (int b = 0; b < 2; ++b)
#pragma unroll
                for (int m = 0; m < 4; ++m)
#pragma unroll
                    for (int n = 0; n < 2; ++n) acc[a][b][m][n] = (f32x4){0.f, 0.f, 0.f, 0.f};
        cur = nxt; cA = nA; cB = nB; ++ui;
        if constexpr (ALIGN_EPI) { if (wr == 1) PG8_BAR; }
    }
    PG8_WAIT_V(0);
    if constexpr (!ALIGN_EPI) { if (wr == 0) PG8_BAR; }
    PG8_BAR;
    if constexpr (Epi::AFTER_DRAIN) { E.fused(acc, cur, wr, wc, fr, fq, lds, wid, lane); S.done(cur); }
#undef PG8_SA
#undef PG8_SB
#undef PG8_STAGE
#undef PG8_LDA
#undef PG8_LDB
#undef PG8_MMA
#undef PG8_WAIT_V
#undef PG8_WAIT_L
#undef PG8_BAR
#undef PG8_SCHED
}
}
constexpr int NWAVES = 8, NTHREADS = 512;
constexpr int RING_BYTES = 131072, LDS_BYTES = 147456;
struct Args { const float* in[20]; float* out; unsigned char* ws; int ph_lo, ph_hi, layer, pad; };
enum { I_X = 0, I_LN1G, I_WIN, I_FB, I_LQ1, I_LK1, I_LQ2, I_LK2, I_DNG, I_QNG, I_WUQ, I_KVNG, I_WUKV, I_WO, I_LN2G, I_WUP, I_CW, I_CB, I_WDN, I_FG };

__device__ __forceinline__ float wave_sum(float v) {
#pragma unroll
    for (int o = 1; o < 64; o <<= 1) v += __shfl_xor(v, o);
    return v;
}
struct MapIn {
    __device__ __forceinline__ int src(int n) const { return n < 768 ? n : (n < 2720 ? n + 4 : (n < 2724 ? n - 2720 + 768 : -1)); }
    __device__ __forceinline__ float scale(int n) const { return (n < 256 || (n >= H_DQ && n < H_DK)) ? 0.125f * LOG2E : 1.0f; }
};
struct MapUq {
    __device__ __forceinline__ int src(int n) const { if (n >= 384) return -1; const int h = n / 96, d = n % 96; if (d < 64) return n; const int jj = d - 64; return h * 96 + 64 + (jj >> 1) + 16 * (jj & 1); }
    __device__ __forceinline__ float scale(int) const { return 0.10206207261596577f * LOG2E; }
};
struct MapId {
    __device__ __forceinline__ int src(int n) const { return n; }
    __device__ __forceinline__ float scale(int) const { return 1.0f; }
};
struct MapUp {
    __device__ __forceinline__ int src(int n) const { return ((n >> 7) & 1) * DFF + 128 * (n >> 8) + (n & 127); }
    __device__ __forceinline__ float scale(int) const { return 1.0f; }
};
template <class Map>
__device__ __forceinline__ void wprep_item(const float* W, int ldw, int K, bf16* WT, int nblk, LAS float* scr, int item, int lane, const float* gk, const Map map) {
    const int kb = item / nblk, nb = item % nblk, k0 = 64 * kb, n0 = 32 * nb;
    const int nd = n0 + (lane & 31), sc = map.src(nd); const float cs = map.scale(nd);
#pragma unroll 8
    for (int i = 0; i < 32; ++i) { const int kk = 2 * i + (lane >> 5); float v = (sc >= 0) ? W[(size_t)(k0 + kk) * ldw + sc] : 0.f; if (gk) v *= gk[k0 + kk]; scr[kk * 33 + (lane & 31)] = v * cs; }
    asm volatile("s_waitcnt lgkmcnt(0)" ::: "memory");
    const int c = lane & 7;
#pragma unroll
    for (int j = 0; j < 4; ++j) { const int n = (lane >> 3) + 8 * j; const LAS float* s = scr + (8 * c) * 33 + n;
        v4u o; o.x = pk2(s[0 * 33], s[1 * 33]); o.y = pk2(s[2 * 33], s[3 * 33]); o.z = pk2(s[4 * 33], s[5 * 33]); o.w = pk2(s[6 * 33], s[7 * 33]);
        *(v4u*)(WT + (size_t)(n0 + n) * K + k0 + 8 * c) = o; }
    asm volatile("s_waitcnt lgkmcnt(0)" ::: "memory");
}
__device__ __forceinline__ void xprep_row(const float* xrow, bf16* orow, float* rstd, int lane) {
    const float4* xr = (const float4*)xrow + lane;
    float4 v[4]; float s = 0.f;
#pragma unroll
    for (int j = 0; j < 4; ++j) { v[j] = xr[64 * j]; s += (v[j].x * v[j].x + v[j].y * v[j].y) + (v[j].z * v[j].z + v[j].w * v[j].w); }
    s = wave_sum(s);
    if (lane == 0) *rstd = s;
    v2u* o8 = (v2u*)orow + lane;
#pragma unroll
    for (int j = 0; j < 4; ++j) { v2u w; w.x = pk2(v[j].x, v[j].y); w.y = pk2(v[j].z, v[j].w); o8[64 * j] = w; }
}
__device__ __forceinline__ void p0_prologue(const __attribute__((address_space(4))) Args* ap_, LAS unsigned char* lds, int gw, int ngw, int lane, int wave) {
    LAS float* scr = (LAS float*)(lds + wave * 16384);
    unsigned char* ws = ap_->ws;
    constexpr int I_IN = 16 * 88, I_UQ = 4 * 16, I_UKV = 2 * 16, I_O = 16 * 32, I_UP = 16 * 176, I_DN = 44 * 32, I_L = I_IN + I_UQ + I_UKV + I_O + I_UP + I_DN;
    for (int it = gw; it < 2 * I_L; it += ngw) {
        const int l = it / I_L; int r = it % I_L;
        unsigned char* wl = ws + WS_W + (size_t)l * WS_WL;
        if (r < I_IN) { wprep_item(ap_->in[I_WIN] + (size_t)l * DM * IN_COLS, IN_COLS, DM, (bf16*)(wl + W_IN), 88, scr, r, lane, ap_->in[I_LN1G] + l * DM, MapIn()); continue; } r -= I_IN;
        if (r < I_UQ) { wprep_item(ap_->in[I_WUQ] + (size_t)l * 256 * 384, 384, 256, (bf16*)(wl + W_UQ), 16, scr, r, lane, ap_->in[I_QNG] + l * 256, MapUq()); continue; } r -= I_UQ;
        if (r < I_UKV) { wprep_item(ap_->in[I_WUKV] + (size_t)l * 128 * 512, 512, 128, (bf16*)(wl + W_UKV), 16, scr, r, lane, ap_->in[I_KVNG] + l * 128, MapId()); continue; } r -= I_UKV;
        if (r < I_O) { wprep_item(ap_->in[I_WO] + (size_t)l * DM * DM, DM, DM, (bf16*)(wl + W_O), 32, scr, r, lane, (const float*)nullptr, MapId()); continue; } r -= I_O;
        if (r < I_UP) { wprep_item(ap_->in[I_WUP] + (size_t)l * DM * NUP, NUP, DM, (bf16*)(wl + W_UP), 176, scr, r, lane, ap_->in[I_LN2G] + l * DM, MapUp()); continue; } r -= I_UP;
        wprep_item(ap_->in[I_WDN] + (size_t)l * DFF * DM, DM, DFF, (bf16*)(wl + W_DN), 32, scr, r, lane, (const float*)nullptr, MapId());
    }
    float* rstd1 = (float*)(ws + WS_SM + SM_RSTD1);
    for (int m = gw; m < MTOK; m += ngw) xprep_row(ap_->in[I_X] + (size_t)m * DM, (bf16*)(ws + WS_XB) + (size_t)m * DM, rstd1 + m, lane);
    float* z = (float*)(ws + WS_SM + SM_ZERO_BEG); const int nz = (int)((SM_ZERO_END - SM_ZERO_BEG) / 4);
    for (int i = gw * 64 + lane; i < nz; i += ngw * 64) z[i] = 0.f;
}
namespace pg8 {
__device__ __forceinline__ u32x4 pack8(const f32x4 v0, const f32x4 v1) { u32x4 w; w.x = cvt_pk_bf16(v0[0], v0[1]); w.y = cvt_pk_bf16(v0[2], v0[3]); w.z = cvt_pk_bf16(v1[0], v1[1]); w.w = cvt_pk_bf16(v1[2], v1[3]); return w; }
__device__ __forceinline__ float sq8(const f32x4 a, const f32x4 b) { return (a[0] * a[0] + a[1] * a[1]) + (a[2] * a[2] + a[3] * a[3]) + (b[0] * b[0] + b[1] * b[1]) + (b[2] * b[2] + b[3] * b[3]); }
__device__ __forceinline__ float log_sigmoid_d(float z) { return fminf(z, 0.f) - 0.6931471805599453f * __builtin_amdgcn_logf(1.0f + __builtin_amdgcn_exp2f(-1.4426950408889634f * fabsf(z))); }
struct EpiH {
    static constexpr bool PERM = true, AFTER_DRAIN = false;
    unsigned char* ws; const float* fb; int l;
    __device__ __forceinline__ void operator()(const f32x4 (&acc)[2][2][4][2], const Unit& u, int wr, int wc, int fr, int fq) const {
        { int t_ = threadIdx.x; asm volatile("" : "+v"(t_)); fr = t_ & 15; fq = (t_ >> 4) & 3; const int w_ = __builtin_amdgcn_readfirstlane(t_ >> 6); wr = w_ >> 2; wc = w_ & 3; }
        bf16_t* Hb = (bf16_t*)(ws + WS_HB); float* sm = (float*)(ws + WS_SM);
        const float* ssin = l == 0 ? sm + SM_RSTD1 / 4 : sm + SM_SS1N / 4 + (l - 1) * MTOK;
        float* logf = sm + SM_LOGF / 4; float* ssq = sm + SM_SSQ / 4 + l * MTOK; float* sskv = sm + SM_SSKV / 4 + l * MTOK;
        const int row0 = u.pm * BM + wr * 64 + fr, colw = wc * 32 + 8 * fq;
#pragma unroll
        for (int ai = 0; ai < 2; ++ai)
#pragma unroll
            for (int m = 0; m < 4; ++m) {
                const int row = row0 + ai * HALF + m * 16; const float rs = __builtin_amdgcn_rsqf(ssin[row] * (1.0f / DM) + EPS);
                float s = 0.f;
#pragma unroll
                for (int bj = 0; bj < 2; ++bj) {
                    const f32x4 v0 = acc[ai][bj][m][0] * rs, v1 = acc[ai][bj][m][1] * rs;
                    *(u32x4*)(Hb + (size_t)row * HN + u.pn * BM + bj * HALF + colw) = pack8(v0, v1);
                    if (u.pn == 9 || (u.pn == 10 && bj == 0)) s += sq8(v0, v1);
                    if (u.pn == 10 && bj == 1 && wc == 1 && fq == 0) { f32x4 lf; lf[0] = log_sigmoid_d(v0[0] + fb[0]); lf[1] = log_sigmoid_d(v0[1] + fb[1]); lf[2] = log_sigmoid_d(v0[2] + fb[2]); lf[3] = log_sigmoid_d(v0[3] + fb[3]); *(f32x4*)(logf + (size_t)row * 4) = lf; }
                }
                if (u.pn == 9 || u.pn == 10) { s += __shfl_xor(s, 16); s += __shfl_xor(s, 32); if (fq == 0) atomicAdd((u.pn == 9 ? ssq : sskv) + row, s); }
                asm volatile("" ::: "memory");
            }
    }
};
struct EpiQ {
    static constexpr bool PERM = true, AFTER_DRAIN = false;
    bf16_t* QM; const float* ssq; const float2* rope;
    __device__ __forceinline__ void operator()(const f32x4 (&acc)[2][2][4][2], const Unit& u, int wr, int wc, int fr, int fq) const {
        { int t_ = threadIdx.x; asm volatile("" : "+v"(t_)); fr = t_ & 15; fq = (t_ >> 4) & 3; const int w_ = __builtin_amdgcn_readfirstlane(t_ >> 6); wr = w_ >> 2; wc = w_ & 3; }
        const int row0 = u.pm * BM + wr * 64 + fr, colw = wc * 32 + 8 * fq;
#pragma unroll
        for (int ai = 0; ai < 2; ++ai)
#pragma unroll
            for (int m = 0; m < 4; ++m) {
                const int row = row0 + ai * HALF + m * 16; const float rs = __builtin_amdgcn_rsqf(ssq[row] * (1.0f / 256.0f) + EPS);
                const float2* rt = rope + (size_t)(row & (SEQ - 1)) * 16;
#pragma unroll
                for (int bj = 0; bj < 2; ++bj) {
                    const int col = u.pn * BM + bj * HALF + colw;
                    if (col < 384) {
                        f32x4 v0 = acc[ai][bj][m][0] * rs, v1 = acc[ai][bj][m][1] * rs;
                        const int d = col % 96;
                        if (d >= 64) { const int j0 = (d - 64) >> 1; const float2 c0 = rt[j0], c1 = rt[j0 + 1], c2 = rt[j0 + 2], c3 = rt[j0 + 3];
                            f32x4 r0, r1;
                            r0[0] = v0[0] * c0.x - v0[1] * c0.y; r0[1] = v0[0] * c0.y + v0[1] * c0.x; r0[2] = v0[2] * c1.x - v0[3] * c1.y; r0[3] = v0[2] * c1.y + v0[3] * c1.x;
                            r1[0] = v1[0] * c2.x - v1[1] * c2.y; r1[1] = v1[0] * c2.y + v1[1] * c2.x; r1[2] = v1[2] * c3.x - v1[3] * c3.y; r1[3] = v1[2] * c3.y + v1[3] * c3.x;
                            v0 = r0; v1 = r1; }
                        *(u32x4*)(QM + (size_t)row * 384 + col) = pack8(v0, v1);
                    }
                }
                asm volatile("" ::: "memory");
            }
    }
};
struct EpiKV {
    static constexpr bool PERM = true, AFTER_DRAIN = false;
    bf16_t* KVM; const float* sskv;
    __device__ __forceinline__ void operator()(const f32x4 (&acc)[2][2][4][2], const Unit& u, int wr, int wc, int fr, int fq) const {
        { int t_ = threadIdx.x; asm volatile("" : "+v"(t_)); fr = t_ & 15; fq = (t_ >> 4) & 3; const int w_ = __builtin_amdgcn_readfirstlane(t_ >> 6); wr = w_ >> 2; wc = w_ & 3; }
        const int row0 = u.pm * BM + wr * 64 + fr, colw = wc * 32 + 8 * fq;
#pragma unroll
        for (int ai = 0; ai < 2; ++ai)
#pragma unroll
            for (int m = 0; m < 4; ++m) {
                const int row = row0 + ai * HALF + m * 16; const float rs = __builtin_amdgcn_rsqf(sskv[row] * (1.0f / 128.0f) + EPS);
#pragma unroll
                for (int bj = 0; bj < 2; ++bj) *(u32x4*)(KVM + (size_t)row * 512 + u.pn * BM + bj * HALF + colw) = pack8(acc[ai][bj][m][0] * rs, acc[ai][bj][m][1] * rs);
                asm volatile("" ::: "memory");
            }
    }
};
struct EpiRes {
    static constexpr bool PERM = true, AFTER_DRAIN = false;
    const float* xold; float* xnew; bf16_t* xb; float* ss;
    __device__ __forceinline__ void operator()(const f32x4 (&acc)[2][2][4][2], const Unit& u, int wr, int wc, int fr, int fq) const {
        { int t_ = threadIdx.x; asm volatile("" : "+v"(t_)); fr = t_ & 15; fq = (t_ >> 4) & 3; const int w_ = __builtin_amdgcn_readfirstlane(t_ >> 6); wr = w_ >> 2; wc = w_ & 3; }
        const int row0 = u.pm * BM + wr * 64 + fr, colw = wc * 32 + 8 * fq;
#pragma unroll
        for (int ai = 0; ai < 2; ++ai)
#pragma unroll
            for (int m = 0; m < 4; ++m) {
                const int row = row0 + ai * HALF + m * 16; float s = 0.f;
#pragma unroll
                for (int bj = 0; bj < 2; ++bj) {
                    const size_t off = (size_t)row * DM + u.pn * BM + bj * HALF + colw;
                    const f32x4 v0 = *(const f32x4*)(xold + off) + acc[ai][bj][m][0], v1 = *(const f32x4*)(xold + off + 4) + acc[ai][bj][m][1];
                    *(f32x4*)(xnew + off) = v0; *(f32x4*)(xnew + off + 4) = v1; *(u32x4*)(xb + off) = pack8(v0, v1);
                    s += sq8(v0, v1);
                }
                s += __shfl_xor(s, 16); s += __shfl_xor(s, 32); if (fq == 0) atomicAdd(ss + row, s);
                asm volatile("" ::: "memory");
            }
    }
};
struct HalfOrder {
    int nN, nwg, G2, c2; bool active;
    __device__ void init(int M, int N, int G, int c, int half) { nN = N / BM; nwg = (M / BM) * nN; G2 = G / 2; active = (c / G2) == half; c2 = c % G2; }
    __device__ bool next(int i, Unit& u) const { if (!active) return false; const int L = i * G2 + c2; if (L >= nwg) return false; u.pm = L / nN; u.pn = L % nN; return true; }
    __device__ __forceinline__ int arow(const Unit& u) const { return u.pm * BM; }
    __device__ __forceinline__ int arperm(int R) const { return R; }
    __device__ __forceinline__ int ahalf() const { return HALF; }
    __device__ __forceinline__ void a_ready(const Unit&) const {}
    __device__ __forceinline__ void done(const Unit&) const {}
};
constexpr int UP_TILES_PER_B = 33, UP_NM = 2 * UP_TILES_PER_B, UP_NN = NUP / 256;
__device__ __forceinline__ int up_tile_start(int pm) { const int b = pm / UP_TILES_PER_B, i = pm % UP_TILES_PER_B; int s = 252 * i; s = s > SEQ - 254 ? SEQ - 254 : s; return b * SEQ + s; }
struct UpOrder : StaticOrder {
    __device__ void init_up(int G_, int c_) { nM = UP_NM; nN = UP_NN; nwg = nM * nN; G = G_; c = c_; }
    __device__ __forceinline__ int arow(const Unit& u) const { return up_tile_start(u.pm); }
    __device__ __forceinline__ int arperm(int R) const { return R < 64 ? R : R + 62; }
    __device__ __forceinline__ int ahalf() const { return 64; }
};
template <int CTRL> __device__ __forceinline__ float dppz(float src) {
    return __builtin_bit_cast(float, __builtin_amdgcn_update_dpp(0, __builtin_bit_cast(int, src), CTRL, 0xf, 0xf, false));
}
struct EpiUp {
    static constexpr bool PERM = true, AFTER_DRAIN = false;
    unsigned char* ws; const float* cw; const float* cb; int l;
    __device__ __forceinline__ void operator()(f32x4 (&acc)[2][2][4][2], const Unit& u, int wr, int wc, int fr, int fq) const {
        { int t_ = threadIdx.x; asm volatile("" : "+v"(t_)); fr = t_ & 15; fq = (t_ >> 4) & 3; const int w_ = __builtin_amdgcn_readfirstlane(t_ >> 6); wr = w_ >> 2; wc = w_ & 3; }
        const float* ss2 = (const float*)(ws + WS_SM) + SM_SS2 / 4 + l * MTOK; bf16_t* act = (bf16_t*)(ws + WS_HB);
        const int t0 = up_tile_start(u.pm) + 126 * wr + fr;
        const bool keep_head = (u.pm % UP_TILES_PER_B) == 0 && wr == 0;
#pragma unroll
        for (int ai = 0; ai < 2; ++ai)
#pragma unroll
            for (int m = 0; m < 4; ++m) { const float rs = __builtin_amdgcn_rsqf(ss2[t0 + ai * 64 + m * 16] * (1.0f / DM) + EPS);
#pragma unroll
                for (int bj = 0; bj < 2; ++bj) { acc[ai][bj][m][0] *= rs; acc[ai][bj][m][1] *= rs; } }
        const int cg0 = u.pn * 128 + wc * 32 + 8 * fq;
#pragma unroll
        for (int n = 0; n < 2; ++n) {
            const int cg = cg0 + 4 * n;
            const f32x4 wg0 = *(const f32x4*)(cw + cg), wg1 = *(const f32x4*)(cw + NUP + cg), wg2 = *(const f32x4*)(cw + 2 * NUP + cg), bg = *(const f32x4*)(cb + cg);
            const f32x4 wu0 = *(const f32x4*)(cw + DFF + cg), wu1 = *(const f32x4*)(cw + NUP + DFF + cg), wu2 = *(const f32x4*)(cw + 2 * NUP + DFF + cg), bu = *(const f32x4*)(cb + DFF + cg);
#pragma unroll
            for (int ai = 0; ai < 2; ++ai)
#pragma unroll
                for (int m = 0; m < 4; ++m) {
                    const f32x4 xg = acc[ai][0][m][n], xu = acc[ai][1][m][n];
                    f32x4 pg, pu;
                    if (m > 0) { pg = acc[ai][0][m - 1][n]; pu = acc[ai][1][m - 1][n]; }
                    else if (ai > 0) { pg = acc[0][0][3][n]; pu = acc[0][1][3][n]; }
                    else { pg = (f32x4){0.f, 0.f, 0.f, 0.f}; pu = pg; }
                    float a[4];
#pragma unroll
                    for (int c = 0; c < 4; ++c) {
                        const float g1 = dppz<0x111>(xg[c]) + dppz<0x10F>(pg[c]), g2 = dppz<0x112>(xg[c]) + dppz<0x10E>(pg[c]);
                        const float u1 = dppz<0x111>(xu[c]) + dppz<0x10F>(pu[c]), u2 = dppz<0x112>(xu[c]) + dppz<0x10E>(pu[c]);
                        const float G = bg[c] + wg2[c] * xg[c] + wg1[c] * g1 + wg0[c] * g2;
                        const float U = bu[c] + wu2[c] * xu[c] + wu1[c] * u1 + wu0[c] * u2;
                        a[c] = G * __builtin_amdgcn_rcpf(1.0f + __builtin_amdgcn_exp2f(-1.4426950408889634f * G)) * U;
                    }
                    typedef unsigned u32x2 __attribute__((ext_vector_type(2)));
                    u32x2 w; w.x = cvt_pk_bf16(a[0], a[1]); w.y = cvt_pk_bf16(a[2], a[3]);
                    const bool halo = (ai == 0 && m == 0 && fr < 2 && !keep_head);
                    if (!halo) *(u32x2*)(act + (size_t)(t0 + ai * 64 + m * 16) * DFF + cg) = w;
                }
            asm volatile("" ::: "memory");
        }
    }
};
}
namespace att {
typedef short bf16x8 __attribute__((ext_vector_type(8)));
typedef short s16x4 __attribute__((ext_vector_type(4)));
typedef float f32x4 __attribute__((ext_vector_type(4)));
constexpr int ST_K = 0, ST_V = 16384, ST_CK = 32768, ST_BYTES = 33280;
constexpr float THR = 8.0f;
constexpr float MASKV = -1.0e30f;
constexpr int N_FOX = 256, N_MLA = 256, N_DIFF = 512, N_ITEMS = N_FOX + N_MLA + N_DIFF;

__device__ __forceinline__ s16x4 vtr(LAS const unsigned char* p) { typedef short v4i16_t __attribute__((ext_vector_type(4))); return __builtin_bit_cast(s16x4, __builtin_amdgcn_ds_read_tr16_b64_v4i16((LAS v4i16_t*)p)); }
__device__ __forceinline__ unsigned cvtpk(float lo, float hi) { typedef float f32x2_t __attribute__((ext_vector_type(2))); typedef __bf16 bf16x2_t __attribute__((ext_vector_type(2))); f32x2_t v = {lo, hi}; bf16x2_t b = __builtin_convertvector(v, bf16x2_t); return __builtin_bit_cast(unsigned, b); }
__device__ __forceinline__ float max3f(float a, float b, float c) { return __builtin_fmaxf(__builtin_fmaxf(a, b), c); }
__device__ __forceinline__ float halfmax(float v) { auto rr = __builtin_amdgcn_permlane32_swap(__float_as_uint(v), __float_as_uint(v), false, false); return __builtin_fmaxf(__uint_as_float(rr[0]), __uint_as_float(rr[1])); }
__device__ __forceinline__ float halfsum(float v) { auto rr = __builtin_amdgcn_permlane32_swap(__float_as_uint(v), __float_as_uint(v), false, false); return __uint_as_float(rr[0]) + __uint_as_float(rr[1]); }

__device__ __forceinline__ int item_cost(int type, int qb) { return (type == 0 ? 64 : (type == 1 ? 48 : 80)) * (qb + 1); }
__device__ __forceinline__ int n_gt(int a, int n, int c) { const int f = c / a; return 8 * (n - (f < n ? f : n)); }
__device__ __forceinline__ int n_eq(int a, int n, int c) { return (c % a == 0 && c / a >= 1 && c / a <= n) ? 8 : 0; }
__device__ __forceinline__ void build_items(int* list, int gtid, int ngt) {
    for (int i = gtid; i < N_ITEMS; i += ngt) {
        int type, rem;
        if (i < N_FOX) { type = 0; rem = i; } else if (i < N_FOX + N_DIFF) { type = 1; rem = i - N_FOX; } else { type = 2; rem = i - N_FOX - N_DIFF; }
        const int nq = type == 1 ? 64 : 32; const int bh = rem / nq, qb = rem % nq;
        const int c = item_cost(type, qb);
        int rank = n_gt(64, 32, c) + n_gt(48, 64, c) + n_gt(80, 32, c);
        if (type > 0) rank += n_eq(64, 32, c);
        if (type > 1) rank += n_eq(48, 64, c);
        rank += bh;
        list[rank] = type | (rem << 2);
    }
}

struct Params { const bf16* HB; const bf16* QM; const bf16* KVM; const bf16* KR; bf16* AO; const float* cum; const float* lq1; const float* lk1; const float* lq2; const float* lk2; const float* dng; float lam_init; int pad; };

template <int MODE>
__device__ __forceinline__ void attn_unit(const Params& P, LAS unsigned char* lds, const int b, const int head, const int qblk) {
    constexpr int DK = MODE == 2 ? 96 : 64, DV = MODE == 1 ? 128 : 64, NS = DK / 16, NDB = DV / 32;
    constexpr int KPITCH = MODE == 2 ? 256 : 128, VPITCH = DV * 2;
    int tid = threadIdx.x; asm volatile("" : "+v"(tid));
    const int lane = tid & 63, wave = __builtin_amdgcn_readfirstlane(tid >> 6), r = lane & 31, h = lane >> 5;
    const size_t rb = (size_t)b * SEQ;
    const int wq = MODE == 1 ? (wave & 3) : wave;
    const int map = MODE == 1 ? (wave >> 2) : 0;
    const int q0 = (MODE == 1 ? 128 : 256) * qblk, qrow = q0 + 32 * wq;
    const int NT = (MODE == 1 ? 2 : 4) * qblk + (MODE == 1 ? 2 : 4);
    const int jv = (MODE == 1 ? 2 : 4) * qblk + (wq >> 1);
    const bf16 *Qp, *Kp, *K2p = nullptr, *Vp; int qpitch, kpitch, vpitch; bf16* Op;
    if (MODE == 0) { Qp = P.HB + H_FQ + head * 64; Kp = P.HB + H_FK + head * 64; Vp = P.HB + H_FV + head * 64; qpitch = kpitch = vpitch = HN; Op = P.AO + head * 64; }
    else if (MODE == 1) { Qp = P.HB + H_DQ + head * 128 + map * 64; Kp = P.HB + H_DK + head * 128; Vp = P.HB + H_DV + head * 128; qpitch = kpitch = vpitch = HN; Op = P.AO + 256 + head * 128; }
    else { Qp = P.QM + head * 96; Kp = P.KVM + head * 128; K2p = P.KR; Vp = P.KVM + head * 128 + 64; qpitch = 384; kpitch = vpitch = 512; Op = P.AO + 768 + head * 64; }
    bf16x8 qf[NS];
#pragma unroll
    for (int s = 0; s < NS; ++s) qf[s] = *(const bf16x8*)(Qp + (rb + qrow + r) * qpitch + 16 * s + 8 * h);
    v4u kreg0, kreg1, vreg0, vreg1; f32x4 ckreg;
    kreg1 = (v4u){0u, 0u, 0u, 0u}; vreg1 = kreg1; ckreg = (f32x4){0.f, 0.f, 0.f, 0.f};
    const int skey = tid >> 3, sc = tid & 7;
    unsigned kw0, kw1 = 0, vw0, vw1 = 0;
    if (MODE == 2) { kw0 = ST_K + skey * 256 + ((sc ^ (skey & 15)) << 4); const int k2 = tid >> 2, c2 = 8 + (tid & 3); kw1 = ST_K + k2 * 256 + ((c2 ^ (k2 & 15)) << 4); }
    else { kw0 = ST_K + skey * 128 + ((sc ^ ((skey >> 1) & 7)) << 4); kw1 = kw0 + 8192; }
    if (DV == 64) vw0 = ST_V + skey * 128 + ((((sc >> 2) ^ ((skey >> 1) & 1))) << 6) + ((sc & 3) << 4);
    else { const int k0_ = tid >> 4, c0_ = tid & 15; vw0 = ST_V + k0_ * 256 + ((((c0_ >> 2) ^ (k0_ & 3))) << 6) + ((c0_ & 3) << 4); const int k1_ = k0_ + 32; vw1 = ST_V + k1_ * 256 + ((((c0_ >> 2) ^ (k1_ & 3))) << 6) + ((c0_ & 3) << 4); }
    const float cref = (MODE == 0) ? P.cum[(rb + q0) * 4 + head] : 0.f;
#define ATT_LOAD(j) do { const size_t kr_ = rb + (size_t)(j) * 64; \
        if (MODE == 2) { kreg0 = *(const v4u*)(Kp + (kr_ + skey) * kpitch + sc * 8); if (tid < 256) kreg1 = *(const v4u*)(K2p + (kr_ + (tid >> 2)) * 32 + (tid & 3) * 8); } \
        else { kreg0 = *(const v4u*)(Kp + (kr_ + skey) * kpitch + sc * 8); if (MODE == 1) kreg1 = *(const v4u*)(Kp + 64 + (kr_ + skey) * kpitch + sc * 8); } \
        if (DV == 64) vreg0 = *(const v4u*)(Vp + (kr_ + skey) * vpitch + sc * 8); \
        else { vreg0 = *(const v4u*)(Vp + (kr_ + (tid >> 4)) * vpitch + (tid & 15) * 8); vreg1 = *(const v4u*)(Vp + (kr_ + 32 + (tid >> 4)) * vpitch + (tid & 15) * 8); } \
        if (MODE == 0 && tid < 16) { const float* cp_ = P.cum + (kr_ + tid * 4) * 4 + head; ckreg = (f32x4){cref - cp_[0], cref - cp_[4], cref - cp_[8], cref - cp_[12]}; } } while (0)
#define ATT_WRITE(st) do { LAS unsigned char* sb_ = lds + (st) * ST_BYTES; \
        *(LAS v4u*)(sb_ + kw0) = kreg0; if (MODE == 1 || (MODE == 2 && tid < 256)) *(LAS v4u*)(sb_ + kw1) = kreg1; \
        *(LAS v4u*)(sb_ + vw0) = vreg0; if (DV == 128) *(LAS v4u*)(sb_ + vw1) = vreg1; \
        if (MODE == 0 && tid < 16) *(LAS f32x4*)(sb_ + ST_CK + tid * 16) = ckreg; } while (0)
    unsigned ka[NS];
#pragma unroll
    for (int s = 0; s < NS; ++s) ka[s] = ST_K + (MODE == 1 ? map * 8192 : 0) + r * KPITCH + (MODE == 2 ? (((2 * s + h) ^ (r & 15)) << 4) : (((2 * s + h) ^ ((r >> 1) & 7)) << 4));
    unsigned va[NDB];
    { const int qp = (lane & 15) >> 2, kb_ = 4 * h + qp, dby = 32 * ((lane >> 4) & 1) + 8 * (lane & 3);
#pragma unroll
      for (int d = 0; d < NDB; ++d) va[d] = ST_V + kb_ * VPITCH + (DV == 64 ? ((d ^ ((qp >> 1) & 1)) << 6) : ((d ^ qp) << 6)) + dby; }
    f32x16 o[NDB];
#pragma unroll
    for (int d = 0; d < NDB; ++d)
#pragma unroll
        for (int i = 0; i < 16; ++i) o[d][i] = 0.f;
    float m_run = MASKV, l_run = 0.f;
    const float slope2 = (MODE == 1) ? exp2f(-2.0f * (float)(head + 1)) * LOG2E : 0.f;
    ATT_LOAD(0); ATT_WRITE(0);
    __syncthreads();
    for (int j = 0; j < NT; ++j) {
        if (j + 1 < NT) ATT_LOAD(j + 1);
        if (j <= jv) {
            LAS const unsigned char* sb = lds + (j & 1) * ST_BYTES;
            f32x16 p0, p1;
            if (MODE == 0) {
#pragma unroll
                for (int g = 0; g < 4; ++g) { const f32x4 c0 = *(LAS const f32x4*)(sb + ST_CK + 16 * h + 32 * g), c1 = *(LAS const f32x4*)(sb + ST_CK + 128 + 16 * h + 32 * g);
#pragma unroll
                    for (int i = 0; i < 4; ++i) { p0[4 * g + i] = c0[i]; p1[4 * g + i] = c1[i]; } }
            } else if (MODE == 1) {
                const float tb = slope2 * (float)(64 * j + 4 * h - (qrow + r));
#pragma unroll
                for (int i = 0; i < 16; ++i) { p0[i] = tb + slope2 * (float)((i & 3) + 8 * (i >> 2)); p1[i] = p0[i] + 32.0f * slope2; }
            } else {
#pragma unroll
                for (int i = 0; i < 16; ++i) { p0[i] = 0.f; p1[i] = 0.f; }
            }
            f32x16 c0s, c1s;
            if (MODE == 1) { c0s = p0; c1s = p1; }
#pragma unroll
            for (int s = 0; s < NS; ++s) {
                const bf16x8 k0 = *(LAS const bf16x8*)(sb + ka[s]), k1 = *(LAS const bf16x8*)(sb + ka[s] + 32 * KPITCH);
                p0 = __builtin_amdgcn_mfma_f32_32x32x16_bf16(k0, qf[s], p0, 0, 0, 0);
                p1 = __builtin_amdgcn_mfma_f32_32x32x16_bf16(k1, qf[s], p1, 0, 0, 0);
            }
            if (j == jv) {
                if (MODE == 0) {
                    const int qrel = (qrow + r) - 64 * j - 4 * h;
#pragma unroll
                    for (int i = 0; i < 16; ++i) { const int kr_ = (i & 3) + 8 * (i >> 2); if (kr_ > qrel) p0[i] = MASKV; if (kr_ + 32 > qrel) p1[i] = MASKV; }
                } else if (MODE == 1) {
#pragma unroll
                    for (int i = 0; i < 16; ++i) { p0[i] -= 2.0f * __builtin_fmaxf(c0s[i], 0.f); p1[i] -= 2.0f * __builtin_fmaxf(c1s[i], 0.f); }
                }
            }
            float tm;
            { float a = max3f(p0[0], p0[1], p1[0]), bq = max3f(p0[2], p0[3], p1[1]); a = max3f(a, p1[2], p1[3]);
#pragma unroll
              for (int i = 4; i < 16; i += 4) { a = max3f(a, p0[i], p0[i + 1]); bq = max3f(bq, p0[i + 2], p0[i + 3]); a = max3f(a, p1[i], p1[i + 1]); bq = max3f(bq, p1[i + 2], p1[i + 3]); }
              tm = halfmax(__builtin_fmaxf(a, bq)); }
            if (__any(tm > m_run + THR)) {
                const float mn = __builtin_fmaxf(m_run, tm), al = __builtin_amdgcn_exp2f(m_run - mn);
                m_run = mn; l_run *= al;
#pragma unroll
                for (int d = 0; d < NDB; ++d)
#pragma unroll
                    for (int i = 0; i < 16; ++i) o[d][i] *= al;
            }
            float ls = 0.f;
#pragma unroll
            for (int i = 0; i < 16; ++i) { p0[i] = __builtin_amdgcn_exp2f(p0[i] - m_run); p1[i] = __builtin_amdgcn_exp2f(p1[i] - m_run); ls += p0[i] + p1[i]; }
            l_run += ls;
            bf16x8 pf[4];
#pragma unroll
            for (int t = 0; t < 2; ++t) {
                v4u w0, w1;
                w0.x = cvtpk(p0[8 * t + 0], p0[8 * t + 1]); w0.y = cvtpk(p0[8 * t + 2], p0[8 * t + 3]); w0.z = cvtpk(p0[8 * t + 4], p0[8 * t + 5]); w0.w = cvtpk(p0[8 * t + 6], p0[8 * t + 7]);
                w1.x = cvtpk(p1[8 * t + 0], p1[8 * t + 1]); w1.y = cvtpk(p1[8 * t + 2], p1[8 * t + 3]); w1.z = cvtpk(p1[8 * t + 4], p1[8 * t + 5]); w1.w = cvtpk(p1[8 * t + 6], p1[8 * t + 7]);
                pf[t] = __builtin_bit_cast(bf16x8, w0); pf[2 + t] = __builtin_bit_cast(bf16x8, w1);
            }
#pragma unroll
            for (int d = 0; d < NDB; ++d)
#pragma unroll
                for (int ks = 0; ks < 4; ++ks) {
                    const s16x4 lo = vtr(sb + va[d] + ks * 16 * VPITCH), hi = vtr(sb + va[d] + ks * 16 * VPITCH + 8 * VPITCH);
                    const bf16x8 vf = (bf16x8){lo[0], lo[1], lo[2], lo[3], hi[0], hi[1], hi[2], hi[3]};
                    o[d] = __builtin_amdgcn_mfma_f32_32x32x16_bf16(vf, pf[ks], o[d], 0, 0, 0);
                }
        }
        if (j + 1 < NT) ATT_WRITE((j + 1) & 1);
        __syncthreads();
    }
#undef ATT_LOAD
#undef ATT_WRITE
    const float linv = 1.0f / halfsum(l_run);
    if (MODE != 1) {
        bf16* orow = Op + (rb + qrow + r) * DM + 4 * h;
#pragma unroll
        for (int d = 0; d < NDB; ++d)
#pragma unroll
            for (int g = 0; g < 4; ++g) { v2u w; w.x = cvtpk(o[d][4 * g] * linv, o[d][4 * g + 1] * linv); w.y = cvtpk(o[d][4 * g + 2] * linv, o[d][4 * g + 3] * linv); *(v2u*)(orow + 32 * d + 8 * g) = w; }
    } else {
        LAS float* ex = (LAS float*)lds;
        if (map == 1) {
#pragma unroll
            for (int d = 0; d < NDB; ++d)
#pragma unroll
                for (int i = 0; i < 16; ++i) ex[((wq * 4 + d) * 16 + i) * 64 + lane] = o[d][i] * linv;
        }
        __syncthreads();
        if (map == 0) {
            float s1 = P.lq1[lane] * P.lk1[lane], s2 = P.lq2[lane] * P.lk2[lane];
            s1 = wave_sum(s1); s2 = wave_sum(s2);
            const float lam = __expf(s1) - __expf(s2) + P.lam_init;
            float ss = 0.f;
#pragma unroll
            for (int d = 0; d < NDB; ++d)
#pragma unroll
                for (int i = 0; i < 16; ++i) { o[d][i] = o[d][i] * linv - lam * ex[((wq * 4 + d) * 16 + i) * 64 + lane]; ss += o[d][i] * o[d][i]; }
            ss = halfsum(ss);
            const float rn = __builtin_amdgcn_rsqf(ss * (1.0f / 128.0f) + EPS) * (1.0f - P.lam_init);
            bf16* orow = Op + (rb + qrow + r) * DM + 4 * h;
#pragma unroll
            for (int d = 0; d < NDB; ++d)
#pragma unroll
                for (int g = 0; g < 4; ++g) { const f32x4 gg = *(const f32x4*)(P.dng + 32 * d + 8 * g + 4 * h);
                    v2u w; w.x = cvtpk(o[d][4 * g] * rn * gg[0], o[d][4 * g + 1] * rn * gg[1]); w.y = cvtpk(o[d][4 * g + 2] * rn * gg[2], o[d][4 * g + 3] * rn * gg[3]); *(v2u*)(orow + 32 * d + 8 * g) = w; }
        }
        __syncthreads();
    }
}

__device__ __forceinline__ void attn_phase(const Params& P, LAS unsigned char* lds, const int* list, int G, int c) {
    for (int rnd = 0; rnd * G < N_ITEMS; ++rnd) {
        const int idx = rnd * G + ((rnd & 1) ? (G - 1 - c) : c);
        if (idx >= N_ITEMS) break;
        const int code = list[idx], type = code & 3, rem = code >> 2;
        if (type == 0) attn_unit<0>(P, lds, (rem / 32) >> 2, (rem / 32) & 3, rem % 32);
        else if (type == 1) attn_unit<1>(P, lds, (rem / 64) >> 2, (rem / 64) & 3, rem % 64);
        else attn_unit<2>(P, lds, (rem / 32) >> 2, (rem / 32) & 3, rem % 32);
    }
}
}
template <class Epi>
__global__ __launch_bounds__(256) void k_ngemm(const bf16* A, int lda, const bf16* Bt, int K, Epi epi) {
    const int w = threadIdx.x >> 6, l = threadIdx.x & 63;
    const int row0 = blockIdx.y * 64 + (w >> 1) * 32, col0 = blockIdx.x * 64 + (w & 1) * 32;
    const int r = l & 31, hf = l >> 5;
    f32x16 acc;
#pragma unroll
    for (int i = 0; i < 16; ++i) acc[i] = 0.f;
    const bf16* ap = A + (size_t)(row0 + r) * lda + 4 * hf;
    const bf16* bp = Bt + (size_t)(col0 + r) * K + 4 * hf;
    for (int k = 0; k < K; k += 8) {
        const v2u a = *(const v2u*)(ap + k), b = *(const v2u*)(bp + k);
        acc = __builtin_amdgcn_mfma_f32_32x32x2f32(bflo(a.x), bflo(b.x), acc, 0, 0, 0);
        acc = __builtin_amdgcn_mfma_f32_32x32x2f32(bfhi(a.x), bfhi(b.x), acc, 0, 0, 0);
        acc = __builtin_amdgcn_mfma_f32_32x32x2f32(bflo(a.y), bflo(b.y), acc, 0, 0, 0);
        acc = __builtin_amdgcn_mfma_f32_32x32x2f32(bfhi(a.y), bfhi(b.y), acc, 0, 0, 0);
    }
#pragma unroll
    for (int i = 0; i < 16; ++i) epi(row0 + (i & 3) + 8 * (i >> 2) + 4 * hf, col0 + r, acc[i]);
}
__device__ __forceinline__ float log_sigmoid_f(float z) { return fminf(z, 0.f) - log1pf(expf(-fabsf(z))); }
struct NEpiH {
    bf16* Hb; const float* rstd; float* logf; const float* fb; float* ssq; float* sskv;
    __device__ __forceinline__ void operator()(int row, int col, float v) const {
        v *= rstd[row];
        Hb[(size_t)row * HN + col] = (bf16)f2bf(v);
        if (col >= H_CQ && col < H_CKV) atomicAdd(ssq + row, v * v);
        else if (col >= H_CKV && col < H_KR) atomicAdd(sskv + row, v * v);
        else if (col >= H_FF && col < H_FF + 4) logf[row * 4 + (col - H_FF)] = log_sigmoid_f(v + fb[col - H_FF]);
    }
};
__device__ __forceinline__ void rope_cs(int t, int j, float& c, float& s) {
    const float inv = (float)(1.0 / pow(10000.0, (double)j / 16.0));
    const float ang = (float)t * inv;
    c = (float)cos((double)ang); s = (float)sin((double)ang);
}
struct NEpiQ {
    bf16* QM; const float* ssq;
    __device__ __forceinline__ void operator()(int row, int col, float v) const {
        v *= 1.0f / sqrtf(ssq[row] * (1.0f / 256.0f) + EPS);
        const float other = __shfl_xor(v, 1);
        const int d = col % 96;
        if (col < 384) {
            if (d >= 64) { const int jj = d - 64, j = jj >> 1; float c, s; rope_cs(row & (SEQ - 1), j, c, s); v = (jj & 1) ? (other * s + v * c) : (v * c - other * s); }
            QM[(size_t)row * 384 + col] = (bf16)f2bf(v);
        }
    }
};
struct NEpiKV {
    bf16* KVM; const float* sskv;
    __device__ __forceinline__ void operator()(int row, int col, float v) const {
        v *= 1.0f / sqrtf(sskv[row] * (1.0f / 128.0f) + EPS);
        KVM[(size_t)row * 512 + col] = (bf16)f2bf(v);
    }
};
struct NEpiRes {
    const float* xold; float* xnew; bf16* xb; float* ss;
    __device__ __forceinline__ void operator()(int row, int col, float v) const {
        const float x = xold[(size_t)row * DM + col] + v;
        xnew[(size_t)row * DM + col] = x; xb[(size_t)row * DM + col] = (bf16)f2bf(x);
        atomicAdd(ss + row, x * x);
    }
};
struct NEpiUp {
    float* tmp; const float* ss2; int row_base, pad;
    __device__ __forceinline__ void operator()(int row, int col, float v) const {
        tmp[(size_t)(row - row_base) * NUP + col] = v / sqrtf(ss2[row] * (1.0f / DM) + EPS);
    }
};
__global__ void k_kr(const bf16* Hb, bf16* KR) {
    const int idx = blockIdx.x * blockDim.x + threadIdx.x;
    const int j = idx & 15, row = idx >> 4;
    float c, s; rope_cs(row & (SEQ - 1), j, c, s);
    const float x1 = bf2f(Hb[(size_t)row * HN + H_KR + j]), x2 = bf2f(Hb[(size_t)row * HN + H_KR + 16 + j]);
    KR[(size_t)row * 32 + 2 * j] = (bf16)f2bf(x1 * c - x2 * s); KR[(size_t)row * 32 + 2 * j + 1] = (bf16)f2bf(x1 * s + x2 * c);
}
__global__ __launch_bounds__(256) void k_cum(const float* logf, float* cum) {
    const int b = blockIdx.x >> 2, h = blockIdx.x & 3, tid = threadIdx.x;
    __shared__ double part[256];
    double loc[32]; double s = 0.0;
#pragma unroll
    for (int i = 0; i < 32; ++i) { s += (double)logf[(size_t)(b * SEQ + tid * 32 + i) * 4 + h]; loc[i] = s; }
    part[tid] = s;
    __syncthreads();
    double pre = 0.0;
    for (int j = 0; j < tid; ++j) pre += part[j];
#pragma unroll
    for (int i = 0; i < 32; ++i) cum[(size_t)(b * SEQ + tid * 32 + i) * 4 + h] = (float)((pre + loc[i]) * 1.4426950408889634);
}
template <int DK, int DV, int MODE>
__global__ __launch_bounds__(256) void k_attn(const bf16* Q, int ldq, int hq, const bf16* K, int ldk, int hk, const bf16* K2, int ldk2, const bf16* V, int ldv, int hv,
                                              bf16* Ob, float* Of, int ldo, int ho, const float* cum) {
    constexpr int KP = DK + 4, VP = DV + 4, PP = 68, DVT = DV / 8;
    __shared__ __attribute__((aligned(16))) float Ks[64 * KP];
    __shared__ __attribute__((aligned(16))) float Vs[64 * VP];
    __shared__ __attribute__((aligned(16))) float Ps[32 * PP];
    const int tid = threadIdx.x, qi = tid >> 3, part = tid & 7;
    const int head = blockIdx.y, b = blockIdx.z;
    const int q0 = blockIdx.x * 32, qg = q0 + qi;
    const size_t rb = (size_t)b * SEQ;
    Q += (size_t)head * hq; K += (size_t)head * hk; V += (size_t)(MODE == 1 ? (head >> 1) : head) * hv;
    float slope = 0.f;
    if (MODE == 1) slope = exp2f(-8.0f * (float)((head >> 1) + 1) / 4.0f) * LOG2E;
    float q[DK];
#pragma unroll
    for (int d = 0; d < DK; ++d) q[d] = bf2f(Q[(rb + qg) * ldq + d]);
    float o[DVT];
#pragma unroll
    for (int d = 0; d < DVT; ++d) o[d] = 0.f;
    float m = -3.0e38f, lsum = 0.f;
    const float cq = (MODE == 0) ? cum[(rb + qg) * 4 + head] : 0.f;
    const int ntile = q0 / 64 + 1;
    for (int j = 0; j < ntile; ++j) {
        const int k0 = j * 64;
        __syncthreads();
        for (int i = tid; i < 64 * DK; i += 256) { const int rr = i / DK, c = i % DK; Ks[rr * KP + c] = (c < 64) ? bf2f(K[(rb + k0 + rr) * ldk + c]) : bf2f(K2[(rb + k0 + rr) * ldk2 + (c - 64)]); }
        for (int i = tid; i < 64 * DV; i += 256) { const int rr = i / DV, c = i % DV; Vs[rr * VP + c] = bf2f(V[(rb + k0 + rr) * ldv + c]); }
        __syncthreads();
        float tmax = -3.0e38f;
#pragma unroll 1
        for (int i = 0; i < 8; ++i) {
            const int kk = part + 8 * i, kg = k0 + kk;
            float a = 0.f;
#pragma unroll
            for (int d = 0; d < DK; d += 4) { const float4 kv = *(const float4*)(Ks + kk * KP + d); a += q[d] * kv.x; a += q[d + 1] * kv.y; a += q[d + 2] * kv.z; a += q[d + 3] * kv.w; }
            float bias;
            if (MODE == 0) bias = (kg <= qg) ? (cq - cum[(rb + kg) * 4 + head]) : NEGV;
            else if (MODE == 1) bias = ((kg >> 6) <= (qg >> 6)) ? (-slope * fabsf((float)(qg - kg))) : NEGV;
            else bias = ((kg >> 6) <= (qg >> 6)) ? 0.f : NEGV;
            const float sv = a + bias;
            Ps[qi * PP + kk] = sv;
            tmax = fmaxf(tmax, sv);
        }
        tmax = fmaxf(tmax, __shfl_xor(tmax, 1)); tmax = fmaxf(tmax, __shfl_xor(tmax, 2)); tmax = fmaxf(tmax, __shfl_xor(tmax, 4));
        const float mn = fmaxf(m, tmax);
        const float alpha = exp2f(m - mn);
        m = mn;
        float ps = 0.f;
#pragma unroll 1
        for (int i = 0; i < 8; ++i) { const int kk = part + 8 * i; const float p = exp2f(Ps[qi * PP + kk] - mn); ps += p; Ps[qi * PP + kk] = p; }
        lsum = lsum * alpha + ps;
#pragma unroll
        for (int d = 0; d < DVT; ++d) o[d] *= alpha;
        __syncthreads();
#pragma unroll 4
        for (int kk = 0; kk < 64; ++kk) {
            const float p = Ps[qi * PP + kk];
#pragma unroll
            for (int d = 0; d < DVT; d += 4) { const float4 vv = *(const float4*)(Vs + kk * VP + part * DVT + d); o[d] += p * vv.x; o[d + 1] += p * vv.y; o[d + 2] += p * vv.z; o[d + 3] += p * vv.w; }
        }
    }
    lsum += __shfl_xor(lsum, 1); lsum += __shfl_xor(lsum, 2); lsum += __shfl_xor(lsum, 4);
    const float inv = 1.0f / lsum;
#pragma unroll
    for (int d = 0; d < DVT; ++d) {
        const float v = o[d] * inv;
        if (MODE == 1) Of[(size_t)qg * ldo + head * ho + part * DVT + d] = v;
        else Ob[(rb + qg) * ldo + head * ho + part * DVT + d] = (bf16)f2bf(v);
    }
}
__global__ __launch_bounds__(256) void k_diff_combine(const float* o12, const float* lq1, const float* lk1, const float* lq2, const float* lk2, const float* ng, float lam_init, bf16* AOb) {
    const int wv = blockIdx.x * 4 + (threadIdx.x >> 6), lane = threadIdx.x & 63;
    const int t = wv >> 2, h = wv & 3;
    float s1 = lq1[lane] * lk1[lane], s2 = lq2[lane] * lk2[lane];
    s1 = wave_sum(s1); s2 = wave_sum(s2);
    const float lam = expf(s1) - expf(s2) + lam_init;
    const float* p1 = o12 + (size_t)t * 1024 + (h * 2) * 128;
    const float* p2 = p1 + 128;
    const float a = p1[lane] - lam * p2[lane], b = p1[lane + 64] - lam * p2[lane + 64];
    const float ss = wave_sum(a * a + b * b);
    const float r = 1.0f / sqrtf(ss / 128.0f + EPS);
    bf16* out = AOb + (size_t)t * 1024 + 256 + h * 128;
    out[lane] = (bf16)f2bf(a * r * ng[lane] * (1.0f - lam_init));
    out[lane + 64] = (bf16)f2bf(b * r * ng[lane + 64] * (1.0f - lam_init));
}
__global__ void k_conv_act(const float* tmp, int lead, int t0, const float* cw, const float* cb, bf16* act, int nrows) {
    const size_t idx = (size_t)blockIdx.x * blockDim.x + threadIdx.x;
    if (idx >= (size_t)nrows * DFF) return;
    const int c = (int)(idx % DFF), r = (int)(idx / DFF);
    const int t = (t0 + r) & (SEQ - 1);
    const int ng = 256 * (c >> 7) + (c & 127), nu = ng + 128;
    float G = cb[c], U = cb[DFF + c];
#pragma unroll
    for (int j = 0; j < 3; ++j) {
        const int tt = t - 2 + j;
        if (tt >= 0) {
            const float* row = tmp + (size_t)(r + lead - 2 + j) * NUP;
            G += row[ng] * cw[j * NUP + c];
            U += row[nu] * cw[j * NUP + DFF + c];
        }
    }
    const float sg = G / (1.0f + expf(-G));
    act[(size_t)(t0 + r) * DFF + c] = (bf16)f2bf(sg * U);
}
__global__ __launch_bounds__(256) void k_final(float* x, const float* ss, const float* g) {
    const int row = blockIdx.x * 4 + (threadIdx.x >> 6), lane = threadIdx.x & 63;
    const float r = 1.0f / sqrtf(ss[row] * (1.0f / DM) + EPS);
    float4* xr = (float4*)(x + (size_t)row * DM) + lane; const float4* gr = (const float4*)g + lane;
#pragma unroll
    for (int j = 0; j < 4; ++j) { float4 v = xr[64 * j]; const float4 gg = gr[64 * j]; v.x *= r * gg.x; v.y *= r * gg.y; v.z *= r * gg.z; v.w *= r * gg.w; xr[64 * j] = v; }
}
constexpr size_t WS_ROPE = 234 * MiB;
constexpr size_t WS_ITEMS = 235 * MiB;
constexpr size_t WS_END2 = 236 * MiB;
constexpr int PH_H = 0, PH_M = 1, PH_A = 2, PH_O = 3, PH_U = 4, PH_D = 5, PH_FINAL = 13, NPHASES = 14;

__device__ __forceinline__ void rope_table(float2* tab, int gtid, int ngt) {
    for (int i = gtid; i < SEQ * 16; i += ngt) { float c, s; rope_cs(i >> 4, i & 15, c, s); tab[i] = make_float2(c, s); }
}
__device__ __forceinline__ void cum_scan(const float* logf, float* cum, int b, int h, LAS double* part, int tid) {
    double loc[16]; double s = 0.0;
#pragma unroll
    for (int i = 0; i < 16; ++i) { s += (double)logf[(size_t)(b * SEQ + tid * 16 + i) * 4 + h]; loc[i] = s; }
    part[tid] = s;
    __syncthreads();
    double pre = 0.0;
    for (int j = 0; j < tid; ++j) pre += part[j];
#pragma unroll
    for (int i = 0; i < 16; ++i) cum[(size_t)(b * SEQ + tid * 16 + i) * 4 + h] = (float)((pre + loc[i]) * 1.4426950408889634);
    __syncthreads();
}

#define CAS __attribute__((address_space(4)))
__global__ void __launch_bounds__(NTHREADS, 2) fwd(Args args) {
    extern __shared__ __attribute__((aligned(16))) unsigned char lds_raw[];
    LAS unsigned char* lds = (LAS unsigned char*)lds_raw;
    int lo, hi; { CAS const Args* ap0 = (CAS const Args*)__builtin_amdgcn_kernarg_segment_ptr(); lo = ap0->ph_lo; hi = ap0->ph_hi; }
#define IN(k) (lo <= (k) && (k) < hi)
#define FRAME() \
    int tid = threadIdx.x; asm volatile("" : "+v"(tid)); \
    CAS const Args* ap = (CAS const Args*)__builtin_amdgcn_kernarg_segment_ptr(); asm volatile("" : "+s"(ap)); unsigned char* ws = ap->ws; \
    const int lane = tid & 63, wave = __builtin_amdgcn_readfirstlane(tid >> 6); \
    int G_ = gridDim.x, bx_ = blockIdx.x; asm volatile("" : "+s"(G_), "+s"(bx_)); const int G = __builtin_amdgcn_readfirstlane(G_), bx = __builtin_amdgcn_readfirstlane(bx_); \
    const int vcu = (G % 8 == 0) ? (bx % 8) * (G / 8) + bx / 8 : bx; \
    const int gw = vcu * NWAVES + wave, ngw = G * NWAVES; \
    float* sm = (float*)(ws + WS_SM); (void)lane; (void)gw; (void)ngw; (void)sm;
    if (IN(0)) { FRAME(); p0_prologue(ap, lds, gw, ngw, lane, wave); rope_table((float2*)(ws + WS_ROPE), gw * 64 + lane, ngw * 64); att::build_items((int*)(ws + WS_ITEMS), gw * 64 + lane, ngw * 64); }
    for (int l = 0; l < DEPTH; ++l) {
        const int pb = 1 + 6 * l;
        if (IN(pb + PH_H)) {
            FRAME();
            unsigned char* wl = ws + WS_W + (size_t)l * WS_WL;
            pg8::Gemm g{(const bf16*)(ws + WS_XB), (const bf16*)(wl + W_IN), MTOK, HN, DM, DM}; pg8::StaticOrder S; S.init(MTOK, HN, G, bx);
            pg8::EpiH E{ws, ap->in[I_FB] + l * 4, l};
            pg8::gemm_phase<pg8::EpiH, pg8::StaticOrder, true, true>(lds, g, S, E);
        }
        if (IN(pb + PH_M)) {
            { FRAME(); unsigned char* wl = ws + WS_W + (size_t)l * WS_WL;
              pg8::Gemm g{(const bf16*)(ws + WS_HB) + H_CQ, (const bf16*)(wl + W_UQ), MTOK, 512, 256, HN}; pg8::HalfOrder S; S.init(MTOK, 512, G, bx, 0);
              pg8::EpiQ E{(bf16*)(ws + WS_QM), sm + SM_SSQ / 4 + l * MTOK, (const float2*)(ws + WS_ROPE)}; pg8::gemm_phase<pg8::EpiQ, pg8::HalfOrder, true, true>(lds, g, S, E); }
            { FRAME(); unsigned char* wl = ws + WS_W + (size_t)l * WS_WL;
              pg8::Gemm g{(const bf16*)(ws + WS_HB) + H_CKV, (const bf16*)(wl + W_UKV), MTOK, 512, 128, HN}; pg8::HalfOrder S; S.init(MTOK, 512, G, bx, 1);
              pg8::EpiKV E{(bf16*)(ws + WS_KVM), sm + SM_SSKV / 4 + l * MTOK}; pg8::gemm_phase<pg8::EpiKV, pg8::HalfOrder, true, true>(lds, g, S, E); }
            { FRAME(); const bf16* HB = (const bf16*)(ws + WS_HB); bf16* KR = (bf16*)(ws + WS_KR); const float2* rope = (const float2*)(ws + WS_ROPE);
              for (int i = (gw * 64 + lane); i < MTOK * 16; i += ngw * 64) {
                const int j = i & 15, row = i >> 4; const float2 cs = rope[(size_t)(row & (SEQ - 1)) * 16 + j];
                const float x1 = bf2f(HB[(size_t)row * HN + H_KR + j]), x2 = bf2f(HB[(size_t)row * HN + H_KR + 16 + j]);
                *(unsigned*)(KR + (size_t)row * 32 + 2 * j) = pk2(x1 * cs.x - x2 * cs.y, x1 * cs.y + x2 * cs.x);
              }
              __syncthreads();
              if (bx < 8) cum_scan(sm + SM_LOGF / 4, sm + SM_CUM / 4, bx >> 2, bx & 3, (LAS double*)lds, tid); }
        }
        if (IN(pb + PH_A)) {
            FRAME();
            const float lam_init = l == 0 ? 0.2f : 0.35550906759096934f;
            att::Params P{(const bf16*)(ws + WS_HB), (const bf16*)(ws + WS_QM), (const bf16*)(ws + WS_KVM), (const bf16*)(ws + WS_KR), (bf16*)(ws + WS_AO), sm + SM_CUM / 4,
                          ap->in[I_LQ1] + l * 64, ap->in[I_LK1] + l * 64, ap->in[I_LQ2] + l * 64, ap->in[I_LK2] + l * 64, ap->in[I_DNG] + l * 128, lam_init, 0};
            att::attn_phase(P, lds, (const int*)(ws + WS_ITEMS), G, vcu);
        }
        if (IN(pb + PH_O)) {
            FRAME(); unsigned char* wl = ws + WS_W + (size_t)l * WS_WL;
            pg8::Gemm g{(const bf16*)(ws + WS_AO), (const bf16*)(wl + W_O), MTOK, DM, DM, DM}; pg8::StaticOrder S; S.init(MTOK, DM, G, bx);
            pg8::EpiRes E{l == 0 ? ap->in[I_X] : ap->out, ap->out, (bf16*)(ws + WS_XB), sm + SM_SS2 / 4 + l * MTOK};
            pg8::gemm_phase<pg8::EpiRes, pg8::StaticOrder, true, true>(lds, g, S, E);
        }
        if (IN(pb + PH_U)) {
            FRAME(); unsigned char* wl = ws + WS_W + (size_t)l * WS_WL;
            pg8::Gemm g{(const bf16*)(ws + WS_XB), (const bf16*)(wl + W_UP), MTOK, NUP, DM, DM}; pg8::UpOrder S; S.init_up(G, bx);
            pg8::EpiUp E{ws, ap->in[I_CW] + (size_t)l * 3 * NUP, ap->in[I_CB] + (size_t)l * NUP, l};
            pg8::gemm_phase<pg8::EpiUp, pg8::UpOrder, true, true>(lds, g, S, E);
        }
        if (IN(pb + PH_D)) {
            FRAME(); unsigned char* wl = ws + WS_W + (size_t)l * WS_WL;
            pg8::Gemm g{(const bf16*)(ws + WS_HB), (const bf16*)(wl + W_DN), MTOK, DM, DFF, DFF}; pg8::StaticOrder S; S.init(MTOK, DM, G, bx);
            pg8::EpiRes E{ap->out, ap->out, (bf16*)(ws + WS_XB), sm + SM_SS1N / 4 + l * MTOK};
            pg8::gemm_phase<pg8::EpiRes, pg8::StaticOrder, true, true>(lds, g, S, E);
        }
    }
    if (IN(PH_FINAL)) {
        FRAME();
        const float* ss = sm + SM_SS1N / 4 + (DEPTH - 1) * MTOK; const float4* gr = (const float4*)ap->in[I_FG] + lane;
        for (int row = gw; row < MTOK; row += ngw) {
            const float r = __builtin_amdgcn_rsqf(ss[row] * (1.0f / DM) + EPS);
            float4* xr = (float4*)(ap->out + (size_t)row * DM) + lane;
#pragma unroll
            for (int j = 0; j < 4; ++j) { float4 v = xr[64 * j]; const float4 gg = gr[64 * j]; v.x *= r * gg.x; v.y *= r * gg.y; v.z *= r * gg.z; v.w *= r * gg.w; xr[64 * j] = v; }
        }
    }
#undef IN
#undef FRAME
}
template <class Epi> static void ngemm(hipStream_t st, const bf16* A, int lda, const bf16* Bt, int K, int rows, int N, Epi epi) {
    hipLaunchKernelGGL((k_ngemm<Epi>), dim3(N / 64, rows / 64), dim3(256), 0, st, A, lda, Bt, K, epi);
}
static void launch_fwd(hipStream_t st, Args a, int lo, int hi) { a.ph_lo = lo; a.ph_hi = hi; hipLaunchKernelGGL(fwd, dim3(256), dim3(NTHREADS), LDS_BYTES, st, a); }
extern "C" void kernel_launch(void* const* d_in, const int* in_sizes, int n_in, void* d_out, int out_size, void* d_ws, size_t ws_size, hipStream_t stream) {
    static int inited = 0;
    if (!inited) {
        if (n_in != 20 || ws_size < WS_END2) { fprintf(stderr, "kernel_launch: unexpected n_in %d / ws_size %zu\n", n_in, ws_size); inited = -1; return; }
        if (hipFuncSetAttribute((const void*)fwd, hipFuncAttributeMaxDynamicSharedMemorySize, LDS_BYTES) != hipSuccess) { fprintf(stderr, "hipFuncSetAttribute failed\n"); inited = -1; return; }
        inited = 1;
    }
    if (inited < 0) return;
    Args a{};
    for (int i = 0; i < 20; ++i) a.in[i] = (const float*)d_in[i];
    a.out = (float*)d_out; a.ws = (unsigned char*)d_ws;
    unsigned char* ws = (unsigned char*)d_ws;
    (void)hipMemsetAsync(ws + WS_CTL, 0, 1 * MiB, stream);
    launch_fwd(stream, a, 0, 1);

    bf16* XB = (bf16*)(ws + WS_XB); bf16* HB = (bf16*)(ws + WS_HB); bf16* QM = (bf16*)(ws + WS_QM); bf16* KVM = (bf16*)(ws + WS_KVM); bf16* KR = (bf16*)(ws + WS_KR); bf16* AO = (bf16*)(ws + WS_AO);
    bf16* ACT = (bf16*)(ws + WS_HB);
    float* sm = (float*)(ws + WS_SM);
    float* cum = sm + SM_CUM / 4;
    float* o12 = (float*)(ws + WS_XB);
    float* uptmp = (float*)(ws + WS_QM);
    for (int l = 0; l < DEPTH; ++l) {
        const float lam_init = 0.8f - 0.6f * expf(-0.3f * (float)l);
        const int pb = 1 + 6 * l;
        unsigned char* wl = ws + WS_W + (size_t)l * WS_WL;
        float* ss2 = sm + SM_SS2 / 4 + l * MTOK;
        launch_fwd(stream, a, pb + PH_H, pb + PH_H + 1);
        launch_fwd(stream, a, pb + PH_M, pb + PH_M + 1);
        launch_fwd(stream, a, pb + PH_A, pb + PH_A + 1);
        launch_fwd(stream, a, pb + PH_O, pb + PH_O + 1);
        launch_fwd(stream, a, pb + PH_U, pb + PH_U + 1);
        launch_fwd(stream, a, pb + PH_D, pb + PH_D + 1);
    }
    launch_fwd(stream, a, PH_FINAL, PH_FINAL + 1);
}
```

```cpp
#include <hip/hip_runtime.h>
#include <cstdio>
#include <cstdint>

constexpr int BATCH = 2, SEQ = 8192, DM = 1024, DEPTH = 2, MTOK = BATCH * SEQ;
constexpr int IN_COLS = 2724, DFF = 2816, NUP = 2 * DFF;
constexpr int HN = 2816;
constexpr int H_FQ = 0, H_FK = 256, H_FV = 512, H_DQ = 768, H_DK = 1280, H_DV = 1792, H_CQ = 2304, H_CKV = 2560, H_KR = 2688, H_FF = 2720;
constexpr float EPS = 1e-6f;
constexpr float LOG2E = 1.4426950408889634f;
constexpr float NEGV = -1e30f;

constexpr size_t MiB = 1u << 20;
constexpr size_t WS_CTL = 0;
constexpr size_t WS_W = 1 * MiB, WS_WL = 25 * MiB;
constexpr size_t W_IN = 0, W_UQ = 5632 * 1024, W_UKV = W_UQ + 256 * 1024, W_O = 6 * MiB, W_UP = 8 * MiB, W_DN = 19 * MiB;
constexpr size_t WS_XB = 51 * MiB;
constexpr size_t WS_SM = 83 * MiB;
constexpr size_t SM_RSTD1 = 0;
constexpr size_t SM_SSQ = 64 * 1024, SM_SSKV = 192 * 1024, SM_SS2 = 320 * 1024, SM_SS1N = 448 * 1024;
constexpr size_t SM_LOGF = 576 * 1024, SM_CUM = 832 * 1024;
constexpr size_t SM_ZERO_BEG = SM_SSQ, SM_ZERO_END = SM_LOGF;
constexpr size_t WS_HB = 85 * MiB;
constexpr size_t WS_QM = 173 * MiB;
constexpr size_t WS_KVM = 185 * MiB;
constexpr size_t WS_KR = 201 * MiB;
constexpr size_t WS_AO = 202 * MiB;
constexpr size_t WS_END = 234 * MiB;

#define LAS __attribute__((address_space(3)))
typedef unsigned short bf16;
typedef float f32x16 __attribute__((ext_vector_type(16)));
typedef unsigned v4u __attribute__((ext_vector_type(4)));
typedef unsigned v2u __attribute__((ext_vector_type(2)));
__device__ __forceinline__ unsigned f2bf(float f) { unsigned u = __builtin_bit_cast(unsigned, f); return (u + 0x7fffu + ((u >> 16) & 1u)) >> 16; }
__device__ __forceinline__ unsigned pk2(float lo, float hi) { return f2bf(lo) | (f2bf(hi) << 16); }
__device__ __forceinline__ float bf2f(unsigned b) { return __builtin_bit_cast(float, (b & 0xffffu) << 16); }
__device__ __forceinline__ float bflo(unsigned w) { return __builtin_bit_cast(float, w << 16); }
__device__ __forceinline__ float bfhi(unsigned w) { return __builtin_bit_cast(float, w & 0xffff0000u); }

namespace pg8 {
#define PG8_LAS __attribute__((address_space(3)))
typedef unsigned short bf16_t;
typedef short bf16x8 __attribute__((ext_vector_type(8)));
typedef float f32x4 __attribute__((ext_vector_type(4)));
typedef unsigned u32x4 __attribute__((ext_vector_type(4)));
constexpr int BM = 256, BK = 64, HALF = 128, HTB = HALF * BK * 2  , STAGE_BYTES = 8 * HTB, NXCD = 8, WGM = 8;

__host__ __device__ __forceinline__ int lds_byte(int r, int c) { const int st = (r >> 4) * 2 + (c >> 5), rr = r & 15, cc = c & 31, ob = rr * 64 + cc * 2; return st * 1024 + (ob ^ (((ob >> 9) & 1) << 5)); }
__host__ __device__ __forceinline__ void stage_rc(int b, int& R, int& C) { const int st = b / 1024, sb = b % 1024, swz = sb ^ (((sb >> 9) & 1) << 5); R = (st >> 1) * 16 + swz / 64; C = (st & 1) * 32 + (swz % 64) / 2; }
__host__ __device__ __forceinline__ int perm32(int rho) { const int n = rho >> 4, i = rho & 15; return 8 * (i >> 2) + 4 * n + (i & 3); }

struct Unit { int pm, pn; };
struct Gemm { const bf16_t* A; const bf16_t* Bt; int M, N, K, lda; };

struct StaticOrder {
    int nM, nN, nwg, G, c;
    __host__ __device__ void init(int M, int N, int G_, int c_) { nM = M / BM; nN = N / BM; nwg = nM * nN; G = G_; c = c_; }
    __host__ __device__ bool next(int i, Unit& u) const {
        const long L = (long)i * G + c; if (L >= nwg) return false;
        int wgid = (int)L; { const int q = nwg / NXCD, r = nwg % NXCD, xcd = wgid % NXCD, off = wgid / NXCD; wgid = (xcd < r ? xcd * (q + 1) : r * (q + 1) + (xcd - r) * q) + off; }
        const int nig = WGM * nN, gid = wgid / nig, fm = gid * WGM, gsz = (nM - fm) < WGM ? (nM - fm) : WGM;
        u.pm = fm + ((wgid % nig) % gsz); u.pn = (wgid % nig) / gsz; return true;
    }
    __device__ __forceinline__ int arow(const Unit& u) const { return u.pm * BM; }
    __device__ __forceinline__ int arperm(int R) const { return R; }
    __device__ __forceinline__ int ahalf() const { return HALF; }
    __device__ __forceinline__ void a_ready(const Unit&) const {}
    __device__ __forceinline__ void done(const Unit&) const {}
};

__device__ __forceinline__ unsigned cvt_pk_bf16(float lo, float hi) { unsigned r; asm volatile("v_cvt_pk_bf16_f32 %0, %1, %2" : "=v"(r) : "v"(lo), "v"(hi)); return r; }
typedef float f32x2 __attribute__((ext_vector_type(2)));
__device__ __forceinline__ void glds16_s(unsigned voff, const void* sbase, unsigned ldsdst) {
    unsigned keep; ldsdst = __builtin_amdgcn_readfirstlane(ldsdst);
    { const unsigned long long p_ = (unsigned long long)sbase; sbase = (const void*)(((unsigned long long)(unsigned)__builtin_amdgcn_readfirstlane((unsigned)(p_ >> 32)) << 32) | (unsigned)__builtin_amdgcn_readfirstlane((unsigned)p_)); }
    asm volatile("s_mov_b32 %0, m0\n\ts_mov_b32 m0, %3\n\ts_nop 2\n\tglobal_load_lds_dwordx4 %1, %2\n\ts_mov_b32 m0, %0" : "=&s"(keep) : "v"(voff), "s"(sbase), "s"(ldsdst) : "memory");
}
template <class Epi, class Sched, bool ALIGN_EPI = false, bool SP2 = false>
__device__ __forceinline__ void gemm_phase(PG8_LAS unsigned char* lds, const Gemm g, const Sched& S, const Epi& E) {
    int tid_l = threadIdx.x; asm volatile("" : "+v"(tid_l));
    const int tid = tid_l, wid = __builtin_amdgcn_readfirstlane(tid >> 6), lane = tid & 63, wr = wid >> 2, wc = wid & 3, fr = lane & 15, fq = lane >> 4;
    const int K = g.K, nt = K / BK;
    unsigned voffA[2], voffB[2];
#pragma unroll
    for (int i = 0; i < 2; ++i) { int R, C; stage_rc(tid * 16 + i * 8192, R, C); const int Rb = Epi::PERM ? ((R & ~31) + perm32(R & 31)) : R;
        voffA[i] = (unsigned)(S.arperm(R) * g.lda + C) * 2u; voffB[i] = (unsigned)(Rb * K + C) * 2u; }
    const unsigned kstep = (unsigned)(BK * 2);
    const unsigned hstep = (unsigned)HALF * K * 2; const unsigned hstepA = (unsigned)S.ahalf() * g.lda * 2;
    const unsigned tstep = 2 * hstep;
    const unsigned ldsw = (unsigned)wid * 1024u;
    const int aoff = lds_byte(wr * 64 + fr, fq * 8), boff = lds_byte(wc * 32 + fr, fq * 8);
#define PG8_SA(b, h) (((b) * 2 + (h)) * HTB)
#define PG8_SB(b, h) ((4 + (b) * 2 + (h)) * HTB)
#define PG8_STAGE(bufoff, gbase, voff) do { _Pragma("unroll") for (int _i = 0; _i < 2; ++_i) \
        glds16_s((voff)[_i], (const char*)(gbase), (unsigned)(uintptr_t)(lds + (bufoff) + ldsw + _i * 8192)); } while (0)
#define PG8_LDA(dst, b, h) do { _Pragma("unroll") for (int m = 0; m < 4; ++m) _Pragma("unroll") for (int k = 0; k < 2; ++k) dst[m][k] = *(const PG8_LAS bf16x8*)(lds + PG8_SA(b, h) + aoff + m * 2048 + k * 1024); } while (0)
#define PG8_LDB(dst, b, h) do { _Pragma("unroll") for (int n = 0; n < 2; ++n) _Pragma("unroll") for (int k = 0; k < 2; ++k) dst[n][k] = *(const PG8_LAS bf16x8*)(lds + PG8_SB(b, h) + boff + n * 2048 + k * 1024); } while (0)
#define PG8_MMA(ai, bj, At, Bt) do { __builtin_amdgcn_s_setprio(1); _Pragma("unroll") for (int m = 0; m < 4; ++m) _Pragma("unroll") for (int n = 0; n < 2; ++n) _Pragma("unroll") for (int k = 0; k < 2; ++k) \
        acc[ai][bj][m][n] = __builtin_amdgcn_mfma_f32_16x16x32_bf16(Bt[n][k], At[m][k], acc[ai][bj][m][n], 0, 0, 0); __builtin_amdgcn_s_setprio(0); } while (0)
#define PG8_WAIT_V(n) asm volatile("s_waitcnt vmcnt(" #n ")" ::: "memory")
#define PG8_WAIT_L(n) asm volatile("s_waitcnt lgkmcnt(" #n ")" ::: "memory")
#define PG8_BAR __builtin_amdgcn_s_barrier()
#define PG8_SCHED __builtin_amdgcn_sched_barrier(0)
    Unit cur, nxt; int ui = 0;
    if (!S.next(0, cur)) return;
    f32x4 acc[2][2][4][2];
#pragma unroll
    for (int a = 0; a < 2; ++a)
#pragma unroll
        for (int b = 0; b < 2; ++b)
#pragma unroll
            for (int m = 0; m < 4; ++m)
#pragma unroll
                for (int n = 0; n < 2; ++n) acc[a][b][m][n] = (f32x4){0.f, 0.f, 0.f, 0.f};
    bf16x8 At[4][2], B0[2][2], B1[2][2];
    const char* cA = (const char*)g.A + (size_t)S.arow(cur) * g.lda * 2; const char* cB = (const char*)g.Bt + (size_t)cur.pn * tstep;
    S.a_ready(cur);
    if constexpr (SP2) {
        PG8_STAGE(PG8_SB(0, 0), cB, voffB); PG8_STAGE(PG8_SB(0, 1), cB + hstep, voffB); PG8_STAGE(PG8_SA(0, 0), cA, voffA); PG8_STAGE(PG8_SA(0, 1), cA + hstepA, voffA);
        if (wr == 1) PG8_BAR;
        PG8_WAIT_V(2); PG8_BAR;
        PG8_STAGE(PG8_SB(1, 0), cB + kstep, voffB); PG8_STAGE(PG8_SA(1, 0), cA + kstep, voffA); PG8_STAGE(PG8_SB(1, 1), cB + hstep + kstep, voffB);
        PG8_WAIT_V(6); PG8_BAR;
    } else {
        PG8_STAGE(PG8_SB(0, 0), cB, voffB); PG8_STAGE(PG8_SA(0, 0), cA, voffA); PG8_STAGE(PG8_SB(0, 1), cB + hstep, voffB); PG8_STAGE(PG8_SA(0, 1), cA + hstepA, voffA);
        if (wr == 1) PG8_BAR;
        PG8_WAIT_V(4); PG8_BAR;
        PG8_STAGE(PG8_SB(1, 0), cB + kstep, voffB); PG8_STAGE(PG8_SA(1, 0), cA + kstep, voffA); PG8_STAGE(PG8_SB(1, 1), cB + hstep + kstep, voffB);
        PG8_WAIT_V(6); PG8_BAR;
    }
    for (;;) {
        const bool has_next = S.next(ui + 1, nxt);
        const char* nA = has_next ? (const char*)g.A + (size_t)S.arow(nxt) * g.lda * 2 : cA; const char* nB = has_next ? (const char*)g.Bt + (size_t)nxt.pn * tstep : cB;
        for (int t = 0; t < nt; t += 2) {
            const bool last = (t == nt - 2);
            const char* a1 = cA + (size_t)(t + 1) * kstep;
            const char* a2 = last ? nA : cA + (size_t)(t + 2) * kstep; const char* b2 = last ? nB : cB + (size_t)(t + 2) * kstep;
            const char* a3 = a2 + kstep; const char* b3 = b2 + kstep;
            if (last && has_next) S.a_ready(nxt);
            if constexpr (SP2) {
            PG8_LDB(B0, 0, 0); PG8_LDB(B1, 0, 1); PG8_SCHED; PG8_LDA(At, 0, 0); PG8_STAGE(PG8_SA(1, 1), a1 + hstepA, voffA);
            PG8_WAIT_V(8); PG8_WAIT_L(0); PG8_BAR; PG8_MMA(0, 0, At, B0); PG8_MMA(0, 1, At, B1); PG8_BAR; PG8_SCHED;
            PG8_LDA(At, 0, 1); PG8_STAGE(PG8_SB(0, 0), b2, voffB); PG8_STAGE(PG8_SB(0, 1), b2 + hstep, voffB); PG8_STAGE(PG8_SA(0, 0), a2, voffA);
            PG8_WAIT_V(8); PG8_WAIT_L(0); PG8_BAR; PG8_MMA(1, 0, At, B0); PG8_MMA(1, 1, At, B1); PG8_BAR; PG8_SCHED;
            PG8_LDB(B0, 1, 0); PG8_LDB(B1, 1, 1); PG8_SCHED; PG8_LDA(At, 1, 0); PG8_STAGE(PG8_SA(0, 1), a2 + hstepA, voffA);
            PG8_WAIT_V(8); PG8_WAIT_L(0); PG8_BAR; PG8_MMA(0, 0, At, B0); PG8_MMA(0, 1, At, B1); PG8_BAR; PG8_SCHED;
            PG8_LDA(At, 1, 1); PG8_STAGE(PG8_SB(1, 0), b3, voffB); PG8_STAGE(PG8_SB(1, 1), b3 + hstep, voffB); PG8_STAGE(PG8_SA(1, 0), a3, voffA);
            PG8_WAIT_V(8); PG8_WAIT_L(0); PG8_BAR; PG8_MMA(1, 0, At, B0); PG8_MMA(1, 1, At, B1); PG8_BAR; PG8_SCHED;
            } else {
            PG8_LDB(B0, 0, 0); PG8_SCHED; PG8_LDA(At, 0, 0); PG8_STAGE(PG8_SA(1, 1), a1 + hstepA, voffA);
            PG8_WAIT_L(8); PG8_BAR; PG8_WAIT_L(0); PG8_MMA(0, 0, At, B0); PG8_BAR; PG8_SCHED;
            PG8_LDB(B1, 0, 1); PG8_STAGE(PG8_SB(0, 0), b2, voffB);
            PG8_BAR; PG8_WAIT_L(0); PG8_MMA(0, 1, At, B1); PG8_BAR;
            PG8_LDA(At, 0, 1); PG8_STAGE(PG8_SA(0, 0), a2, voffA);
            PG8_BAR; PG8_WAIT_L(0); PG8_MMA(1, 0, At, B0); PG8_BAR; PG8_SCHED;
            PG8_STAGE(PG8_SB(0, 1), b2 + hstep, voffB);
            PG8_WAIT_V(6); PG8_BAR; PG8_MMA(1, 1, At, B1); PG8_BAR;
            PG8_LDB(B0, 1, 0); PG8_SCHED; PG8_LDA(At, 1, 0); PG8_STAGE(PG8_SA(0, 1), a2 + hstepA, voffA);
            PG8_WAIT_L(8); PG8_BAR; PG8_WAIT_L(0); PG8_MMA(0, 0, At, B0); PG8_BAR; PG8_SCHED;
            PG8_LDB(B1, 1, 1); PG8_STAGE(PG8_SB(1, 0), b3, voffB);
            PG8_BAR; PG8_WAIT_L(0); PG8_MMA(0, 1, At, B1); PG8_BAR;
            PG8_LDA(At, 1, 1); PG8_STAGE(PG8_SA(1, 0), a3, voffA);
            PG8_BAR; PG8_WAIT_L(0); PG8_MMA(1, 0, At, B0); PG8_BAR; PG8_SCHED;
            PG8_STAGE(PG8_SB(1, 1), b3 + hstep, voffB);
            PG8_WAIT_V(6); PG8_BAR; PG8_MMA(1, 1, At, B1); PG8_BAR;
            }
        }
        if constexpr (ALIGN_EPI) { if (wr == 0) PG8_BAR; }
        if constexpr (!Epi::AFTER_DRAIN) { E(acc, cur, wr, wc, fr, fq); S.done(cur); }
        if (!has_next) break;
#pragma unroll
        for (int a = 0; a < 2; ++a)
#pragma unroll
            for (int b = 0; b < 2; ++b)
#pragma unroll
                for (int m = 0; m < 4; ++m)
#pragma unroll
                    for (int n = 0; n < 2; ++n) acc[a][b][m][n] = (f32x4){0.f, 0.f, 0.f, 0.f};
        cur = nxt; cA = nA; cB = nB; ++ui;
        if constexpr (ALIGN_EPI) { if (wr == 1) PG8_BAR; }
    }
    PG8_WAIT_V(0);
    if constexpr (!ALIGN_EPI) { if (wr == 0) PG8_BAR; }
    PG8_BAR;
    if constexpr (Epi::AFTER_DRAIN) { E.fused(acc, cur, wr, wc, fr, fq, lds, wid, lane); S.done(cur); }
#undef PG8_SA
#undef PG8_SB
#undef PG8_STAGE
#undef PG8_LDA
#undef PG8_LDB
#undef PG8_MMA
#undef PG8_WAIT_V
#undef PG8_WAIT_L
#undef PG8_BAR
#undef PG8_SCHED
}
}
constexpr int NWAVES = 8, NTHREADS = 512;
constexpr int RING_BYTES = 131072, LDS_BYTES = 147456;
struct Args { const float* in[20]; float* out; unsigned char* ws; int ph_lo, ph_hi, layer, pad; };
enum { I_X = 0, I_LN1G, I_WIN, I_FB, I_LQ1, I_LK1, I_LQ2, I_LK2, I_DNG, I_QNG, I_WUQ, I_KVNG, I_WUKV, I_WO, I_LN2G, I_WUP, I_CW, I_CB, I_WDN, I_FG };

__device__ __forceinline__ float wave_sum(float v) {
#pragma unroll
    for (int o = 1; o < 64; o <<= 1) v += __shfl_xor(v, o);
    return v;
}
struct MapIn {
    __device__ __forceinline__ int src(int n) const { return n < 768 ? n : (n < 2720 ? n + 4 : (n < 2724 ? n - 2720 + 768 : -1)); }
    __device__ __forceinline__ float scale(int n) const { return (n < 256 || (n >= H_DQ && n < H_DK)) ? 0.125f * LOG2E : 1.0f; }
};
struct MapUq {
    __device__ __forceinline__ int src(int n) const { if (n >= 384) return -1; const int h = n / 96, d = n % 96; if (d < 64) return n; const int jj = d - 64; return h * 96 + 64 + (jj >> 1) + 16 * (jj & 1); }
    __device__ __forceinline__ float scale(int) const { return 0.10206207261596577f * LOG2E; }
};
struct MapId {
    __device__ __forceinline__ int src(int n) const { return n; }
    __device__ __forceinline__ float scale(int) const { return 1.0f; }
};
struct MapUp {
    __device__ __forceinline__ int src(int n) const { return ((n >> 7) & 1) * DFF + 128 * (n >> 8) + (n & 127); }
    __device__ __forceinline__ float scale(int) const { return 1.0f; }
};
template <class Map>
__device__ __forceinline__ void wprep_item(const float* W, int ldw, int K, bf16* WT, int nblk, LAS float* scr, int item, int lane, const float* gk, const Map map) {
    const int kb = item / nblk, nb = item % nblk, k0 = 64 * kb, n0 = 32 * nb;
    const int nd = n0 + (lane & 31), sc = map.src(nd); const float cs = map.scale(nd);
#pragma unroll 8
    for (int i = 0; i < 32; ++i) { const int kk = 2 * i + (lane >> 5); float v = (sc >= 0) ? W[(size_t)(k0 + kk) * ldw + sc] : 0.f; if (gk) v *= gk[k0 + kk]; scr[kk * 33 + (lane & 31)] = v * cs; }
    asm volatile("s_waitcnt lgkmcnt(0)" ::: "memory");
    const int c = lane & 7;
#pragma unroll
    for (int j = 0; j < 4; ++j) { const int n = (lane >> 3) + 8 * j; const LAS float* s = scr + (8 * c) * 33 + n;
        v4u o; o.x = pk2(s[0 * 33], s[1 * 33]); o.y = pk2(s[2 * 33], s[3 * 33]); o.z = pk2(s[4 * 33], s[5 * 33]); o.w = pk2(s[6 * 33], s[7 * 33]);
        *(v4u*)(WT + (size_t)(n0 + n) * K + k0 + 8 * c) = o; }
    asm volatile("s_waitcnt lgkmcnt(0)" ::: "memory");
}
__device__ __forceinline__ void xprep_row(const float* xrow, bf16* orow, float* rstd, int lane) {
    const float4* xr = (const float4*)xrow + lane;
    float4 v[4]; float s = 0.f;
#pragma unroll
    for (int j = 0; j < 4; ++j) { v[j] = xr[64 * j]; s += (v[j].x * v[j].x + v[j].y * v[j].y) + (v[j].z * v[j].z + v[j].w * v[j].w); }
    s = wave_sum(s);
    if (lane == 0) *rstd = s;
    v2u* o8 = (v2u*)orow + lane;
#pragma unroll
    for (int j = 0; j < 4; ++j) { v2u w; w.x = pk2(v[j].x, v[j].y); w.y = pk2(v[j].z, v[j].w); o8[64 * j] = w; }
}
__device__ __forceinline__ void p0_prologue(const __attribute__((address_space(4))) Args* ap_, LAS unsigned char* lds, int gw, int ngw, int lane, int wave) {
    LAS float* scr = (LAS float*)(lds + wave * 16384);
    unsigned char* ws = ap_->ws;
    constexpr int I_IN = 16 * 88, I_UQ = 4 * 16, I_UKV = 2 * 16, I_O = 16 * 32, I_UP = 16 * 176, I_DN = 44 * 32, I_L = I_IN + I_UQ + I_UKV + I_O + I_UP + I_DN;
    for (int it = gw; it < 2 * I_L; it += ngw) {
        const int l = it / I_L; int r = it % I_L;
        unsigned char* wl = ws + WS_W + (size_t)l * WS_WL;
        if (r < I_IN) { wprep_item(ap_->in[I_WIN] + (size_t)l * DM * IN_COLS, IN_COLS, DM, (bf16*)(wl + W_IN), 88, scr, r, lane, ap_->in[I_LN1G] + l * DM, MapIn()); continue; } r -= I_IN;
        if (r < I_UQ) { wprep_item(ap_->in[I_WUQ] + (size_t)l * 256 * 384, 384, 256, (bf16*)(wl + W_UQ), 16, scr, r, lane, ap_->in[I_QNG] + l * 256, MapUq()); continue; } r -= I_UQ;
        if (r < I_UKV) { wprep_item(ap_->in[I_WUKV] + (size_t)l * 128 * 512, 512, 128, (bf16*)(wl + W_UKV), 16, scr, r, lane, ap_->in[I_KVNG] + l * 128, MapId()); continue; } r -= I_UKV;
        if (r < I_O) { wprep_item(ap_->in[I_WO] + (size_t)l * DM * DM, DM, DM, (bf16*)(wl + W_O), 32, scr, r, lane, (const float*)nullptr, MapId()); continue; } r -= I_O;
        if (r < I_UP) { wprep_item(ap_->in[I_WUP] + (size_t)l * DM * NUP, NUP, DM, (bf16*)(wl + W_UP), 176, scr, r, lane, ap_->in[I_LN2G] + l * DM, MapUp()); continue; } r -= I_UP;
        wprep_item(ap_->in[I_WDN] + (size_t)l * DFF * DM, DM, DFF, (bf16*)(wl + W_DN), 32, scr, r, lane, (const float*)nullptr, MapId());
    }
    float* rstd1 = (float*)(ws + WS_SM + SM_RSTD1);
    for (int m = gw; m < MTOK; m += ngw) xprep_row(ap_->in[I_X] + (size_t)m * DM, (bf16*)(ws + WS_XB) + (size_t)m * DM, rstd1 + m, lane);
    float* z = (float*)(ws + WS_SM + SM_ZERO_BEG); const int nz = (int)((SM_ZERO_END - SM_ZERO_BEG) / 4);
    for (int i = gw * 64 + lane; i < nz; i += ngw * 64) z[i] = 0.f;
}
namespace pg8 {
__device__ __forceinline__ u32x4 pack8(const f32x4 v0, const f32x4 v1) { u32x4 w; w.x = cvt_pk_bf16(v0[0], v0[1]); w.y = cvt_pk_bf16(v0[2], v0[3]); w.z = cvt_pk_bf16(v1[0], v1[1]); w.w = cvt_pk_bf16(v1[2], v1[3]); return w; }
__device__ __forceinline__ float sq8(const f32x4 a, const f32x4 b) { return (a[0] * a[0] + a[1] * a[1]) + (a[2] * a[2] + a[3] * a[3]) + (b[0] * b[0] + b[1] * b[1]) + (b[2] * b[2] + b[3] * b[3]); }
__device__ __forceinline__ float log_sigmoid_d(float z) { return fminf(z, 0.f) - 0.6931471805599453f * __builtin_amdgcn_logf(1.0f + __builtin_amdgcn_exp2f(-1.4426950408889634f * fabsf(z))); }
struct EpiH {
    static constexpr bool PERM = true, AFTER_DRAIN = false;
    unsigned char* ws; const float* fb; int l;
    __device__ __forceinline__ void operator()(const f32x4 (&acc)[2][2][4][2], const Unit& u, int wr, int wc, int fr, int fq) const {
        { int t_ = threadIdx.x; asm volatile("" : "+v"(t_)); fr = t_ & 15; fq = (t_ >> 4) & 3; const int w_ = __builtin_amdgcn_readfirstlane(t_ >> 6); wr = w_ >> 2; wc = w_ & 3; }
        bf16_t* Hb = (bf16_t*)(ws + WS_HB); float* sm = (float*)(ws + WS_SM);
        const float* ssin = l == 0 ? sm + SM_RSTD1 / 4 : sm + SM_SS1N / 4 + (l - 1) * MTOK;
        float* logf = sm + SM_LOGF / 4; float* ssq = sm + SM_SSQ / 4 + l * MTOK; float* sskv = sm + SM_SSKV / 4 + l * MTOK;
        const int row0 = u.pm * BM + wr * 64 + fr, colw = wc * 32 + 8 * fq;
#pragma unroll
        for (int ai = 0; ai < 2; ++ai)
#pragma unroll
            for (int m = 0; m < 4; ++m) {
                const int row = row0 + ai * HALF + m * 16; const float rs = __builtin_amdgcn_rsqf(ssin[row] * (1.0f / DM) + EPS);
                float s = 0.f;
#pragma unroll
                for (int bj = 0; bj < 2; ++bj) {
                    const f32x4 v0 = acc[ai][bj][m][0] * rs, v1 = acc[ai][bj][m][1] * rs;
                    *(u32x4*)(Hb + (size_t)row * HN + u.pn * BM + bj * HALF + colw) = pack8(v0, v1);
                    if (u.pn == 9 || (u.pn == 10 && bj == 0)) s += sq8(v0, v1);
                    if (u.pn == 10 && bj == 1 && wc == 1 && fq == 0) { f32x4 lf; lf[0] = log_sigmoid_d(v0[0] + fb[0]); lf[1] = log_sigmoid_d(v0[1] + fb[1]); lf[2] = log_sigmoid_d(v0[2] + fb[2]); lf[3] = log_sigmoid_d(v0[3] + fb[3]); *(f32x4*)(logf + (size_t)row * 4) = lf; }
                }
                if (u.pn == 9 || u.pn == 10) { s += __shfl_xor(s, 16); s += __shfl_xor(s, 32); if (fq == 0) atomicAdd((u.pn == 9 ? ssq : sskv) + row, s); }
                asm volatile("" ::: "memory");
            }
    }
};
struct EpiQ {
    static constexpr bool PERM = true, AFTER_DRAIN = false;
    bf16_t* QM; const float* ssq; const float2* rope;
    __device__ __forceinline__ void operator()(const f32x4 (&acc)[2][2][4][2], const Unit& u, int wr, int wc, int fr, int fq) const {
        { int t_ = threadIdx.x; asm volatile("" : "+v"(t_)); fr = t_ & 15; fq = (t_ >> 4) & 3; const int w_ = __builtin_amdgcn_readfirstlane(t_ >> 6); wr = w_ >> 2; wc = w_ & 3; }
        const int row0 = u.pm * BM + wr * 64 + fr, colw = wc * 32 + 8 * fq;
#pragma unroll
        for (int ai = 0; ai < 2; ++ai)
#pragma unroll
            for (int m = 0; m < 4; ++m) {
                const int row = row0 + ai * HALF + m * 16; const float rs = __builtin_amdgcn_rsqf(ssq[row] * (1.0f / 256.0f) + EPS);
                const float2* rt = rope + (size_t)(row & (SEQ - 1)) * 16;
#pragma unroll
                for (int bj = 0; bj < 2; ++bj) {
                    const int col = u.pn * BM + bj * HALF + colw;
                    if (col < 384) {
                        f32x4 v0 = acc[ai][bj][m][0] * rs, v1 = acc[ai][bj][m][1] * rs;
                        const int d = col % 96;
                        if (d >= 64) { const int j0 = (d - 64) >> 1; const float2 c0 = rt[j0], c1 = rt[j0 + 1], c2 = rt[j0 + 2], c3 = rt[j0 + 3];
                            f32x4 r0, r1;
                            r0[0] = v0[0] * c0.x - v0[1] * c0.y; r0[1] = v0[0] * c0.y + v0[1] * c0.x; r0[2] = v0[2] * c1.x - v0[3] * c1.y; r0[3] = v0[2] * c1.y + v0[3] * c1.x;
                            r1[0] = v1[0] * c2.x - v1[1] * c2.y; r1[1] = v1[0] * c2.y + v1[1] * c2.x; r1[2] = v1[2] * c3.x - v1[3] * c3.y; r1[3] = v1[2] * c3.y + v1[3] * c3.x;
                            v0 = r0; v1 = r1; }
                        *(u32x4*)(QM + (size_t)row * 384 + col) = pack8(v0, v1);
                    }
                }
                asm volatile("" ::: "memory");
            }
    }
};
struct EpiKV {
    static constexpr bool PERM = true, AFTER_DRAIN = false;
    bf16_t* KVM; const float* sskv;
    __device__ __forceinline__ void operator()(const f32x4 (&acc)[2][2][4][2], const Unit& u, int wr, int wc, int fr, int fq) const {
        { int t_ = threadIdx.x; asm volatile("" : "+v"(t_)); fr = t_ & 15; fq = (t_ >> 4) & 3; const int w_ = __builtin_amdgcn_readfirstlane(t_ >> 6); wr = w_ >> 2; wc = w_ & 3; }
        const int row0 = u.pm * BM + wr * 64 + fr, colw = wc * 32 + 8 * fq;
#pragma unroll
        for (int ai = 0; ai < 2; ++ai)
#pragma unroll
            for (int m = 0; m < 4; ++m) {
                const int row = row0 + ai * HALF + m * 16; const float rs = __builtin_amdgcn_rsqf(sskv[row] * (1.0f / 128.0f) + EPS);
#pragma unroll
                for (int bj = 0; bj < 2; ++bj) *(u32x4*)(KVM + (size_t)row * 512 + u.pn * BM + bj * HALF + colw) = pack8(acc[ai][bj][m][0] * rs, acc[ai][bj][m][1] * rs);
                asm volatile("" ::: "memory");
            }
    }
};
struct EpiRes {
    static constexpr bool PERM = true, AFTER_DRAIN = false;
    const float* xold; float* xnew; bf16_t* xb; float* ss;
    __device__ __forceinline__ void operator()(const f32x4 (&acc)[2][2][4][2], const Unit& u, int wr, int wc, int fr, int fq) const {
        { int t_ = threadIdx.x; asm volatile("" : "+v"(t_)); fr = t_ & 15; fq = (t_ >> 4) & 3; const int w_ = __builtin_amdgcn_readfirstlane(t_ >> 6); wr = w_ >> 2; wc = w_ & 3; }
        const int row0 = u.pm * BM + wr * 64 + fr, colw = wc * 32 + 8 * fq;
#pragma unroll
        for (int ai = 0; ai < 2; ++ai)
#pragma unroll
            for (int m = 0; m < 4; ++m) {
                const int row = row0 + ai * HALF + m * 16; float s = 0.f;
#pragma unroll
                for (int bj = 0; bj < 2; ++bj) {
                    const size_t off = (size_t)row * DM + u.pn * BM + bj * HALF + colw;
                    const f32x4 v0 = *(const f32x4*)(xold + off) + acc[ai][bj][m][0], v1 = *(const f32x4*)(xold + off + 4) + acc[ai][bj][m][1];
                    *(f32x4*)(xnew + off) = v0; *(f32x4*)(xnew + off + 4) = v1; *(u32x4*)(xb + off) = pack8(v0, v1);
                    s += sq8(v0, v1);
                }
                s += __shfl_xor(s, 16); s += __shfl_xor(s, 32); if (fq == 0) atomicAdd(ss + row, s);
                asm volatile("" ::: "memory");
            }
    }
};
struct HalfOrder {
    int nN, nwg, G2, c2; bool active;
    __device__ void init(int M, int N, int G, int c, int half) { nN = N / BM; nwg = (M / BM) * nN; G2 = G / 2; active = (c / G2) == half; c2 = c % G2; }
    __device__ bool next(int i, Unit& u) const { if (!active) return false; const int L = i * G2 + c2; if (L >= nwg) return false; u.pm = L / nN; u.pn = L % nN; return true; }
    __device__ __forceinline__ int arow(const Unit& u) const { return u.pm * BM; }
    __device__ __forceinline__ int arperm(int R) const { return R; }
    __device__ __forceinline__ int ahalf() const { return HALF; }
    __device__ __forceinline__ void a_ready(const Unit&) const {}
    __device__ __forceinline__ void done(const Unit&) const {}
};
constexpr int UP_TILES_PER_B = 33, UP_NM = 2 * UP_TILES_PER_B, UP_NN = NUP / 256;
__device__ __forceinline__ int up_tile_start(int pm) { const int b = pm / UP_TILES_PER_B, i = pm % UP_TILES_PER_B; int s = 252 * i; s = s > SEQ - 254 ? SEQ - 254 : s; return b * SEQ + s; }
struct UpOrder : StaticOrder {
    __device__ void init_up(int G_, int c_) { nM = UP_NM; nN = UP_NN; nwg = nM * nN; G = G_; c = c_; }
    __device__ __forceinline__ int arow(const Unit& u) const { return up_tile_start(u.pm); }
    __device__ __forceinline__ int arperm(int R) const { return R < 64 ? R : R + 62; }
    __device__ __forceinline__ int ahalf() const { return 64; }
};
template <int CTRL> __device__ __forceinline__ float dppz(float src) {
    return __builtin_bit_cast(float, __builtin_amdgcn_update_dpp(0, __builtin_bit_cast(int, src), CTRL, 0xf, 0xf, false));
}
struct EpiUp {
    static constexpr bool PERM = true, AFTER_DRAIN = false;
    unsigned char* ws; const float* cw; const float* cb; int l;
    __device__ __forceinline__ void operator()(f32x4 (&acc)[2][2][4][2], const Unit& u, int wr, int wc, int fr, int fq) const {
        { int t_ = threadIdx.x; asm volatile("" : "+v"(t_)); fr = t_ & 15; fq = (t_ >> 4) & 3; const int w_ = __builtin_amdgcn_readfirstlane(t_ >> 6); wr = w_ >> 2; wc = w_ & 3; }
        const float* ss2 = (const float*)(ws + WS_SM) + SM_SS2 / 4 + l * MTOK; bf16_t* act = (bf16_t*)(ws + WS_HB);
        const int t0 = up_tile_start(u.pm) + 126 * wr + fr;
        const bool keep_head = (u.pm % UP_TILES_PER_B) == 0 && wr == 0;
#pragma unroll
        for (int ai = 0; ai < 2; ++ai)
#pragma unroll
            for (int m = 0; m < 4; ++m) { const float rs = __builtin_amdgcn_rsqf(ss2[t0 + ai * 64 + m * 16] * (1.0f / DM) + EPS);
#pragma unroll
                for (int bj = 0; bj < 2; ++bj) { acc[ai][bj][m][0] *= rs; acc[ai][bj][m][1] *= rs; } }
        const int cg0 = u.pn * 128 + wc * 32 + 8 * fq;
#pragma unroll
        for (int n = 0; n < 2; ++n) {
            const int cg = cg0 + 4 * n;
            const f32x4 wg0 = *(const f32x4*)(cw + cg), wg1 = *(const f32x4*)(cw + NUP + cg), wg2 = *(const f32x4*)(cw + 2 * NUP + cg), bg = *(const f32x4*)(cb + cg);
            const f32x4 wu0 = *(const f32x4*)(cw + DFF + cg), wu1 = *(const f32x4*)(cw + NUP + DFF + cg), wu2 = *(const f32x4*)(cw + 2 * NUP + DFF + cg), bu = *(const f32x4*)(cb + DFF + cg);
#pragma unroll
            for (int ai = 0; ai < 2; ++ai)
#pragma unroll
                for (int m = 0; m < 4; ++m) {
                    const f32x4 xg = acc[ai][0][m][n], xu = acc[ai][1][m][n];
                    f32x4 pg, pu;
                    if (m > 0) { pg = acc[ai][0][m - 1][n]; pu = acc[ai][1][m - 1][n]; }
                    else if (ai > 0) { pg = acc[0][0][3][n]; pu = acc[0][1][3][n]; }
                    else { pg = (f32x4){0.f, 0.f, 0.f, 0.f}; pu = pg; }
                    float a[4];
#pragma unroll
                    for (int c = 0; c < 4; ++c) {
                        const float g1 = dppz<0x111>(xg[c]) + dppz<0x10F>(pg[c]), g2 = dppz<0x112>(xg[c]) + dppz<0x10E>(pg[c]);
                        const float u1 = dppz<0x111>(xu[c]) + dppz<0x10F>(pu[c]), u2 = dppz<0x112>(xu[c]) + dppz<0x10E>(pu[c]);
                        const float G = bg[c] + wg2[c] * xg[c] + wg1[c] * g1 + wg0[c] * g2;
                        const float U = bu[c] + wu2[c] * xu[c] + wu1[c] * u1 + wu0[c] * u2;
                        a[c] = G * __builtin_amdgcn_rcpf(1.0f + __builtin_amdgcn_exp2f(-1.4426950408889634f * G)) * U;
                    }
                    typedef unsigned u32x2 __attribute__((ext_vector_type(2)));
                    u32x2 w; w.x = cvt_pk_bf16(a[0], a[1]); w.y = cvt_pk_bf16(a[2], a[3]);
                    const bool halo = (ai == 0 && m == 0 && fr < 2 && !keep_head);
                    if (!halo) *(u32x2*)(act + (size_t)(t0 + ai * 64 + m * 16) * DFF + cg) = w;
                }
            asm volatile("" ::: "memory");
        }
    }
};
}
namespace att {
typedef short bf16x8 __attribute__((ext_vector_type(8)));
typedef short s16x4 __attribute__((ext_vector_type(4)));
typedef float f32x4 __attribute__((ext_vector_type(4)));
constexpr int ST_K = 0, ST_V = 16384, ST_CK = 32768, ST_BYTES = 33280;
constexpr float THR = 8.0f;
constexpr float MASKV = -1.0e30f;
constexpr int N_FOX = 256, N_MLA = 256, N_DIFF = 512, N_ITEMS = N_FOX + N_MLA + N_DIFF;

__device__ __forceinline__ s16x4 vtr(LAS const unsigned char* p) { typedef short v4i16_t __attribute__((ext_vector_type(4))); return __builtin_bit_cast(s16x4, __builtin_amdgcn_ds_read_tr16_b64_v4i16((LAS v4i16_t*)p)); }
__device__ __forceinline__ unsigned cvtpk(float lo, float hi) { typedef float f32x2_t __attribute__((ext_vector_type(2))); typedef __bf16 bf16x2_t __attribute__((ext_vector_type(2))); f32x2_t v = {lo, hi}; bf16x2_t b = __builtin_convertvector(v, bf16x2_t); return __builtin_bit_cast(unsigned, b); }
__device__ __forceinline__ float max3f(float a, float b, float c) { return __builtin_fmaxf(__builtin_fmaxf(a, b), c); }
__device__ __forceinline__ float halfmax(float v) { auto rr = __builtin_amdgcn_permlane32_swap(__float_as_uint(v), __float_as_uint(v), false, false); return __builtin_fmaxf(__uint_as_float(rr[0]), __uint_as_float(rr[1])); }
__device__ __forceinline__ float halfsum(float v) { auto rr = __builtin_amdgcn_permlane32_swap(__float_as_uint(v), __float_as_uint(v), false, false); return __uint_as_float(rr[0]) + __uint_as_float(rr[1]); }

__device__ __forceinline__ int item_cost(int type, int qb) { return (type == 0 ? 64 : (type == 1 ? 48 : 80)) * (qb + 1); }
__device__ __forceinline__ int n_gt(int a, int n, int c) { const int f = c / a; return 8 * (n - (f < n ? f : n)); }
__device__ __forceinline__ int n_eq(int a, int n, int c) { return (c % a == 0 && c / a >= 1 && c / a <= n) ? 8 : 0; }
__device__ __forceinline__ void build_items(int* list, int gtid, int ngt) {
    for (int i = gtid; i < N_ITEMS; i += ngt) {
        int type, rem;
        if (i < N_FOX) { type = 0; rem = i; } else if (i < N_FOX + N_DIFF) { type = 1; rem = i - N_FOX; } else { type = 2; rem = i - N_FOX - N_DIFF; }
        const int nq = type == 1 ? 64 : 32; const int bh = rem / nq, qb = rem % nq;
        const int c = item_cost(type, qb);
        int rank = n_gt(64, 32, c) + n_gt(48, 64, c) + n_gt(80, 32, c);
        if (type > 0) rank += n_eq(64, 32, c);
        if (type > 1) rank += n_eq(48, 64, c);
        rank += bh;
        list[rank] = type | (rem << 2);
    }
}

struct Params { const bf16* HB; const bf16* QM; const bf16* KVM; const bf16* KR; bf16* AO; const float* cum; const float* lq1; const float* lk1; const float* lq2; const float* lk2; const float* dng; float lam_init; int pad; };

template <int MODE>
__device__ __forceinline__ void attn_unit(const Params& P, LAS unsigned char* lds, const int b, const int head, const int qblk) {
    constexpr int DK = MODE == 2 ? 96 : 64, DV = MODE == 1 ? 128 : 64, NS = DK / 16, NDB = DV / 32;
    constexpr int KPITCH = MODE == 2 ? 256 : 128, VPITCH = DV * 2;
    int tid = threadIdx.x; asm volatile("" : "+v"(tid));
    const int lane = tid & 63, wave = __builtin_amdgcn_readfirstlane(tid >> 6), r = lane & 31, h = lane >> 5;
    const size_t rb = (size_t)b * SEQ;
    const int wq = MODE == 1 ? (wave & 3) : wave;
    const int map = MODE == 1 ? (wave >> 2) : 0;
    const int q0 = (MODE == 1 ? 128 : 256) * qblk, qrow = q0 + 32 * wq;
    const int NT = (MODE == 1 ? 2 : 4) * qblk + (MODE == 1 ? 2 : 4);
    const int jv = (MODE == 1 ? 2 : 4) * qblk + (wq >> 1);
    const bf16 *Qp, *Kp, *K2p = nullptr, *Vp; int qpitch, kpitch, vpitch; bf16* Op;
    if (MODE == 0) { Qp = P.HB + H_FQ + head * 64; Kp = P.HB + H_FK + head * 64; Vp = P.HB + H_FV + head * 64; qpitch = kpitch = vpitch = HN; Op = P.AO + head * 64; }
    else if (MODE == 1) { Qp = P.HB + H_DQ + head * 128 + map * 64; Kp = P.HB + H_DK + head * 128; Vp = P.HB + H_DV + head * 128; qpitch = kpitch = vpitch = HN; Op = P.AO + 256 + head * 128; }
    else { Qp = P.QM + head * 96; Kp = P.KVM + head * 128; K2p = P.KR; Vp = P.KVM + head * 128 + 64; qpitch = 384; kpitch = vpitch = 512; Op = P.AO + 768 + head * 64; }
    bf16x8 qf[NS];
#pragma unroll
    for (int s = 0; s < NS; ++s) qf[s] = *(const bf16x8*)(Qp + (rb + qrow + r) * qpitch + 16 * s + 8 * h);
    v4u kreg0, kreg1, vreg0, vreg1; f32x4 ckreg;
    kreg1 = (v4u){0u, 0u, 0u, 0u}; vreg1 = kreg1; ckreg = (f32x4){0.f, 0.f, 0.f, 0.f};
    const int skey = tid >> 3, sc = tid & 7;
    unsigned kw0, kw1 = 0, vw0, vw1 = 0;
    if (MODE == 2) { kw0 = ST_K + skey * 256 + ((sc ^ (skey & 15)) << 4); const int k2 = tid >> 2, c2 = 8 + (tid & 3); kw1 = ST_K + k2 * 256 + ((c2 ^ (k2 & 15)) << 4); }
    else { kw0 = ST_K + skey * 128 + ((sc ^ ((skey >> 1) & 7)) << 4); kw1 = kw0 + 8192; }
    if (DV == 64) vw0 = ST_V + skey * 128 + ((((sc >> 2) ^ ((skey >> 1) & 1))) << 6) + ((sc & 3) << 4);
    else { const int k0_ = tid >> 4, c0_ = tid & 15; vw0 = ST_V + k0_ * 256 + ((((c0_ >> 2) ^ (k0_ & 3))) << 6) + ((c0_ & 3) << 4); const int k1_ = k0_ + 32; vw1 = ST_V + k1_ * 256 + ((((c0_ >> 2) ^ (k1_ & 3))) << 6) + ((c0_ & 3) << 4); }
    const float cref = (MODE == 0) ? P.cum[(rb + q0) * 4 + head] : 0.f;
#define ATT_LOAD(j) do { const size_t kr_ = rb + (size_t)(j) * 64; \
        if (MODE == 2) { kreg0 = *(const v4u*)(Kp + (kr_ + skey) * kpitch + sc * 8); if (tid < 256) kreg1 = *(const v4u*)(K2p + (kr_ + (tid >> 2)) * 32 + (tid & 3) * 8); } \
        else { kreg0 = *(const v4u*)(Kp + (kr_ + skey) * kpitch + sc * 8); if (MODE == 1) kreg1 = *(const v4u*)(Kp + 64 + (kr_ + skey) * kpitch + sc * 8); } \
        if (DV == 64) vreg0 = *(const v4u*)(Vp + (kr_ + skey) * vpitch + sc * 8); \
        else { vreg0 = *(const v4u*)(Vp + (kr_ + (tid >> 4)) * vpitch + (tid & 15) * 8); vreg1 = *(const v4u*)(Vp + (kr_ + 32 + (tid >> 4)) * vpitch + (tid & 15) * 8); } \
        if (MODE == 0 && tid < 16) { const float* cp_ = P.cum + (kr_ + tid * 4) * 4 + head; ckreg = (f32x4){cref - cp_[0], cref - cp_[4], cref - cp_[8], cref - cp_[12]}; } } while (0)
#define ATT_WRITE(st) do { LAS unsigned char* sb_ = lds + (st) * ST_BYTES; \
        *(LAS v4u*)(sb_ + kw0) = kreg0; if (MODE == 1 || (MODE == 2 && tid < 256)) *(LAS v4u*)(sb_ + kw1) = kreg1; \
        *(LAS v4u*)(sb_ + vw0) = vreg0; if (DV == 128) *(LAS v4u*)(sb_ + vw1) = vreg1; \
        if (MODE == 0 && tid < 16) *(LAS f32x4*)(sb_ + ST_CK + tid * 16) = ckreg; } while (0)
    unsigned ka[NS];
#pragma unroll
    for (int s = 0; s < NS; ++s) ka[s] = ST_K + (MODE == 1 ? map * 8192 : 0) + r * KPITCH + (MODE == 2 ? (((2 * s + h) ^ (r & 15)) << 4) : (((2 * s + h) ^ ((r >> 1) & 7)) << 4));
    unsigned va[NDB];
    { const int qp = (lane & 15) >> 2, kb_ = 4 * h + qp, dby = 32 * ((lane >> 4) & 1) + 8 * (lane & 3);
#pragma unroll
      for (int d = 0; d < NDB; ++d) va[d] = ST_V + kb_ * VPITCH + (DV == 64 ? ((d ^ ((qp >> 1) & 1)) << 6) : ((d ^ qp) << 6)) + dby; }
    f32x16 o[NDB];
#pragma unroll
    for (int d = 0; d < NDB; ++d)
#pragma unroll
        for (int i = 0; i < 16; ++i) o[d][i] = 0.f;
    float m_run = MASKV, l_run = 0.f;
    const float slope2 = (MODE == 1) ? exp2f(-2.0f * (float)(head + 1)) * LOG2E : 0.f;
    ATT_LOAD(0); ATT_WRITE(0);
    __syncthreads();
    for (int j = 0; j < NT; ++j) {
        if (j + 1 < NT) ATT_LOAD(j + 1);
        if (j <= jv) {
            LAS const unsigned char* sb = lds + (j & 1) * ST_BYTES;
            f32x16 p0, p1;
            if (MODE == 0) {
#pragma unroll
                for (int g = 0; g < 4; ++g) { const f32x4 c0 = *(LAS const f32x4*)(sb + ST_CK + 16 * h + 32 * g), c1 = *(LAS const f32x4*)(sb + ST_CK + 128 + 16 * h + 32 * g);
#pragma unroll
                    for (int i = 0; i < 4; ++i) { p0[4 * g + i] = c0[i]; p1[4 * g + i] = c1[i]; } }
            } else if (MODE == 1) {
                const float tb = slope2 * (float)(64 * j + 4 * h - (qrow + r));
#pragma unroll
                for (int i = 0; i < 16; ++i) { p0[i] = tb + slope2 * (float)((i & 3) + 8 * (i >> 2)); p1[i] = p0[i] + 32.0f * slope2; }
            } else {
#pragma unroll
                for (int i = 0; i < 16; ++i) { p0[i] = 0.f; p1[i] = 0.f; }
            }
            f32x16 c0s, c1s;
            if (MODE == 1) { c0s = p0; c1s = p1; }
#pragma unroll
            for (int s = 0; s < NS; ++s) {
                const bf16x8 k0 = *(LAS const bf16x8*)(sb + ka[s]), k1 = *(LAS const bf16x8*)(sb + ka[s] + 32 * KPITCH);
                p0 = __builtin_amdgcn_mfma_f32_32x32x16_bf16(k0, qf[s], p0, 0, 0, 0);
                p1 = __builtin_amdgcn_mfma_f32_32x32x16_bf16(k1, qf[s], p1, 0, 0, 0);
            }
            if (j == jv) {
                if (MODE == 0) {
                    const int qrel = (qrow + r) - 64 * j - 4 * h;
#pragma unroll
                    for (int i = 0; i < 16; ++i) { const int kr_ = (i & 3) + 8 * (i >> 2); if (kr_ > qrel) p0[i] = MASKV; if (kr_ + 32 > qrel) p1[i] = MASKV; }
                } else if (MODE == 1) {
#pragma unroll
                    for (int i = 0; i < 16; ++i) { p0[i] -= 2.0f * __builtin_fmaxf(c0s[i], 0.f); p1[i] -= 2.0f * __builtin_fmaxf(c1s[i], 0.f); }
                }
            }
            float tm;
            { float a = max3f(p0[0], p0[1], p1[0]), bq = max3f(p0[2], p0[3], p1[1]); a = max3f(a, p1[2], p1[3]);
#pragma unroll
              for (int i = 4; i < 16; i += 4) { a = max3f(a, p0[i], p0[i + 1]); bq = max3f(bq, p0[i + 2], p0[i + 3]); a = max3f(a, p1[i], p1[i + 1]); bq = max3f(bq, p1[i + 2], p1[i + 3]); }
              tm = halfmax(__builtin_fmaxf(a, bq)); }
            if (__any(tm > m_run + THR)) {
                const float mn = __builtin_fmaxf(m_run, tm), al = __builtin_amdgcn_exp2f(m_run - mn);
                m_run = mn; l_run *= al;
#pragma unroll
                for (int d = 0; d < NDB; ++d)
#pragma unroll
                    for (int i = 0; i < 16; ++i) o[d][i] *= al;
            }
            float ls = 0.f;
#pragma unroll
            for (int i = 0; i < 16; ++i) { p0[i] = __builtin_amdgcn_exp2f(p0[i] - m_run); p1[i] = __builtin_amdgcn_exp2f(p1[i] - m_run); ls += p0[i] + p1[i]; }
            l_run += ls;
            bf16x8 pf[4];
#pragma unroll
            for (int t = 0; t < 2; ++t) {
                v4u w0, w1;
                w0.x = cvtpk(p0[8 * t + 0], p0[8 * t + 1]); w0.y = cvtpk(p0[8 * t + 2], p0[8 * t + 3]); w0.z = cvtpk(p0[8 * t + 4], p0[8 * t + 5]); w0.w = cvtpk(p0[8 * t + 6], p0[8 * t + 7]);
                w1.x = cvtpk(p1[8 * t + 0], p1[8 * t + 1]); w1.y = cvtpk(p1[8 * t + 2], p1[8 * t + 3]); w1.z = cvtpk(p1[8 * t + 4], p1[8 * t + 5]); w1.w = cvtpk(p1[8 * t + 6], p1[8 * t + 7]);
                pf[t] = __builtin_bit_cast(bf16x8, w0); pf[2 + t] = __builtin_bit_cast(bf16x8, w1);
            }
#pragma unroll
            for (int d = 0; d < NDB; ++d)
#pragma unroll
                for (int ks = 0; ks < 4; ++ks) {
                    const s16x4 lo = vtr(sb + va[d] + ks * 16 * VPITCH), hi = vtr(sb + va[d] + ks * 16 * VPITCH + 8 * VPITCH);
                    const bf16x8 vf = (bf16x8){lo[0], lo[1], lo[2], lo[3], hi[0], hi[1], hi[2], hi[3]};
                    o[d] = __builtin_amdgcn_mfma_f32_32x32x16_bf16(vf, pf[ks], o[d], 0, 0, 0);
                }
        }
        if (j + 1 < NT) ATT_WRITE((j + 1) & 1);
        __syncthreads();
    }
#undef ATT_LOAD
#undef ATT_WRITE
    const float linv = 1.0f / halfsum(l_run);
    if (MODE != 1) {
        bf16* orow = Op + (rb + qrow + r) * DM + 4 * h;
#pragma unroll
        for (int d = 0; d < NDB; ++d)
#pragma unroll
            for (int g = 0; g < 4; ++g) { v2u w; w.x = cvtpk(o[d][4 * g] * linv, o[d][4 * g + 1] * linv); w.y = cvtpk(o[d][4 * g + 2] * linv, o[d][4 * g + 3] * linv); *(v2u*)(orow + 32 * d + 8 * g) = w; }
    } else {
        LAS float* ex = (LAS float*)lds;
        if (map == 1) {
#pragma unroll
            for (int d = 0; d < NDB; ++d)
#pragma unroll
                for (int i = 0; i < 16; ++i) ex[((wq * 4 + d) * 16 + i) * 64 + lane] = o[d][i] * linv;
        }
        __syncthreads();
        if (map == 0) {
            float s1 = P.lq1[lane] * P.lk1[lane], s2 = P.lq2[lane] * P.lk2[lane];
            s1 = wave_sum(s1); s2 = wave_sum(s2);
            const float lam = __expf(s1) - __expf(s2) + P.lam_init;
            float ss = 0.f;
#pragma unroll
            for (int d = 0; d < NDB; ++d)
#pragma unroll
                for (int i = 0; i < 16; ++i) { o[d][i] = o[d][i] * linv - lam * ex[((wq * 4 + d) * 16 + i) * 64 + lane]; ss += o[d][i] * o[d][i]; }
            ss = halfsum(ss);
            const float rn = __builtin_amdgcn_rsqf(ss * (1.0f / 128.0f) + EPS) * (1.0f - P.lam_init);
            bf16* orow = Op + (rb + qrow + r) * DM + 4 * h;
#pragma unroll
            for (int d = 0; d < NDB; ++d)
#pragma unroll
                for (int g = 0; g < 4; ++g) { const f32x4 gg = *(const f32x4*)(P.dng + 32 * d + 8 * g + 4 * h);
                    v2u w; w.x = cvtpk(o[d][4 * g] * rn * gg[0], o[d][4 * g + 1] * rn * gg[1]); w.y = cvtpk(o[d][4 * g + 2] * rn * gg[2], o[d][4 * g + 3] * rn * gg[3]); *(v2u*)(orow + 32 * d + 8 * g) = w; }
        }
        __syncthreads();
    }
}

__device__ __forceinline__ void attn_phase(const Params& P, LAS unsigned char* lds, const int* list, int G, int c) {
    for (int rnd = 0; rnd * G < N_ITEMS; ++rnd) {
        const int idx = rnd * G + ((rnd & 1) ? (G - 1 - c) : c);
        if (idx >= N_ITEMS) break;
        const int code = list[idx], type = code & 3, rem = code >> 2;
        if (type == 0) attn_unit<0>(P, lds, (rem / 32) >> 2, (rem / 32) & 3, rem % 32);
        else if (type == 1) attn_unit<1>(P, lds, (rem / 64) >> 2, (rem / 64) & 3, rem % 64);
        else attn_unit<2>(P, lds, (rem / 32) >> 2, (rem / 32) & 3, rem % 32);
    }
}
}
#include <hip/hip_cooperative_groups.h>
namespace cg = cooperative_groups;
constexpr size_t WS_ROPE = 234 * MiB;
constexpr size_t WS_ITEMS = 235 * MiB;
constexpr size_t WS_END2 = 236 * MiB;
constexpr int PH_H = 0, PH_M = 1, PH_A = 2, PH_O = 3, PH_U = 4, PH_D = 5, PH_FINAL = 13, NPHASES = 14;

__device__ __forceinline__ void rope_cs(int t, int j, float& c, float& s) {
    const float inv = (float)(1.0 / pow(10000.0, (double)j / 16.0));
    const float ang = (float)t * inv;
    c = (float)cos((double)ang); s = (float)sin((double)ang);
}
__device__ __forceinline__ void rope_table(float2* tab, int gtid, int ngt) {
    for (int i = gtid; i < SEQ * 16; i += ngt) { float c, s; rope_cs(i >> 4, i & 15, c, s); tab[i] = make_float2(c, s); }
}
__device__ __forceinline__ void cum_scan(const float* logf, float* cum, int b, int h, LAS double* part, int tid) {
    double loc[16]; double s = 0.0;
#pragma unroll
    for (int i = 0; i < 16; ++i) { s += (double)logf[(size_t)(b * SEQ + tid * 16 + i) * 4 + h]; loc[i] = s; }
    part[tid] = s;
    __syncthreads();
    double pre = 0.0;
    for (int j = 0; j < tid; ++j) pre += part[j];
#pragma unroll
    for (int i = 0; i < 16; ++i) cum[(size_t)(b * SEQ + tid * 16 + i) * 4 + h] = (float)((pre + loc[i]) * 1.4426950408889634);
    __syncthreads();
}

#define CAS __attribute__((address_space(4)))
__global__ void __launch_bounds__(NTHREADS, 2) fwd(Args args) {
    extern __shared__ __attribute__((aligned(16))) unsigned char lds_raw[];
    LAS unsigned char* lds = (LAS unsigned char*)lds_raw;
    int lo, hi; { CAS const Args* ap0 = (CAS const Args*)__builtin_amdgcn_kernarg_segment_ptr(); lo = ap0->ph_lo; hi = ap0->ph_hi; }
#define IN(k) (lo <= (k) && (k) < hi)
#define SEAM(k) do { if (IN(k) && IN((k) + 1)) cg::this_grid().sync(); } while (0)
#define FRAME() \
    int tid = threadIdx.x; asm volatile("" : "+v"(tid)); \
    CAS const Args* ap = (CAS const Args*)__builtin_amdgcn_kernarg_segment_ptr(); asm volatile("" : "+s"(ap)); unsigned char* ws = ap->ws; \
    const int lane = tid & 63, wave = __builtin_amdgcn_readfirstlane(tid >> 6); \
    int G_ = gridDim.x, bx_ = blockIdx.x; asm volatile("" : "+s"(G_), "+s"(bx_)); const int G = __builtin_amdgcn_readfirstlane(G_), bx = __builtin_amdgcn_readfirstlane(bx_); \
    const int vcu = (G % 8 == 0) ? (bx % 8) * (G / 8) + bx / 8 : bx; \
    const int gw = vcu * NWAVES + wave, ngw = G * NWAVES; \
    float* sm = (float*)(ws + WS_SM); (void)lane; (void)gw; (void)ngw; (void)sm;
    if (IN(0)) { FRAME(); p0_prologue(ap, lds, gw, ngw, lane, wave); rope_table((float2*)(ws + WS_ROPE), gw * 64 + lane, ngw * 64); att::build_items((int*)(ws + WS_ITEMS), gw * 64 + lane, ngw * 64); }
    SEAM(0);
    for (int l = 0; l < DEPTH; ++l) {
        const int pb = 1 + 6 * l;
        if (IN(pb + PH_H)) {
            FRAME();
            unsigned char* wl = ws + WS_W + (size_t)l * WS_WL;
            pg8::Gemm g{(const bf16*)(ws + WS_XB), (const bf16*)(wl + W_IN), MTOK, HN, DM, DM}; pg8::StaticOrder S; S.init(MTOK, HN, G, bx);
            pg8::EpiH E{ws, ap->in[I_FB] + l * 4, l};
            pg8::gemm_phase<pg8::EpiH, pg8::StaticOrder, true, true>(lds, g, S, E);
        }
        SEAM(pb + PH_H);
        if (IN(pb + PH_M)) {
            { FRAME(); unsigned char* wl = ws + WS_W + (size_t)l * WS_WL;
              pg8::Gemm g{(const bf16*)(ws + WS_HB) + H_CQ, (const bf16*)(wl + W_UQ), MTOK, 512, 256, HN}; pg8::HalfOrder S; S.init(MTOK, 512, G, bx, 0);
              pg8::EpiQ E{(bf16*)(ws + WS_QM), sm + SM_SSQ / 4 + l * MTOK, (const float2*)(ws + WS_ROPE)}; pg8::gemm_phase<pg8::EpiQ, pg8::HalfOrder, true, true>(lds, g, S, E); }
            { FRAME(); unsigned char* wl = ws + WS_W + (size_t)l * WS_WL;
              pg8::Gemm g{(const bf16*)(ws + WS_HB) + H_CKV, (const bf16*)(wl + W_UKV), MTOK, 512, 128, HN}; pg8::HalfOrder S; S.init(MTOK, 512, G, bx, 1);
              pg8::EpiKV E{(bf16*)(ws + WS_KVM), sm + SM_SSKV / 4 + l * MTOK}; pg8::gemm_phase<pg8::EpiKV, pg8::HalfOrder, true, true>(lds, g, S, E); }
            { FRAME(); const bf16* HB = (const bf16*)(ws + WS_HB); bf16* KR = (bf16*)(ws + WS_KR); const float2* rope = (const float2*)(ws + WS_ROPE);
              for (int i = (gw * 64 + lane); i < MTOK * 16; i += ngw * 64) {
                const int j = i & 15, row = i >> 4; const float2 cs = rope[(size_t)(row & (SEQ - 1)) * 16 + j];
                const float x1 = bf2f(HB[(size_t)row * HN + H_KR + j]), x2 = bf2f(HB[(size_t)row * HN + H_KR + 16 + j]);
                *(unsigned*)(KR + (size_t)row * 32 + 2 * j) = pk2(x1 * cs.x - x2 * cs.y, x1 * cs.y + x2 * cs.x);
              }
              __syncthreads();
              if (bx < 8) cum_scan(sm + SM_LOGF / 4, sm + SM_CUM / 4, bx >> 2, bx & 3, (LAS double*)lds, tid); }
        }
        SEAM(pb + PH_M);
        if (IN(pb + PH_A)) {
            FRAME();
            const float lam_init = l == 0 ? 0.2f : 0.35550906759096934f;
            att::Params P{(const bf16*)(ws + WS_HB), (const bf16*)(ws + WS_QM), (const bf16*)(ws + WS_KVM), (const bf16*)(ws + WS_KR), (bf16*)(ws + WS_AO), sm + SM_CUM / 4,
                          ap->in[I_LQ1] + l * 64, ap->in[I_LK1] + l * 64, ap->in[I_LQ2] + l * 64, ap->in[I_LK2] + l * 64, ap->in[I_DNG] + l * 128, lam_init, 0};
            att::attn_phase(P, lds, (const int*)(ws + WS_ITEMS), G, vcu);
        }
        SEAM(pb + PH_A);
        if (IN(pb + PH_O)) {
            FRAME(); unsigned char* wl = ws + WS_W + (size_t)l * WS_WL;
            pg8::Gemm g{(const bf16*)(ws + WS_AO), (const bf16*)(wl + W_O), MTOK, DM, DM, DM}; pg8::StaticOrder S; S.init(MTOK, DM, G, bx);
            pg8::EpiRes E{l == 0 ? ap->in[I_X] : ap->out, ap->out, (bf16*)(ws + WS_XB), sm + SM_SS2 / 4 + l * MTOK};
            pg8::gemm_phase<pg8::EpiRes, pg8::StaticOrder, true, true>(lds, g, S, E);
        }
        SEAM(pb + PH_O);
        if (IN(pb + PH_U)) {
            FRAME(); unsigned char* wl = ws + WS_W + (size_t)l * WS_WL;
            pg8::Gemm g{(const bf16*)(ws + WS_XB), (const bf16*)(wl + W_UP), MTOK, NUP, DM, DM}; pg8::UpOrder S; S.init_up(G, bx);
            pg8::EpiUp E{ws, ap->in[I_CW] + (size_t)l * 3 * NUP, ap->in[I_CB] + (size_t)l * NUP, l};
            pg8::gemm_phase<pg8::EpiUp, pg8::UpOrder, true, true>(lds, g, S, E);
        }
        SEAM(pb + PH_U);
        if (IN(pb + PH_D)) {
            FRAME(); unsigned char* wl = ws + WS_W + (size_t)l * WS_WL;
            pg8::Gemm g{(const bf16*)(ws + WS_HB), (const bf16*)(wl + W_DN), MTOK, DM, DFF, DFF}; pg8::StaticOrder S; S.init(MTOK, DM, G, bx);
            pg8::EpiRes E{ap->out, ap->out, (bf16*)(ws + WS_XB), sm + SM_SS1N / 4 + l * MTOK};
            pg8::gemm_phase<pg8::EpiRes, pg8::StaticOrder, true, true>(lds, g, S, E);
        }
        SEAM(pb + PH_D);
    }
    if (IN(PH_FINAL)) {
        FRAME();
        const float* ss = sm + SM_SS1N / 4 + (DEPTH - 1) * MTOK; const float4* gr = (const float4*)ap->in[I_FG] + lane;
        for (int row = gw; row < MTOK; row += ngw) {
            const float r = __builtin_amdgcn_rsqf(ss[row] * (1.0f / DM) + EPS);
            float4* xr = (float4*)(ap->out + (size_t)row * DM) + lane;
#pragma unroll
            for (int j = 0; j < 4; ++j) { float4 v = xr[64 * j]; const float4 gg = gr[64 * j]; v.x *= r * gg.x; v.y *= r * gg.y; v.z *= r * gg.z; v.w *= r * gg.w; xr[64 * j] = v; }
        }
    }
#undef IN
#undef SEAM
#undef FRAME
}
#ifndef N_LAUNCHES
#define N_LAUNCHES 1
#endif
extern "C" void kernel_launch(void* const* d_in, const int* in_sizes, int n_in, void* d_out, int out_size, void* d_ws, size_t ws_size, hipStream_t stream) {
    static int grid = 0;
    if (!grid) {
        if (n_in != 20 || ws_size < WS_END2 || out_size != MTOK * DM) { fprintf(stderr, "kernel_launch: unexpected n_in %d / out_size %d / ws_size %zu\n", n_in, out_size, ws_size); grid = -1; return; }
        if (hipFuncSetAttribute((const void*)fwd, hipFuncAttributeMaxDynamicSharedMemorySize, LDS_BYTES) != hipSuccess) { fprintf(stderr, "hipFuncSetAttribute failed\n"); grid = -1; return; }
        int dev = 0, cus = 0, per_cu = 0;
        if (hipGetDevice(&dev) != hipSuccess || hipDeviceGetAttribute(&cus, hipDeviceAttributeMultiprocessorCount, dev) != hipSuccess) { grid = -1; return; }
        if (hipOccupancyMaxActiveBlocksPerMultiprocessor(&per_cu, (const void*)fwd, NTHREADS, LDS_BYTES) != hipSuccess || per_cu < 1) { fprintf(stderr, "occupancy query failed (%d)\n", per_cu); grid = -1; return; }
        grid = cus;
        if (grid != 256) fprintf(stderr, "kernel_launch: note: %d CUs\n", grid);
    }
    if (grid < 0) return;
    Args a{};
    for (int i = 0; i < 20; ++i) a.in[i] = (const float*)d_in[i];
    a.out = (float*)d_out; a.ws = (unsigned char*)d_ws;
    (void)hipMemsetAsync((unsigned char*)d_ws + WS_CTL, 0, 1 * MiB, stream);
    if (N_LAUNCHES == 1) {
        a.ph_lo = 0; a.ph_hi = NPHASES;
        void* kargs[] = {&a};
        hipError_t e = hipLaunchCooperativeKernel((const void*)fwd, dim3(grid), dim3(NTHREADS), kargs, LDS_BYTES, stream);
        if (e != hipSuccess) fprintf(stderr, "cooperative launch failed: %s (grid %d)\n", hipGetErrorString(e), grid);
    } else {
        for (int p = 0; p < NPHASES; ++p) { a.ph_lo = p; a.ph_hi = p + 1; hipLaunchKernelGGL(fwd, dim3(grid), dim3(NTHREADS), LDS_BYTES, stream, a); }
    }
}
```

```cpp
#include <hip/hip_runtime.h>
#include <cstdio>
#include <cstdint>

constexpr int BATCH = 2, SEQ = 8192, DM = 1024, DEPTH = 2, MTOK = BATCH * SEQ;
constexpr int IN_COLS = 2724, DFF = 2816, NUP = 2 * DFF;
constexpr int HN = 2816;
constexpr int H_FQ = 0, H_FK = 256, H_FV = 512, H_DQ = 768, H_DK = 1280, H_DV = 1792, H_CQ = 2304, H_CKV = 2560, H_KR = 2688, H_FF = 2720;
constexpr float EPS = 1e-6f;
constexpr float LOG2E = 1.4426950408889634f;
constexpr float NEGV = -1e30f;

constexpr size_t MiB = 1u << 20;
constexpr size_t WS_CTL = 0;
constexpr size_t WS_W = 1 * MiB, WS_WL = 25 * MiB;
constexpr size_t W_IN = 0, W_UQ = 5632 * 1024, W_UKV = W_UQ + 256 * 1024, W_O = 6 * MiB, W_UP = 8 * MiB, W_DN = 19 * MiB;
constexpr size_t WS_XB = 51 * MiB;
constexpr size_t WS_SM = 83 * MiB;
constexpr size_t SM_RSTD1 = 0;
constexpr size_t SM_SSQ = 64 * 1024, SM_SSKV = 192 * 1024, SM_SS2 = 320 * 1024, SM_SS1N = 448 * 1024;
constexpr size_t SM_LOGF = 576 * 1024, SM_CUM = 832 * 1024;
constexpr size_t SM_ZERO_BEG = SM_SSQ, SM_ZERO_END = SM_LOGF;
constexpr size_t WS_HB = 85 * MiB;
constexpr size_t WS_QM = 173 * MiB;
constexpr size_t WS_KVM = 185 * MiB;
constexpr size_t WS_KR = 201 * MiB;
constexpr size_t WS_AO = 202 * MiB;
constexpr size_t WS_END = 234 * MiB;

#define LAS __attribute__((address_space(3)))
typedef unsigned short bf16;
typedef float f32x16 __attribute__((ext_vector_type(16)));
typedef unsigned v4u __attribute__((ext_vector_type(4)));
typedef unsigned v2u __attribute__((ext_vector_type(2)));
__device__ __forceinline__ unsigned f2bf(float f) { unsigned u = __builtin_bit_cast(unsigned, f); return (u + 0x7fffu + ((u >> 16) & 1u)) >> 16; }
__device__ __forceinline__ unsigned pk2(float lo, float hi) { return f2bf(lo) | (f2bf(hi) << 16); }
__device__ __forceinline__ float bf2f(unsigned b) { return __builtin_bit_cast(float, (b & 0xffffu) << 16); }
__device__ __forceinline__ float bflo(unsigned w) { return __builtin_bit_cast(float, w << 16); }
__device__ __forceinline__ float bfhi(unsigned w) { return __builtin_bit_cast(float, w & 0xffff0000u); }

namespace pg8 {
#define PG8_LAS __attribute__((address_space(3)))
typedef unsigned short bf16_t;
typedef short bf16x8 __attribute__((ext_vector_type(8)));
typedef float f32x4 __attribute__((ext_vector_type(4)));
typedef unsigned u32x4 __attribute__((ext_vector_type(4)));
constexpr int BM = 256, BK = 64, HALF = 128, HTB = HALF * BK * 2  , STAGE_BYTES = 8 * HTB, NXCD = 8, WGM = 8;

__host__ __device__ __forceinline__ int lds_byte(int r, int c) { const int st = (r >> 4) * 2 + (c >> 5), rr = r & 15, cc = c & 31, ob = rr * 64 + cc * 2; return st * 1024 + (ob ^ (((ob >> 9) & 1) << 5)); }
__host__ __device__ __forceinline__ void stage_rc(int b, int& R, int& C) { const int st = b / 1024, sb = b % 1024, swz = sb ^ (((sb >> 9) & 1) << 5); R = (st >> 1) * 16 + swz / 64; C = (st & 1) * 32 + (swz % 64) / 2; }
__host__ __device__ __forceinline__ int perm32(int rho) { const int n = rho >> 4, i = rho & 15; return 8 * (i >> 2) + 4 * n + (i & 3); }

struct Unit { int pm, pn; };
struct Gemm { const bf16_t* A; const bf16_t* Bt; int M, N, K, lda; };

struct StaticOrder {
    int nM, nN, nwg, G, c;
    __host__ __device__ void init(int M, int N, int G_, int c_) { nM = M / BM; nN = N / BM; nwg = nM * nN; G = G_; c = c_; }
    __host__ __device__ bool next(int i, Unit& u) const {
        const long L = (long)i * G + c; if (L >= nwg) return false;
        int wgid = (int)L; { const int q = nwg / NXCD, r = nwg % NXCD, xcd = wgid % NXCD, off = wgid / NXCD; wgid = (xcd < r ? xcd * (q + 1) : r * (q + 1) + (xcd - r) * q) + off; }
        const int nig = WGM * nN, gid = wgid / nig, fm = gid * WGM, gsz = (nM - fm) < WGM ? (nM - fm) : WGM;
        u.pm = fm + ((wgid % nig) % gsz); u.pn = (wgid % nig) / gsz; return true;
    }
    __device__ __forceinline__ int arow(const Unit& u) const { return u.pm * BM; }
    __device__ __forceinline__ int arperm(int R) const { return R; }
    __device__ __forceinline__ int ahalf() const { return HALF; }
    __device__ __forceinline__ void a_ready(const Unit&) const {}
    __device__ __forceinline__ void done(const Unit&) const {}
};

__device__ __forceinline__ unsigned cvt_pk_bf16(float lo, float hi) { unsigned r; asm volatile("v_cvt_pk_bf16_f32 %0, %1, %2" : "=v"(r) : "v"(lo), "v"(hi)); return r; }
typedef float f32x2 __attribute__((ext_vector_type(2)));
__device__ __forceinline__ void glds16_s(unsigned voff, const void* sbase, unsigned ldsdst) {
    unsigned keep; ldsdst = __builtin_amdgcn_readfirstlane(ldsdst);
    { const unsigned long long p_ = (unsigned long long)sbase; sbase = (const void*)(((unsigned long long)(unsigned)__builtin_amdgcn_readfirstlane((unsigned)(p_ >> 32)) << 32) | (unsigned)__builtin_amdgcn_readfirstlane((unsigned)p_)); }
    asm volatile("s_mov_b32 %0, m0\n\ts_mov_b32 m0, %3\n\ts_nop 2\n\tglobal_load_lds_dwordx4 %1, %2\n\ts_mov_b32 m0, %0" : "=&s"(keep) : "v"(voff), "s"(sbase), "s"(ldsdst) : "memory");
}
template <class Epi, class Sched, bool ALIGN_EPI = false, bool SP2 = false>
__device__ __forceinline__ void gemm_phase(PG8_LAS unsigned char* lds, const Gemm g, const Sched& S, const Epi& E) {
    int tid_l = threadIdx.x; asm volatile("" : "+v"(tid_l));
    const int tid = tid_l, wid = __builtin_amdgcn_readfirstlane(tid >> 6), lane = tid & 63, wr = wid >> 2, wc = wid & 3, fr = lane & 15, fq = lane >> 4;
    const int K = g.K, nt = K / BK;
    unsigned voffA[2], voffB[2];
#pragma unroll
    for (int i = 0; i < 2; ++i) { int R, C; stage_rc(tid * 16 + i * 8192, R, C); const int Rb = Epi::PERM ? ((R & ~31) + perm32(R & 31)) : R;
        voffA[i] = (unsigned)(S.arperm(R) * g.lda + C) * 2u; voffB[i] = (unsigned)(Rb * K + C) * 2u; }
    const unsigned kstep = (unsigned)(BK * 2);
    const unsigned hstep = (unsigned)HALF * K * 2; const unsigned hstepA = (unsigned)S.ahalf() * g.lda * 2;
    const unsigned tstep = 2 * hstep;
    const unsigned ldsw = (unsigned)wid * 1024u;
    const int aoff = lds_byte(wr * 64 + fr, fq * 8), boff = lds_byte(wc * 32 + fr, fq * 8);
#define PG8_SA(b, h) (((b) * 2 + (h)) * HTB)
#define PG8_SB(b, h) ((4 + (b) * 2 + (h)) * HTB)
#define PG8_STAGE(bufoff, gbase, voff) do { _Pragma("unroll") for (int _i = 0; _i < 2; ++_i) \
        glds16_s((voff)[_i], (const char*)(gbase), (unsigned)(uintptr_t)(lds + (bufoff) + ldsw + _i * 8192)); } while (0)
#define PG8_LDA(dst, b, h) do { _Pragma("unroll") for (int m = 0; m < 4; ++m) _Pragma("unroll") for (int k = 0; k < 2; ++k) dst[m][k] = *(const PG8_LAS bf16x8*)(lds + PG8_SA(b, h) + aoff + m * 2048 + k * 1024); } while (0)
#define PG8_LDB(dst, b, h) do { _Pragma("unroll") for (int n = 0; n < 2; ++n) _Pragma("unroll") for (int k = 0; k < 2; ++k) dst[n][k] = *(const PG8_LAS bf16x8*)(lds + PG8_SB(b, h) + boff + n * 2048 + k * 1024); } while (0)
#define PG8_MMA(ai, bj, At, Bt) do { __builtin_amdgcn_s_setprio(1); _Pragma("unroll") for (int m = 0; m < 4; ++m) _Pragma("unroll") for (int n = 0; n < 2; ++n) _Pragma("unroll") for (int k = 0; k < 2; ++k) \
        acc[ai][bj][m][n] = __builtin_amdgcn_mfma_f32_16x16x32_bf16(Bt[n][k], At[m][k], acc[ai][bj][m][n], 0, 0, 0); __builtin_amdgcn_s_setprio(0); } while (0)
#define PG8_WAIT_V(n) asm volatile("s_waitcnt vmcnt(" #n ")" ::: "memory")
#define PG8_WAIT_L(n) asm volatile("s_waitcnt lgkmcnt(" #n ")" ::: "memory")
#define PG8_BAR __builtin_amdgcn_s_barrier()
#define PG8_SCHED __builtin_amdgcn_sched_barrier(0)
    Unit cur, nxt; int ui = 0;
    if (!S.next(0, cur)) return;
    f32x4 acc[2][2][4][2];
#pragma unroll
    for (int a = 0; a < 2; ++a)
#pragma unroll
        for (int b = 0; b < 2; ++b)
#pragma unroll
            for (int m = 0; m < 4; ++m)
#pragma unroll
                for (int n = 0; n < 2; ++n) acc[a][b][m][n] = (f32x4){0.f, 0.f, 0.f, 0.f};
    bf16x8 At[4][2], B0[2][2], B1[2][2];
    const char* cA = (const char*)g.A + (size_t)S.arow(cur) * g.lda * 2; const char* cB = (const char*)g.Bt + (size_t)cur.pn * tstep;
    S.a_ready(cur);
    if constexpr (SP2) {
        PG8_STAGE(PG8_SB(0, 0), cB, voffB); PG8_STAGE(PG8_SB(0, 1), cB + hstep, voffB); PG8_STAGE(PG8_SA(0, 0), cA, voffA); PG8_STAGE(PG8_SA(0, 1), cA + hstepA, voffA);
        if (wr == 1) PG8_BAR;
        PG8_WAIT_V(2); PG8_BAR;
        PG8_STAGE(PG8_SB(1, 0), cB + kstep, voffB); PG8_STAGE(PG8_SA(1, 0), cA + kstep, voffA); PG8_STAGE(PG8_SB(1, 1), cB + hstep + kstep, voffB);
        PG8_WAIT_V(6); PG8_BAR;
    } else {
        PG8_STAGE(PG8_SB(0, 0), cB, voffB); PG8_STAGE(PG8_SA(0, 0), cA, voffA); PG8_STAGE(PG8_SB(0, 1), cB + hstep, voffB); PG8_STAGE(PG8_SA(0, 1), cA + hstepA, voffA);
        if (wr == 1) PG8_BAR;
        PG8_WAIT_V(4); PG8_BAR;
        PG8_STAGE(PG8_SB(1, 0), cB + kstep, voffB); PG8_STAGE(PG8_SA(1, 0), cA + kstep, voffA); PG8_STAGE(PG8_SB(1, 1), cB + hstep + kstep, voffB);
        PG8_WAIT_V(6); PG8_BAR;
    }
    for (;;) {
        const bool has_next = S.next(ui + 1, nxt);
        const char* nA = has_next ? (const char*)g.A + (size_t)S.arow(nxt) * g.lda * 2 : cA; const char* nB = has_next ? (const char*)g.Bt + (size_t)nxt.pn * tstep : cB;
        for (int t = 0; t < nt; t += 2) {
            const bool last = (t == nt - 2);
            const char* a1 = cA + (size_t)(t + 1) * kstep;
            const char* a2 = last ? nA : cA + (size_t)(t + 2) * kstep; const char* b2 = last ? nB : cB + (size_t)(t + 2) * kstep;
            const char* a3 = a2 + kstep; const char* b3 = b2 + kstep;
            if (last && has_next) S.a_ready(nxt);
            if constexpr (SP2) {
            PG8_LDB(B0, 0, 0); PG8_LDB(B1, 0, 1); PG8_SCHED; PG8_LDA(At, 0, 0); PG8_STAGE(PG8_SA(1, 1), a1 + hstepA, voffA);
            PG8_WAIT_V(8); PG8_WAIT_L(0); PG8_BAR; PG8_MMA(0, 0, At, B0); PG8_MMA(0, 1, At, B1); PG8_BAR; PG8_SCHED;
            PG8_LDA(At, 0, 1); PG8_STAGE(PG8_SB(0, 0), b2, voffB); PG8_STAGE(PG8_SB(0, 1), b2 + hstep, voffB); PG8_STAGE(PG8_SA(0, 0), a2, voffA);
            PG8_WAIT_V(8); PG8_WAIT_L(0); PG8_BAR; PG8_MMA(1, 0, At, B0); PG8_MMA(1, 1, At, B1); PG8_BAR; PG8_SCHED;
            PG8_LDB(B0, 1, 0); PG8_LDB(B1, 1, 1); PG8_SCHED; PG8_LDA(At, 1, 0); PG8_STAGE(PG8_SA(0, 1), a2 + hstepA, voffA);
            PG8_WAIT_V(8); PG8_WAIT_L(0); PG8_BAR; PG8_MMA(0, 0, At, B0); PG8_MMA(0, 1, At, B1); PG8_BAR; PG8_SCHED;
            PG8_LDA(At, 1, 1); PG8_STAGE(PG8_SB(1, 0), b3, voffB); PG8_STAGE(PG8_SB(1, 1), b3 + hstep, voffB); PG8_STAGE(PG8_SA(1, 0), a3, voffA);
            PG8_WAIT_V(8); PG8_WAIT_L(0); PG8_BAR; PG8_MMA(1, 0, At, B0); PG8_MMA(1, 1, At, B1); PG8_BAR; PG8_SCHED;
            } else {
            PG8_LDB(B0, 0, 0); PG8_SCHED; PG8_LDA(At, 0, 0); PG8_STAGE(PG8_SA(1, 1), a1 + hstepA, voffA);
            PG8_WAIT_L(8); PG8_BAR; PG8_WAIT_L(0); PG8_MMA(0, 0, At, B0); PG8_BAR; PG8_SCHED;
            PG8_LDB(B1, 0, 1); PG8_STAGE(PG8_SB(0, 0), b2, voffB);
            PG8_BAR; PG8_WAIT_L(0); PG8_MMA(0, 1, At, B1); PG8_BAR;
            PG8_LDA(At, 0, 1); PG8_STAGE(PG8_SA(0, 0), a2, voffA);
            PG8_BAR; PG8_WAIT_L(0); PG8_MMA(1, 0, At, B0); PG8_BAR; PG8_SCHED;
            PG8_STAGE(PG8_SB(0, 1), b2 + hstep, voffB);
            PG8_WAIT_V(6); PG8_BAR; PG8_MMA(1, 1, At, B1); PG8_BAR;
            PG8_LDB(B0, 1, 0); PG8_SCHED; PG8_LDA(At, 1, 0); PG8_STAGE(PG8_SA(0, 1), a2 + hstepA, voffA);
            PG8_WAIT_L(8); PG8_BAR; PG8_WAIT_L(0); PG8_MMA(0, 0, At, B0); PG8_BAR; PG8_SCHED;
            PG8_LDB(B1, 1, 1); PG8_STAGE(PG8_SB(1, 0), b3, voffB);
            PG8_BAR; PG8_WAIT_L(0); PG8_MMA(0, 1, At, B1); PG8_BAR;
            PG8_LDA(At, 1, 1); PG8_STAGE(PG8_SA(1, 0), a3, voffA);
            PG8_BAR; PG8_WAIT_L(0); PG8_MMA(1, 0, At, B0); PG8_BAR; PG8_SCHED;
            PG8_STAGE(PG8_SB(1, 1), b3 + hstep, voffB);
            PG8_WAIT_V(6); PG8_BAR; PG8_MMA(1, 1, At, B1); PG8_BAR;
            }
        }
        if constexpr (ALIGN_EPI) { if (wr == 0) PG8_BAR; }
        if constexpr (!Epi::AFTER_DRAIN) { E(acc, cur, wr, wc, fr, fq); S.done(cur); }
        if (!has_next) break;
#pragma unroll
        for (int a = 0; a < 2; ++a)
#pragma unroll
            for (int b = 0; b < 2; ++b)
#pragma unroll
                for (int m = 0; m < 4; ++m)
#pragma unroll
                    for (int n = 0; n < 2; ++n) acc[a][b][m][n] = (f32x4){0.f, 0.f, 0.f, 0.f};
        cur = nxt; cA = nA; cB = nB; ++ui;
        if constexpr (ALIGN_EPI) { if (wr == 1) PG8_BAR; }
    }
    PG8_WAIT_V(0);
    if constexpr (!ALIGN_EPI) { if (wr == 0) PG8_BAR; }
    PG8_BAR;
    if constexpr (Epi::AFTER_DRAIN) { E.fused(acc, cur, wr, wc, fr, fq, lds, wid, lane); S.done(cur); }
#undef PG8_SA
#undef PG8_SB
#undef PG8_STAGE
#undef PG8_LDA
#undef PG8_LDB
#undef PG8_MMA
#undef PG8_WAIT_V
#undef PG8_WAIT_L
#undef PG8_BAR
#undef PG8_SCHED
}
}
constexpr int NWAVES = 8, NTHREADS = 512;
constexpr int RING_BYTES = 131072, LDS_BYTES = 147456;
struct Args { const float* in[20]; float* out; unsigned char* ws; int ph_lo, ph_hi, layer, pad; };
enum { I_X = 0, I_LN1G, I_WIN, I_FB, I_LQ1, I_LK1, I_LQ2, I_LK2, I_DNG, I_QNG, I_WUQ, I_KVNG, I_WUKV, I_WO, I_LN2G, I_WUP, I_CW, I_CB, I_WDN, I_FG };

__device__ __forceinline__ float wave_sum(float v) {
#pragma unroll
    for (int o = 1; o < 64; o <<= 1) v += __shfl_xor(v, o);
    return v;
}
struct MapIn {
    __device__ __forceinline__ int src(int n) const { return n < 768 ? n : (n < 2720 ? n + 4 : (n < 2724 ? n - 2720 + 768 : -1)); }
    __device__ __forceinline__ float scale(int n) const { return (n < 256 || (n >= H_DQ && n < H_DK)) ? 0.125f * LOG2E : 1.0f; }
};
struct MapUq {
    __device__ __forceinline__ int src(int n) const { if (n >= 384) return -1; const int h = n / 96, d = n % 96; if (d < 64) return n; const int jj = d - 64; return h * 96 + 64 + (jj >> 1) + 16 * (jj & 1); }
    __device__ __forceinline__ float scale(int) const { return 0.10206207261596577f * LOG2E; }
};
struct MapId {
    __device__ __forceinline__ int src(int n) const { return n; }
    __device__ __forceinline__ float scale(int) const { return 1.0f; }
};
struct MapUp {
    __device__ __forceinline__ int src(int n) const { return ((n >> 7) & 1) * DFF + 128 * (n >> 8) + (n & 127); }
    __device__ __forceinline__ float scale(int) const { return 1.0f; }
};
template <class Map>
__device__ __forceinline__ void wprep_item(const float* W, int ldw, int K, bf16* WT, int nblk, LAS float* scr, int item, int lane, const float* gk, const Map map) {
    const int kb = item / nblk, nb = item % nblk, k0 = 64 * kb, n0 = 32 * nb;
    const int nd = n0 + (lane & 31), sc = map.src(nd); const float cs = map.scale(nd);
#pragma unroll 8
    for (int i = 0; i < 32; ++i) { const int kk = 2 * i + (lane >> 5); float v = (sc >= 0) ? W[(size_t)(k0 + kk) * ldw + sc] : 0.f; if (gk) v *= gk[k0 + kk]; scr[kk * 33 + (lane & 31)] = v * cs; }
    asm volatile("s_waitcnt lgkmcnt(0)" ::: "memory");
    const int c = lane & 7;
#pragma unroll
    for (int j = 0; j < 4; ++j) { const int n = (lane >> 3) + 8 * j; const LAS float* s = scr + (8 * c) * 33 + n;
        v4u o; o.x = pk2(s[0 * 33], s[1 * 33]); o.y = pk2(s[2 * 33], s[3 * 33]); o.z = pk2(s[4 * 33], s[5 * 33]); o.w = pk2(s[6 * 33], s[7 * 33]);
        *(v4u*)(WT + (size_t)(n0 + n) * K + k0 + 8 * c) = o; }
    asm volatile("s_waitcnt lgkmcnt(0)" ::: "memory");
}
__device__ __forceinline__ void xprep_row(const float* xrow, bf16* orow, float* rstd, int lane) {
    const float4* xr = (const float4*)xrow + lane;
    float4 v[4]; float s = 0.f;
#pragma unroll
    for (int j = 0; j < 4; ++j) { v[j] = xr[64 * j]; s += (v[j].x * v[j].x + v[j].y * v[j].y) + (v[j].z * v[j].z + v[j].w * v[j].w); }
    s = wave_sum(s);
    if (lane == 0) *rstd = s;
    v2u* o8 = (v2u*)orow + lane;
#pragma unroll
    for (int j = 0; j < 4; ++j) { v2u w; w.x = pk2(v[j].x, v[j].y); w.y = pk2(v[j].z, v[j].w); o8[64 * j] = w; }
}
__device__ __forceinline__ void p0_prologue(const __attribute__((address_space(4))) Args* ap_, LAS unsigned char* lds, int gw, int ngw, int lane, int wave) {
    LAS float* scr = (LAS float*)(lds + wave * 16384);
    unsigned char* ws = ap_->ws;
    constexpr int I_IN = 16 * 88, I_UQ = 4 * 16, I_UKV = 2 * 16, I_O = 16 * 32, I_UP = 16 * 176, I_DN = 44 * 32, I_L = I_IN + I_UQ + I_UKV + I_O + I_UP + I_DN;
    for (int it = gw; it < 2 * I_L; it += ngw) {
        const int l = it / I_L; int r = it % I_L;
        unsigned char* wl = ws + WS_W + (size_t)l * WS_WL;
        if (r < I_IN) { wprep_item(ap_->in[I_WIN] + (size_t)l * DM * IN_COLS, IN_COLS, DM, (bf16*)(wl + W_IN), 88, scr, r, lane, ap_->in[I_LN1G] + l * DM, MapIn()); continue; } r -= I_IN;
        if (r < I_UQ) { wprep_item(ap_->in[I_WUQ] + (size_t)l * 256 * 384, 384, 256, (bf16*)(wl + W_UQ), 16, scr, r, lane, ap_->in[I_QNG] + l * 256, MapUq()); continue; } r -= I_UQ;
        if (r < I_UKV) { wprep_item(ap_->in[I_WUKV] + (size_t)l * 128 * 512, 512, 128, (bf16*)(wl + W_UKV), 16, scr, r, lane, ap_->in[I_KVNG] + l * 128, MapId()); continue; } r -= I_UKV;
        if (r < I_O) { wprep_item(ap_->in[I_WO] + (size_t)l * DM * DM, DM, DM, (bf16*)(wl + W_O), 32, scr, r, lane, (const float*)nullptr, MapId()); continue; } r -= I_O;
        if (r < I_UP) { wprep_item(ap_->in[I_WUP] + (size_t)l * DM * NUP, NUP, DM, (bf16*)(wl + W_UP), 176, scr, r, lane, ap_->in[I_LN2G] + l * DM, MapUp()); continue; } r -= I_UP;
        wprep_item(ap_->in[I_WDN] + (size_t)l * DFF * DM, DM, DFF, (bf16*)(wl + W_DN), 32, scr, r, lane, (const float*)nullptr, MapId());
    }
    float* rstd1 = (float*)(ws + WS_SM + SM_RSTD1);
    for (int m = gw; m < MTOK; m += ngw) xprep_row(ap_->in[I_X] + (size_t)m * DM, (bf16*)(ws + WS_XB) + (size_t)m * DM, rstd1 + m, lane);
    float* z = (float*)(ws + WS_SM + SM_ZERO_BEG); const int nz = (int)((SM_ZERO_END - SM_ZERO_BEG) / 4);
    for (int i = gw * 64 + lane; i < nz; i += ngw * 64) z[i] = 0.f;
}
namespace pg8 {
__device__ __forceinline__ u32x4 pack8(const f32x4 v0, const f32x4 v1) { u32x4 w; w.x = cvt_pk_bf16(v0[0], v0[1]); w.y = cvt_pk_bf16(v0[2], v0[3]); w.z = cvt_pk_bf16(v1[0], v1[1]); w.w = cvt_pk_bf16(v1[2], v1[3]); return w; }
__device__ __forceinline__ float sq8(const f32x4 a, const f32x4 b) { return (a[0] * a[0] + a[1] * a[1]) + (a[2] * a[2] + a[3] * a[3]) + (b[0] * b[0] + b[1] * b[1]) + (b[2] * b[2] + b[3] * b[3]); }
__device__ __forceinline__ float log_sigmoid_d(float z) { return fminf(z, 0.f) - 0.6931471805599453f * __builtin_amdgcn_logf(1.0f + __builtin_amdgcn_exp2f(-1.4426950408889634f * fabsf(z))); }
struct EpiH {
    static constexpr bool PERM = true, AFTER_DRAIN = false;
    unsigned char* ws; const float* fb; int l;
    __device__ __forceinline__ void operator()(const f32x4 (&acc)[2][2][4][2], const Unit& u, int wr, int wc, int fr, int fq) const {
        { int t_ = threadIdx.x; asm volatile("" : "+v"(t_)); fr = t_ & 15; fq = (t_ >> 4) & 3; const int w_ = __builtin_amdgcn_readfirstlane(t_ >> 6); wr = w_ >> 2; wc = w_ & 3; }
        bf16_t* Hb = (bf16_t*)(ws + WS_HB); float* sm = (float*)(ws + WS_SM);
        const float* ssin = l == 0 ? sm + SM_RSTD1 / 4 : sm + SM_SS1N / 4 + (l - 1) * MTOK;
        float* logf = sm + SM_LOGF / 4; float* ssq = sm + SM_SSQ / 4 + l * MTOK; float* sskv = sm + SM_SSKV / 4 + l * MTOK;
        const int row0 = u.pm * BM + wr * 64 + fr, colw = wc * 32 + 8 * fq;
#pragma unroll
        for (int ai = 0; ai < 2; ++ai)
#pragma unroll
            for (int m = 0; m < 4; ++m) {
                const int row = row0 + ai * HALF + m * 16; const float rs = __builtin_amdgcn_rsqf(ssin[row] * (1.0f / DM) + EPS);
                float s = 0.f;
#pragma unroll
                for (int bj = 0; bj < 2; ++bj) {
                    const f32x4 v0 = acc[ai][bj][m][0] * rs, v1 = acc[ai][bj][m][1] * rs;
                    *(u32x4*)(Hb + (size_t)row * HN + u.pn * BM + bj * HALF + colw) = pack8(v0, v1);
                    if (u.pn == 9 || (u.pn == 10 && bj == 0)) s += sq8(v0, v1);
                    if (u.pn == 10 && bj == 1 && wc == 1 && fq == 0) { f32x4 lf; lf[0] = log_sigmoid_d(v0[0] + fb[0]); lf[1] = log_sigmoid_d(v0[1] + fb[1]); lf[2] = log_sigmoid_d(v0[2] + fb[2]); lf[3] = log_sigmoid_d(v0[3] + fb[3]); *(f32x4*)(logf + (size_t)row * 4) = lf; }
                }
                if (u.pn == 9 || u.pn == 10) { s += __shfl_xor(s, 16); s += __shfl_xor(s, 32); if (fq == 0) atomicAdd((u.pn == 9 ? ssq : sskv) + row, s); }
                asm volatile("" ::: "memory");
            }
    }
};
struct EpiQ {
    static constexpr bool PERM = true, AFTER_DRAIN = false;
    bf16_t* QM; const float* ssq; const float2* rope;
    __device__ __forceinline__ void operator()(const f32x4 (&acc)[2][2][4][2], const Unit& u, int wr, int wc, int fr, int fq) const {
        { int t_ = threadIdx.x; asm volatile("" : "+v"(t_)); fr = t_ & 15; fq = (t_ >> 4) & 3; const int w_ = __builtin_amdgcn_readfirstlane(t_ >> 6); wr = w_ >> 2; wc = w_ & 3; }
        const int row0 = u.pm * BM + wr * 64 + fr, colw = wc * 32 + 8 * fq;
#pragma unroll
        for (int ai = 0; ai < 2; ++ai)
#pragma unroll
            for (int m = 0; m < 4; ++m) {
                const int row = row0 + ai * HALF + m * 16; const float rs = __builtin_amdgcn_rsqf(ssq[row] * (1.0f / 256.0f) + EPS);
                const float2* rt = rope + (size_t)(row & (SEQ - 1)) * 16;
#pragma unroll
                for (int bj = 0; bj < 2; ++bj) {
                    const int col = u.pn * BM + bj * HALF + colw;
                    if (col < 384) {
                        f32x4 v0 = acc[ai][bj][m][0] * rs, v1 = acc[ai][bj][m][1] * rs;
                        const int d = col % 96;
                        if (d >= 64) { const int j0 = (d - 64) >> 1; const float2 c0 = rt[j0], c1 = rt[j0 + 1], c2 = rt[j0 + 2], c3 = rt[j0 + 3];
                            f32x4 r0, r1;
                            r0[0] = v0[0] * c0.x - v0[1] * c0.y; r0[1] = v0[0] * c0.y + v0[1] * c0.x; r0[2] = v0[2] * c1.x - v0[3] * c1.y; r0[3] = v0[2] * c1.y + v0[3] * c1.x;
                            r1[0] = v1[0] * c2.x - v1[1] * c2.y; r1[1] = v1[0] * c2.y + v1[1] * c2.x; r1[2] = v1[2] * c3.x - v1[3] * c3.y; r1[3] = v1[2] * c3.y + v1[3] * c3.x;
                            v0 = r0; v1 = r1; }
                        *(u32x4*)(QM + (size_t)row * 384 + col) = pack8(v0, v1);
                    }
                }
                asm volatile("" ::: "memory");
            }
    }
};
struct EpiKV {
    static constexpr bool PERM = true, AFTER_DRAIN = false;
    bf16_t* KVM; const float* sskv;
    __device__ __forceinline__ void operator()(const f32x4 (&acc)[2][2][4][2], const Unit& u, int wr, int wc, int fr, int fq) const {
        { int t_ = threadIdx.x; asm volatile("" : "+v"(t_)); fr = t_ & 15; fq = (t_ >> 4) & 3; const int w_ = __builtin_amdgcn_readfirstlane(t_ >> 6); wr = w_ >> 2; wc = w_ & 3; }
        const int row0 = u.pm * BM + wr * 64 + fr, colw = wc * 32 + 8 * fq;
#pragma unroll
        for (int ai = 0; ai < 2; ++ai)
#pragma unroll
            for (int m = 0; m < 4; ++m) {
                const int row = row0 + ai * HALF + m * 16; const float rs = __builtin_amdgcn_rsqf(sskv[row] * (1.0f / 128.0f) + EPS);
#pragma unroll
                for (int bj = 0; bj < 2; ++bj) *(u32x4*)(KVM + (size_t)row * 512 + u.pn * BM + bj * HALF + colw) = pack8(acc[ai][bj][m][0] * rs, acc[ai][bj][m][1] * rs);
                asm volatile("" ::: "memory");
            }
    }
};
struct EpiRes {
    static constexpr bool PERM = true, AFTER_DRAIN = false;
    const float* xold; float* xnew; bf16_t* xb; float* ss;
    __device__ __forceinline__ void operator()(const f32x4 (&acc)[2][2][4][2], const Unit& u, int wr, int wc, int fr, int fq) const {
        { int t_ = threadIdx.x; asm volatile("" : "+v"(t_)); fr = t_ & 15; fq = (t_ >> 4) & 3; const int w_ = __builtin_amdgcn_readfirstlane(t_ >> 6); wr = w_ >> 2; wc = w_ & 3; }
        const int row0 = u.pm * BM + wr * 64 + fr, colw = wc * 32 + 8 * fq;
#pragma unroll
        for (int ai = 0; ai < 2; ++ai)
#pragma unroll
            for (int m = 0; m < 4; ++m) {
                const int row = row0 + ai * HALF + m * 16; float s = 0.f;
#pragma unroll
                for (int bj = 0; bj < 2; ++bj) {
                    const size_t off = (size_t)row * DM + u.pn * BM + bj * HALF + colw;
                    const f32x4 v0 = *(const f32x4*)(xold + off) + acc[ai][bj][m][0], v1 = *(const f32x4*)(xold + off + 4) + acc[ai][bj][m][1];
                    *(f32x4*)(xnew + off) = v0; *(f32x4*)(xnew + off + 4) = v1; *(u32x4*)(xb + off) = pack8(v0, v1);
                    s += sq8(v0, v1);
                }
                s += __shfl_xor(s, 16); s += __shfl_xor(s, 32); if (fq == 0) atomicAdd(ss + row, s);
                asm volatile("" ::: "memory");
            }
    }
};
struct HalfOrder {
    int nN, nwg, G2, c2; bool active;
    __device__ void init(int M, int N, int G, int c, int half) { nN = N / BM; nwg = (M / BM) * nN; G2 = G / 2; active = (c / G2) == half; c2 = c % G2; }
    __device__ bool next(int i, Unit& u) const { if (!active) return false; const int L = i * G2 + c2; if (L >= nwg) return false; u.pm = L / nN; u.pn = L % nN; return true; }
    __device__ __forceinline__ int arow(const Unit& u) const { return u.pm * BM; }
    __device__ __forceinline__ int arperm(int R) const { return R; }
    __device__ __forceinline__ int ahalf() const { return HALF; }
    __device__ __forceinline__ void a_ready(const Unit&) const {}
    __device__ __forceinline__ void done(const Unit&) const {}
};
constexpr int UP_TILES_PER_B = 33, UP_NM = 2 * UP_TILES_PER_B, UP_NN = NUP / 256;
__device__ __forceinline__ int up_tile_start(int pm) { const int b = pm / UP_TILES_PER_B, i = pm % UP_TILES_PER_B; int s = 252 * i; s = s > SEQ - 254 ? SEQ - 254 : s; return b * SEQ + s; }
struct UpOrder : StaticOrder {
    __device__ void init_up(int G_, int c_) { nM = UP_NM; nN = UP_NN; nwg = nM * nN; G = G_; c = c_; }
    __device__ __forceinline__ int arow(const Unit& u) const { return up_tile_start(u.pm); }
    __device__ __forceinline__ int arperm(int R) const { return R < 64 ? R : R + 62; }
    __device__ __forceinline__ int ahalf() const { return 64; }
};
template <int CTRL> __device__ __forceinline__ float dppz(float src) {
    return __builtin_bit_cast(float, __builtin_amdgcn_update_dpp(0, __builtin_bit_cast(int, src), CTRL, 0xf, 0xf, false));
}
struct EpiUp {
    static constexpr bool PERM = true, AFTER_DRAIN = false;
    unsigned char* ws; const float* cw; const float* cb; int l;
    __device__ __forceinline__ void operator()(f32x4 (&acc)[2][2][4][2], const Unit& u, int wr, int wc, int fr, int fq) const {
        { int t_ = threadIdx.x; asm volatile("" : "+v"(t_)); fr = t_ & 15; fq = (t_ >> 4) & 3; const int w_ = __builtin_amdgcn_readfirstlane(t_ >> 6); wr = w_ >> 2; wc = w_ & 3; }
        const float* ss2 = (const float*)(ws + WS_SM) + SM_SS2 / 4 + l * MTOK; bf16_t* act = (bf16_t*)(ws + WS_HB);
        const int t0 = up_tile_start(u.pm) + 126 * wr + fr;
        const bool keep_head = (u.pm % UP_TILES_PER_B) == 0 && wr == 0;
#pragma unroll
        for (int ai = 0; ai < 2; ++ai)
#pragma unroll
            for (int m = 0; m < 4; ++m) { const float rs = __builtin_amdgcn_rsqf(ss2[t0 + ai * 64 + m * 16] * (1.0f / DM) + EPS);
#pragma unroll
                for (int bj = 0; bj < 2; ++bj) { acc[ai][bj][m][0] *= rs; acc[ai][bj][m][1] *= rs; } }
        const int cg0 = u.pn * 128 + wc * 32 + 8 * fq;
#pragma unroll
        for (int n = 0; n < 2; ++n) {
            const int cg = cg0 + 4 * n;
            const f32x4 wg0 = *(const f32x4*)(cw + cg), wg1 = *(const f32x4*)(cw + NUP + cg), wg2 = *(const f32x4*)(cw + 2 * NUP + cg), bg = *(const f32x4*)(cb + cg);
            const f32x4 wu0 = *(const f32x4*)(cw + DFF + cg), wu1 = *(const f32x4*)(cw + NUP + DFF + cg), wu2 = *(const f32x4*)(cw + 2 * NUP + DFF + cg), bu = *(const f32x4*)(cb + DFF + cg);
#pragma unroll
            for (int ai = 0; ai < 2; ++ai)
#pragma unroll
                for (int m = 0; m < 4; ++m) {
                    const f32x4 xg = acc[ai][0][m][n], xu = acc[ai][1][m][n];
                    f32x4 pg, pu;
                    if (m > 0) { pg = acc[ai][0][m - 1][n]; pu = acc[ai][1][m - 1][n]; }
                    else if (ai > 0) { pg = acc[0][0][3][n]; pu = acc[0][1][3][n]; }
                    else { pg = (f32x4){0.f, 0.f, 0.f, 0.f}; pu = pg; }
                    float a[4];
#pragma unroll
                    for (int c = 0; c < 4; ++c) {
                        const float g1 = dppz<0x111>(xg[c]) + dppz<0x10F>(pg[c]), g2 = dppz<0x112>(xg[c]) + dppz<0x10E>(pg[c]);
                        const float u1 = dppz<0x111>(xu[c]) + dppz<0x10F>(pu[c]), u2 = dppz<0x112>(xu[c]) + dppz<0x10E>(pu[c]);
                        const float G = bg[c] + wg2[c] * xg[c] + wg1[c] * g1 + wg0[c] * g2;
                        const float U = bu[c] + wu2[c] * xu[c] + wu1[c] * u1 + wu0[c] * u2;
                        a[c] = G * __builtin_amdgcn_rcpf(1.0f + __builtin_amdgcn_exp2f(-1.4426950408889634f * G)) * U;
                    }
                    typedef unsigned u32x2 __attribute__((ext_vector_type(2)));
                    u32x2 w; w.x = cvt_pk_bf16(a[0], a[1]); w.y = cvt_pk_bf16(a[2], a[3]);
                    const bool halo = (ai == 0 && m == 0 && fr < 2 && !keep_head);
                    if (!halo) *(u32x2*)(act + (size_t)(t0 + ai * 64 + m * 16) * DFF + cg) = w;
                }
            asm volatile("" ::: "memory");
        }
    }
};
}
namespace att {
typedef short bf16x8 __attribute__((ext_vector_type(8)));
typedef short s16x4 __attribute__((ext_vector_type(4)));
typedef float f32x4 __attribute__((ext_vector_type(4)));
constexpr int ST_K = 0, ST_V = 16384, ST_CK = 32768, ST_BYTES = 33280;
constexpr float THR = 8.0f;
constexpr float MASKV = -1.0e30f;
constexpr int N_FOX = 256, N_MLA = 256, N_DIFF = 512, N_ITEMS = N_FOX + N_MLA + N_DIFF;

__device__ __forceinline__ s16x4 vtr(LAS const unsigned char* p) { typedef short v4i16_t __attribute__((ext_vector_type(4))); return __builtin_bit_cast(s16x4, __builtin_amdgcn_ds_read_tr16_b64_v4i16((LAS v4i16_t*)p)); }
__device__ __forceinline__ unsigned cvtpk(float lo, float hi) { typedef float f32x2_t __attribute__((ext_vector_type(2))); typedef __bf16 bf16x2_t __attribute__((ext_vector_type(2))); f32x2_t v = {lo, hi}; bf16x2_t b = __builtin_convertvector(v, bf16x2_t); return __builtin_bit_cast(unsigned, b); }
__device__ __forceinline__ float max3f(float a, float b, float c) { return __builtin_fmaxf(__builtin_fmaxf(a, b), c); }
__device__ __forceinline__ float halfmax(float v) { auto rr = __builtin_amdgcn_permlane32_swap(__float_as_uint(v), __float_as_uint(v), false, false); return __builtin_fmaxf(__uint_as_float(rr[0]), __uint_as_float(rr[1])); }
__device__ __forceinline__ float halfsum(float v) { auto rr = __builtin_amdgcn_permlane32_swap(__float_as_uint(v), __float_as_uint(v), false, false); return __uint_as_float(rr[0]) + __uint_as_float(rr[1]); }

__device__ __forceinline__ int item_cost(int type, int qb) { return (type == 0 ? 64 : (type == 1 ? 48 : 80)) * (qb + 1); }
__device__ __forceinline__ int n_gt(int a, int n, int c) { const int f = c / a; return 8 * (n - (f < n ? f : n)); }
__device__ __forceinline__ int n_eq(int a, int n, int c) { return (c % a == 0 && c / a >= 1 && c / a <= n) ? 8 : 0; }
__device__ __forceinline__ void build_items(int* list, int gtid, int ngt) {
    for (int i = gtid; i < N_ITEMS; i += ngt) {
        int type, rem;
        if (i < N_FOX) { type = 0; rem = i; } else if (i < N_FOX + N_DIFF) { type = 1; rem = i - N_FOX; } else { type = 2; rem = i - N_FOX - N_DIFF; }
        const int nq = type == 1 ? 64 : 32; const int bh = rem / nq, qb = rem % nq;
        const int c = item_cost(type, qb);
        int rank = n_gt(64, 32, c) + n_gt(48, 64, c) + n_gt(80, 32, c);
        if (type > 0) rank += n_eq(64, 32, c);
        if (type > 1) rank += n_eq(48, 64, c);
        rank += bh;
        list[rank] = type | (rem << 2);
    }
}

struct Params { const bf16* HB; const bf16* QM; const bf16* KVM; const bf16* KR; bf16* AO; const float* cum; const float* lq1; const float* lk1; const float* lq2; const float* lk2; const float* dng; float lam_init; int pad; };

template <int MODE>
__device__ __forceinline__ void attn_unit(const Params& P, LAS unsigned char* lds, const int b, const int head, const int qblk) {
    constexpr int DK = MODE == 2 ? 96 : 64, DV = MODE == 1 ? 128 : 64, NS = DK / 16, NDB = DV / 32;
    constexpr int KPITCH = MODE == 2 ? 256 : 128, VPITCH = DV * 2;
    int tid = threadIdx.x; asm volatile("" : "+v"(tid));
    const int lane = tid & 63, wave = __builtin_amdgcn_readfirstlane(tid >> 6), r = lane & 31, h = lane >> 5;
    const size_t rb = (size_t)b * SEQ;
    const int wq = MODE == 1 ? (wave & 3) : wave;
    const int map = MODE == 1 ? (wave >> 2) : 0;
    const int q0 = (MODE == 1 ? 128 : 256) * qblk, qrow = q0 + 32 * wq;
    const int NT = (MODE == 1 ? 2 : 4) * qblk + (MODE == 1 ? 2 : 4);
    const int jv = (MODE == 1 ? 2 : 4) * qblk + (wq >> 1);
    const bf16 *Qp, *Kp, *K2p = nullptr, *Vp; int qpitch, kpitch, vpitch; bf16* Op;
    if (MODE == 0) { Qp = P.HB + H_FQ + head * 64; Kp = P.HB + H_FK + head * 64; Vp = P.HB + H_FV + head * 64; qpitch = kpitch = vpitch = HN; Op = P.AO + head * 64; }
    else if (MODE == 1) { Qp = P.HB + H_DQ + head * 128 + map * 64; Kp = P.HB + H_DK + head * 128; Vp = P.HB + H_DV + head * 128; qpitch = kpitch = vpitch = HN; Op = P.AO + 256 + head * 128; }
    else { Qp = P.QM + head * 96; Kp = P.KVM + head * 128; K2p = P.KR; Vp = P.KVM + head * 128 + 64; qpitch = 384; kpitch = vpitch = 512; Op = P.AO + 768 + head * 64; }
    bf16x8 qf[NS];
#pragma unroll
    for (int s = 0; s < NS; ++s) qf[s] = *(const bf16x8*)(Qp + (rb + qrow + r) * qpitch + 16 * s + 8 * h);
    v4u kreg0, kreg1, vreg0, vreg1; f32x4 ckreg;
    kreg1 = (v4u){0u, 0u, 0u, 0u}; vreg1 = kreg1; ckreg = (f32x4){0.f, 0.f, 0.f, 0.f};
    const int skey = tid >> 3, sc = tid & 7;
    unsigned kw0, kw1 = 0, vw0, vw1 = 0;
    if (MODE == 2) { kw0 = ST_K + skey * 256 + ((sc ^ (skey & 15)) << 4); const int k2 = tid >> 2, c2 = 8 + (tid & 3); kw1 = ST_K + k2 * 256 + ((c2 ^ (k2 & 15)) << 4); }
    else { kw0 = ST_K + skey * 128 + ((sc ^ ((skey >> 1) & 7)) << 4); kw1 = kw0 + 8192; }
    if (DV == 64) vw0 = ST_V + skey * 128 + ((((sc >> 2) ^ ((skey >> 1) & 1))) << 6) + ((sc & 3) << 4);
    else { const int k0_ = tid >> 4, c0_ = tid & 15; vw0 = ST_V + k0_ * 256 + ((((c0_ >> 2) ^ (k0_ & 3))) << 6) + ((c0_ & 3) << 4); const int k1_ = k0_ + 32; vw1 = ST_V + k1_ * 256 + ((((c0_ >> 2) ^ (k1_ & 3))) << 6) + ((c0_ & 3) << 4); }
    const float cref = (MODE == 0) ? P.cum[(rb + q0) * 4 + head] : 0.f;
#define ATT_LOAD(j) do { const size_t kr_ = rb + (size_t)(j) * 64; \
        if (MODE == 2) { kreg0 = *(const v4u*)(Kp + (kr_ + skey) * kpitch + sc * 8); if (tid < 256) kreg1 = *(const v4u*)(K2p + (kr_ + (tid >> 2)) * 32 + (tid & 3) * 8); } \
        else { kreg0 = *(const v4u*)(Kp + (kr_ + skey) * kpitch + sc * 8); if (MODE == 1) kreg1 = *(const v4u*)(Kp + 64 + (kr_ + skey) * kpitch + sc * 8); } \
        if (DV == 64) vreg0 = *(const v4u*)(Vp + (kr_ + skey) * vpitch + sc * 8); \
        else { vreg0 = *(const v4u*)(Vp + (kr_ + (tid >> 4)) * vpitch + (tid & 15) * 8); vreg1 = *(const v4u*)(Vp + (kr_ + 32 + (tid >> 4)) * vpitch + (tid & 15) * 8); } \
        if (MODE == 0 && tid < 16) { const float* cp_ = P.cum + (kr_ + tid * 4) * 4 + head; ckreg = (f32x4){cref - cp_[0], cref - cp_[4], cref - cp_[8], cref - cp_[12]}; } } while (0)
#define ATT_WRITE(st) do { LAS unsigned char* sb_ = lds + (st) * ST_BYTES; \
        *(LAS v4u*)(sb_ + kw0) = kreg0; if (MODE == 1 || (MODE == 2 && tid < 256)) *(LAS v4u*)(sb_ + kw1) = kreg1; \
        *(LAS v4u*)(sb_ + vw0) = vreg0; if (DV == 128) *(LAS v4u*)(sb_ + vw1) = vreg1; \
        if (MODE == 0 && tid < 16) *(LAS f32x4*)(sb_ + ST_CK + tid * 16) = ckreg; } while (0)
    unsigned ka[NS];
#pragma unroll
    for (int s = 0; s < NS; ++s) ka[s] = ST_K + (MODE == 1 ? map * 8192 : 0) + r * KPITCH + (MODE == 2 ? (((2 * s + h) ^ (r & 15)) << 4) : (((2 * s + h) ^ ((r >> 1) & 7)) << 4));
    unsigned va[NDB];
    { const int qp = (lane & 15) >> 2, kb_ = 4 * h + qp, dby = 32 * ((lane >> 4) & 1) + 8 * (lane & 3);
#pragma unroll
      for (int d = 0; d < NDB; ++d) va[d] = ST_V + kb_ * VPITCH + (DV == 64 ? ((d ^ ((qp >> 1) & 1)) << 6) : ((d ^ qp) << 6)) + dby; }
    f32x16 o[NDB];
#pragma unroll
    for (int d = 0; d < NDB; ++d)
#pragma unroll
        for (int i = 0; i < 16; ++i) o[d][i] = 0.f;
    float m_run = MASKV, l_run = 0.f;
    const float slope2 = (MODE == 1) ? exp2f(-2.0f * (float)(head + 1)) * LOG2E : 0.f;
    ATT_LOAD(0); ATT_WRITE(0);
    __syncthreads();
    for (int j = 0; j < NT; ++j) {
        if (j + 1 < NT) ATT_LOAD(j + 1);
        if (j <= jv) {
            LAS const unsigned char* sb = lds + (j & 1) * ST_BYTES;
            f32x16 p0, p1;
            if (MODE == 0) {
#pragma unroll
                for (int g = 0; g < 4; ++g) { const f32x4 c0 = *(LAS const f32x4*)(sb + ST_CK + 16 * h + 32 * g), c1 = *(LAS const f32x4*)(sb + ST_CK + 128 + 16 * h + 32 * g);
#pragma unroll
                    for (int i = 0; i < 4; ++i) { p0[4 * g + i] = c0[i]; p1[4 * g + i] = c1[i]; } }
            } else if (MODE == 1) {
                const float tb = slope2 * (float)(64 * j + 4 * h - (qrow + r));
#pragma unroll
                for (int i = 0; i < 16; ++i) { p0[i] = tb + slope2 * (float)((i & 3) + 8 * (i >> 2)); p1[i] = p0[i] + 32.0f * slope2; }
            } else {
#pragma unroll
                for (int i = 0; i < 16; ++i) { p0[i] = 0.f; p1[i] = 0.f; }
            }
            f32x16 c0s, c1s;
            if (MODE == 1) { c0s = p0; c1s = p1; }
#pragma unroll
            for (int s = 0; s < NS; ++s) {
                const bf16x8 k0 = *(LAS const bf16x8*)(sb + ka[s]), k1 = *(LAS const bf16x8*)(sb + ka[s] + 32 * KPITCH);
                p0 = __builtin_amdgcn_mfma_f32_32x32x16_bf16(k0, qf[s], p0, 0, 0, 0);
                p1 = __builtin_amdgcn_mfma_f32_32x32x16_bf16(k1, qf[s], p1, 0, 0, 0);
            }
            if (j == jv) {
                if (MODE == 0) {
                    const int qrel = (qrow + r) - 64 * j - 4 * h;
#pragma unroll
                    for (int i = 0; i < 16; ++i) { const int kr_ = (i & 3) + 8 * (i >> 2); if (kr_ > qrel) p0[i] = MASKV; if (kr_ + 32 > qrel) p1[i] = MASKV; }
                } else if (MODE == 1) {
#pragma unroll
                    for (int i = 0; i < 16; ++i) { p0[i] -= 2.0f * __builtin_fmaxf(c0s[i], 0.f); p1[i] -= 2.0f * __builtin_fmaxf(c1s[i], 0.f); }
                }
            }
            float tm;
            { float a = max3f(p0[0], p0[1], p1[0]), bq = max3f(p0[2], p0[3], p1[1]); a = max3f(a, p1[2], p1[3]);
#pragma unroll
              for (int i = 4; i < 16; i += 4) { a = max3f(a, p0[i], p0[i + 1]); bq = max3f(bq, p0[i + 2], p0[i + 3]); a = max3f(a, p1[i], p1[i + 1]); bq = max3f(bq, p1[i + 2], p1[i + 3]); }
              tm = halfmax(__builtin_fmaxf(a, bq)); }
            if (__any(tm > m_run + THR)) {
                const float mn = __builtin_fmaxf(m_run, tm), al = __builtin_amdgcn_exp2f(m_run - mn);
                m_run = mn; l_run *= al;
#pragma unroll
                for (int d = 0; d < NDB; ++d)
#pragma unroll
                    for (int i = 0; i < 16; ++i) o[d][i] *= al;
            }
            float ls = 0.f;
#pragma unroll
            for (int i = 0; i < 16; ++i) { p0[i] = __builtin_amdgcn_exp2f(p0[i] - m_run); p1[i] = __builtin_amdgcn_exp2f(p1[i] - m_run); ls += p0[i] + p1[i]; }
            l_run += ls;
            bf16x8 pf[4];
#pragma unroll
            for (int t = 0; t < 2; ++t) {
                v4u w0, w1;
                w0.x = cvtpk(p0[8 * t + 0], p0[8 * t + 1]); w0.y = cvtpk(p0[8 * t + 2], p0[8 * t + 3]); w0.z = cvtpk(p0[8 * t + 4], p0[8 * t + 5]); w0.w = cvtpk(p0[8 * t + 6], p0[8 * t + 7]);
                w1.x = cvtpk(p1[8 * t + 0], p1[8 * t + 1]); w1.y = cvtpk(p1[8 * t + 2], p1[8 * t + 3]); w1.z = cvtpk(p1[8 * t + 4], p1[8 * t + 5]); w1.w = cvtpk(p1[8 * t + 6], p1[8 * t + 7]);
                pf[t] = __builtin_bit_cast(bf16x8, w0); pf[2 + t] = __builtin_bit_cast(bf16x8, w1);
            }
#pragma unroll
            for (int d = 0; d < NDB; ++d)
#pragma unroll
                for (int ks = 0; ks < 4; ++ks) {
                    const s16x4 lo = vtr(sb + va[d] + ks * 16 * VPITCH), hi = vtr(sb + va[d] + ks * 16 * VPITCH + 8 * VPITCH);
                    const bf16x8 vf = (bf16x8){lo[0], lo[1], lo[2], lo[3], hi[0], hi[1], hi[2], hi[3]};
                    o[d] = __builtin_amdgcn_mfma_f32_32x32x16_bf16(vf, pf[ks], o[d], 0, 0, 0);
                }
        }
        if (j + 1 < NT) ATT_WRITE((j + 1) & 1);
        __syncthreads();
    }
#undef ATT_LOAD
#undef ATT_WRITE
    const float linv = 1.0f / halfsum(l_run);
    if (MODE != 1) {
        bf16* orow = Op + (rb + qrow + r) * DM + 4 * h;
#pragma unroll
        for (int d = 0; d < NDB; ++d)
#pragma unroll
            for (int g = 0; g < 4; ++g) { v2u w; w.x = cvtpk(o[d][4 * g] * linv, o[d][4 * g + 1] * linv); w.y = cvtpk(o[d][4 * g + 2] * linv, o[d][4 * g + 3] * linv); *(v2u*)(orow + 32 * d + 8 * g) = w; }
    } else {
        LAS float* ex = (LAS float*)lds;
        if (map == 1) {
#pragma unroll
            for (int d = 0; d < NDB; ++d)
#pragma unroll
                for (int i = 0; i < 16; ++i) ex[((wq * 4 + d) * 16 + i) * 64 + lane] = o[d][i] * linv;
        }
        __syncthreads();
        if (map == 0) {
            float s1 = P.lq1[lane] * P.lk1[lane], s2 = P.lq2[lane] * P.lk2[lane];
            s1 = wave_sum(s1); s2 = wave_sum(s2);
            const float lam = __expf(s1) - __expf(s2) + P.lam_init;
            float ss = 0.f;
#pragma unroll
            for (int d = 0; d < NDB; ++d)
#pragma unroll
                for (int i = 0; i < 16; ++i) { o[d][i] = o[d][i] * linv - lam * ex[((wq * 4 + d) * 16 + i) * 64 + lane]; ss += o[d][i] * o[d][i]; }
            ss = halfsum(ss);
            const float rn = __builtin_amdgcn_rsqf(ss * (1.0f / 128.0f) + EPS) * (1.0f - P.lam_init);
            bf16* orow = Op + (rb + qrow + r) * DM + 4 * h;
#pragma unroll
            for (int d = 0; d < NDB; ++d)
#pragma unroll
                for (int g = 0; g < 4; ++g) { const f32x4 gg = *(const f32x4*)(P.dng + 32 * d + 8 * g + 4 * h);
                    v2u w; w.x = cvtpk(o[d][4 * g] * rn * gg[0], o[d][4 * g + 1] * rn * gg[1]); w.y = cvtpk(o[d][4 * g + 2] * rn * gg[2], o[d][4 * g + 3] * rn * gg[3]); *(v2u*)(orow + 32 * d + 8 * g) = w; }
        }
        __syncthreads();
    }
}

__device__ __forceinline__ void attn_phase(const Params& P, LAS unsigned char* lds, const int* list, int G, int c) {
    for (int rnd = 0; rnd * G < N_ITEMS; ++rnd) {
        const int idx = rnd * G + ((rnd & 1) ? (G - 1 - c) : c);
        if (idx >= N_ITEMS) break;
        const int code = list[idx], type = code & 3, rem = code >> 2;
        if (type == 0) attn_unit<0>(P, lds, (rem / 32) >> 2, (rem / 32) & 3, rem % 32);
        else if (type == 1) attn_unit<1>(P, lds, (rem / 64) >> 2, (rem / 64) & 3, rem % 64);
        else attn_unit<2>(P, lds, (rem / 32) >> 2, (rem / 32) & 3, rem % 32);
    }
}
}
#define XB_TMO      128
#define XB_XCNT(j)  (256  + 64 * (j))
#define XB_XSUB(j)  (1280 + 64 * (j))
#define XB_XGEN(j)  (2304 + 64 * (j))
#define XB_TOP      3328
#define XB_TOPGEN   3392
#define XCD_BAR_WORDS 3456
#define XB_SPIN_CAP (1u << 18)

__device__ __forceinline__ unsigned xb_ld(unsigned* p)              { return __hip_atomic_load(p, __ATOMIC_RELAXED, __HIP_MEMORY_SCOPE_AGENT); }
__device__ __forceinline__ unsigned xb_add(unsigned* p, unsigned v) { return __hip_atomic_fetch_add(p, v, __ATOMIC_RELAXED, __HIP_MEMORY_SCOPE_AGENT); }
__device__ __forceinline__ unsigned xb_xcc_id() { return (unsigned)__builtin_amdgcn_s_getreg((3 << 11) | 20) & 0xFu; }
#define XB_SPIN(cond, bar) do { unsigned _sp = 0; while (cond) { __builtin_amdgcn_s_sleep(1); \
    if ((++_sp & 255u) == 0u) { if (xb_ld(&(bar)[XB_TMO])) break; if (_sp > XB_SPIN_CAP) { atomicAdd(&(bar)[XB_TMO], 1u); break; } } } } while (0)

struct XcdBarrier {
    unsigned* bar; unsigned x;
    volatile LAS unsigned* st;
};

__device__ __forceinline__ XcdBarrier xcd_barrier_post(unsigned* bar, volatile LAS unsigned* st) {
    XcdBarrier b; b.bar = bar; b.x = xb_xcc_id(); b.st = st;
    if (threadIdx.x == 0) (void)xb_add(&bar[XB_XCNT(b.x)], 1u);
    return b;
}
__device__ __forceinline__ void xcd_barrier_complete(unsigned* bar, unsigned x, unsigned& nloc, unsigned& nx) {
    const unsigned G = gridDim.x * gridDim.y * gridDim.z;
    unsigned sum, cnt, mine, sp = 0u;
    for (;;) {
        sum = 0u; cnt = 0u; mine = 0u;
#pragma unroll
        for (unsigned j = 0; j < 16; ++j) { const unsigned c = xb_ld(&bar[XB_XCNT(j)]); sum += c; cnt += (c > 0u) ? 1u : 0u; mine = (j == x) ? c : mine; }
        if (sum == G) break;
        __builtin_amdgcn_s_sleep(1);
        if ((++sp & 255u) == 0u) { if (xb_ld(&bar[XB_TMO])) break; if (sp > XB_SPIN_CAP) { atomicAdd(&bar[XB_TMO], 1u); break; } }
    }
    nloc = mine > 0u ? mine : 1u; nx = cnt > 0u ? cnt : 1u;
}

__device__ __forceinline__ void xcd_barrier(const XcdBarrier& b) {
    asm volatile("s_waitcnt vmcnt(0)" ::: "memory");
    __syncthreads();
    if (threadIdx.x == 0) {
        unsigned* bar = b.bar;
        __builtin_amdgcn_s_waitcnt(0);
        unsigned nloc = b.st[0], nx = b.st[1];
        if (nloc == 0u) { xcd_barrier_complete(bar, b.x, nloc, nx); b.st[0] = nloc; b.st[1] = nx; }
        const unsigned old = xb_add(&bar[XB_XSUB(b.x)], 1u);
        const unsigned gen = old / nloc;
        if (old + 1u == (gen + 1u) * nloc) {
            __builtin_amdgcn_fence(__ATOMIC_RELEASE, "agent");
            asm volatile("s_waitcnt vmcnt(0)" ::: "memory");
            const unsigned og = xb_add(&bar[XB_TOP], 1u);
            const unsigned tg = og / nx;
            if (og + 1u == (tg + 1u) * nx) xb_add(&bar[XB_TOPGEN], 1u);
            else XB_SPIN(xb_ld(&bar[XB_TOPGEN]) == tg, bar);
            __builtin_amdgcn_fence(__ATOMIC_ACQUIRE, "agent");
            xb_add(&bar[XB_XGEN(b.x)], 1u);
            asm volatile("s_waitcnt vmcnt(0)" ::: "memory");
        } else {
            XB_SPIN(xb_ld(&bar[XB_XGEN(b.x)]) == gen, bar);
            __builtin_amdgcn_fence(__ATOMIC_ACQUIRE, "agent");
            asm volatile("s_waitcnt vmcnt(0)" ::: "memory");
        }
    }
    __syncthreads();
}

constexpr int CW_BAR = 4096;
constexpr int MISC_OFF = RING_BYTES + 320;
constexpr size_t WS_ROPE = 234 * MiB;
constexpr size_t WS_ITEMS = 235 * MiB;
constexpr size_t WS_END2 = 236 * MiB;
constexpr int PH_H = 0, PH_M = 1, PH_A = 2, PH_O = 3, PH_U = 4, PH_D = 5, PH_FINAL = 13, NPHASES = 14;

__device__ __forceinline__ void rope_cs(int t, int j, float& c, float& s) {
    const float inv = (float)(1.0 / pow(10000.0, (double)j / 16.0));
    const float ang = (float)t * inv;
    c = (float)cos((double)ang); s = (float)sin((double)ang);
}
__device__ __forceinline__ void rope_table(float2* tab, int gtid, int ngt) {
    for (int i = gtid; i < SEQ * 16; i += ngt) { float c, s; rope_cs(i >> 4, i & 15, c, s); tab[i] = make_float2(c, s); }
}
__device__ __forceinline__ void cum_scan(const float* logf, float* cum, int b, int h, LAS double* part, int tid) {
    double loc[16]; double s = 0.0;
#pragma unroll
    for (int i = 0; i < 16; ++i) { s += (double)logf[(size_t)(b * SEQ + tid * 16 + i) * 4 + h]; loc[i] = s; }
    part[tid] = s;
    __syncthreads();
    double pre = 0.0;
    for (int j = 0; j < tid; ++j) pre += part[j];
#pragma unroll
    for (int i = 0; i < 16; ++i) cum[(size_t)(b * SEQ + tid * 16 + i) * 4 + h] = (float)((pre + loc[i]) * 1.4426950408889634);
    __syncthreads();
}

#define CAS __attribute__((address_space(4)))
__global__ void __launch_bounds__(NTHREADS, 2) fwd(Args args) {
    extern __shared__ __attribute__((aligned(16))) unsigned char lds_raw[];
    LAS unsigned char* lds = (LAS unsigned char*)lds_raw;
    { volatile LAS unsigned* misc = (volatile LAS unsigned*)(lds + MISC_OFF); if (threadIdx.x < 32) misc[threadIdx.x] = 0u; __syncthreads(); }
    XcdBarrier bar; { CAS const Args* apb = (CAS const Args*)__builtin_amdgcn_kernarg_segment_ptr(); bar = xcd_barrier_post((unsigned*)(apb->ws + WS_CTL) + CW_BAR, (volatile LAS unsigned*)(lds + MISC_OFF) + 8); }
    int lo, hi; { CAS const Args* ap0 = (CAS const Args*)__builtin_amdgcn_kernarg_segment_ptr(); lo = ap0->ph_lo; hi = ap0->ph_hi; }
#define IN(k) (lo <= (k) && (k) < hi)
#define SEAM(k) do { if (IN(k) && IN((k) + 1)) xcd_barrier(bar); } while (0)
#define FRAME() \
    int tid = threadIdx.x; asm volatile("" : "+v"(tid)); \
    CAS const Args* ap = (CAS const Args*)__builtin_amdgcn_kernarg_segment_ptr(); asm volatile("" : "+s"(ap)); unsigned char* ws = ap->ws; \
    const int lane = tid & 63, wave = __builtin_amdgcn_readfirstlane(tid >> 6); \
    int G_ = gridDim.x, bx_ = blockIdx.x; asm volatile("" : "+s"(G_), "+s"(bx_)); const int G = __builtin_amdgcn_readfirstlane(G_), bx = __builtin_amdgcn_readfirstlane(bx_); \
    const int vcu = (G % 8 == 0) ? (bx % 8) * (G / 8) + bx / 8 : bx; \
    const int gw = vcu * NWAVES + wave, ngw = G * NWAVES; \
    float* sm = (float*)(ws + WS_SM); (void)lane; (void)gw; (void)ngw; (void)sm;
    if (IN(0)) { FRAME(); p0_prologue(ap, lds, gw, ngw, lane, wave); rope_table((float2*)(ws + WS_ROPE), gw * 64 + lane, ngw * 64); att::build_items((int*)(ws + WS_ITEMS), gw * 64 + lane, ngw * 64); }
    SEAM(0);
    for (int l = 0; l < DEPTH; ++l) {
        const int pb = 1 + 6 * l;
        if (IN(pb + PH_H)) {
            FRAME();
            unsigned char* wl = ws + WS_W + (size_t)l * WS_WL;
            pg8::Gemm g{(const bf16*)(ws + WS_XB), (const bf16*)(wl + W_IN), MTOK, HN, DM, DM}; pg8::StaticOrder S; S.init(MTOK, HN, G, bx);
            pg8::EpiH E{ws, ap->in[I_FB] + l * 4, l};
            pg8::gemm_phase<pg8::EpiH, pg8::StaticOrder, true, true>(lds, g, S, E);
        }
        SEAM(pb + PH_H);
        if (IN(pb + PH_M)) {
            { FRAME(); unsigned char* wl = ws + WS_W + (size_t)l * WS_WL;
              pg8::Gemm g{(const bf16*)(ws + WS_HB) + H_CQ, (const bf16*)(wl + W_UQ), MTOK, 512, 256, HN}; pg8::HalfOrder S; S.init(MTOK, 512, G, bx, 0);
              pg8::EpiQ E{(bf16*)(ws + WS_QM), sm + SM_SSQ / 4 + l * MTOK, (const float2*)(ws + WS_ROPE)}; pg8::gemm_phase<pg8::EpiQ, pg8::HalfOrder, true, true>(lds, g, S, E); }
            { FRAME(); unsigned char* wl = ws + WS_W + (size_t)l * WS_WL;
              pg8::Gemm g{(const bf16*)(ws + WS_HB) + H_CKV, (const bf16*)(wl + W_UKV), MTOK, 512, 128, HN}; pg8::HalfOrder S; S.init(MTOK, 512, G, bx, 1);
              pg8::EpiKV E{(bf16*)(ws + WS_KVM), sm + SM_SSKV / 4 + l * MTOK}; pg8::gemm_phase<pg8::EpiKV, pg8::HalfOrder, true, true>(lds, g, S, E); }
            { FRAME(); const bf16* HB = (const bf16*)(ws + WS_HB); bf16* KR = (bf16*)(ws + WS_KR); const float2* rope = (const float2*)(ws + WS_ROPE);
              for (int i = (gw * 64 + lane); i < MTOK * 16; i += ngw * 64) {
                const int j = i & 15, row = i >> 4; const float2 cs = rope[(size_t)(row & (SEQ - 1)) * 16 + j];
                const float x1 = bf2f(HB[(size_t)row * HN + H_KR + j]), x2 = bf2f(HB[(size_t)row * HN + H_KR + 16 + j]);
                *(unsigned*)(KR + (size_t)row * 32 + 2 * j) = pk2(x1 * cs.x - x2 * cs.y, x1 * cs.y + x2 * cs.x);
              }
              __syncthreads();
              if (bx < 8) cum_scan(sm + SM_LOGF / 4, sm + SM_CUM / 4, bx >> 2, bx & 3, (LAS double*)lds, tid); }
        }
        SEAM(pb + PH_M);
        if (IN(pb + PH_A)) {
            FRAME();
            const float lam_init = l == 0 ? 0.2f : 0.35550906759096934f;
            att::Params P{(const bf16*)(ws + WS_HB), (const bf16*)(ws + WS_QM), (const bf16*)(ws + WS_KVM), (const bf16*)(ws + WS_KR), (bf16*)(ws + WS_AO), sm + SM_CUM / 4,
                          ap->in[I_LQ1] + l * 64, ap->in[I_LK1] + l * 64, ap->in[I_LQ2] + l * 64, ap->in[I_LK2] + l * 64, ap->in[I_DNG] + l * 128, lam_init, 0};
            att::attn_phase(P, lds, (const int*)(ws + WS_ITEMS), G, vcu);
        }
        SEAM(pb + PH_A);
        if (IN(pb + PH_O)) {
            FRAME(); unsigned char* wl = ws + WS_W + (size_t)l * WS_WL;
            pg8::Gemm g{(const bf16*)(ws + WS_AO), (const bf16*)(wl + W_O), MTOK, DM, DM, DM}; pg8::StaticOrder S; S.init(MTOK, DM, G, bx);
            pg8::EpiRes E{l == 0 ? ap->in[I_X] : ap->out, ap->out, (bf16*)(ws + WS_XB), sm + SM_SS2 / 4 + l * MTOK};
            pg8::gemm_phase<pg8::EpiRes, pg8::StaticOrder, true, true>(lds, g, S, E);
        }
        SEAM(pb + PH_O);
        if (IN(pb + PH_U)) {
            FRAME(); unsigned char* wl = ws + WS_W + (size_t)l * WS_WL;
            pg8::Gemm g{(const bf16*)(ws + WS_XB), (const bf16*)(wl + W_UP), MTOK, NUP, DM, DM}; pg8::UpOrder S; S.init_up(G, bx);
            pg8::EpiUp E{ws, ap->in[I_CW] + (size_t)l * 3 * NUP, ap->in[I_CB] + (size_t)l * NUP, l};
            pg8::gemm_phase<pg8::EpiUp, pg8::UpOrder, true, true>(lds, g, S, E);
        }
        SEAM(pb + PH_U);
        if (IN(pb + PH_D)) {
            FRAME(); unsigned char* wl = ws + WS_W + (size_t)l * WS_WL;
            pg8::Gemm g{(const bf16*)(ws + WS_HB), (const bf16*)(wl + W_DN), MTOK, DM, DFF, DFF}; pg8::StaticOrder S; S.init(MTOK, DM, G, bx);
            pg8::EpiRes E{ap->out, ap->out, (bf16*)(ws + WS_XB), sm + SM_SS1N / 4 + l * MTOK};
            pg8::gemm_phase<pg8::EpiRes, pg8::StaticOrder, true, true>(lds, g, S, E);
        }
        SEAM(pb + PH_D);
    }
    if (IN(PH_FINAL)) {
        FRAME();
        const float* ss = sm + SM_SS1N / 4 + (DEPTH - 1) * MTOK; const float4* gr = (const float4*)ap->in[I_FG] + lane;
        for (int row = gw; row < MTOK; row += ngw) {
            const float r = __builtin_amdgcn_rsqf(ss[row] * (1.0f / DM) + EPS);
            float4* xr = (float4*)(ap->out + (size_t)row * DM) + lane;
#pragma unroll
            for (int j = 0; j < 4; ++j) { float4 v = xr[64 * j]; const float4 gg = gr[64 * j]; v.x *= r * gg.x; v.y *= r * gg.y; v.z *= r * gg.z; v.w *= r * gg.w; xr[64 * j] = v; }
        }
    }
#undef IN
#undef SEAM
#undef FRAME
}
#ifndef N_LAUNCHES
#define N_LAUNCHES 1
#endif
extern "C" void kernel_launch(void* const* d_in, const int* in_sizes, int n_in, void* d_out, int out_size, void* d_ws, size_t ws_size, hipStream_t stream) {
    static int grid = 0;
    if (!grid) {
        if (n_in != 20 || ws_size < WS_END2 || out_size != MTOK * DM) { fprintf(stderr, "kernel_launch: unexpected n_in %d / out_size %d / ws_size %zu\n", n_in, out_size, ws_size); grid = -1; return; }
        if (hipFuncSetAttribute((const void*)fwd, hipFuncAttributeMaxDynamicSharedMemorySize, LDS_BYTES) != hipSuccess) { fprintf(stderr, "hipFuncSetAttribute failed\n"); grid = -1; return; }
        int dev = 0, cus = 0, per_cu = 0;
        if (hipGetDevice(&dev) != hipSuccess || hipDeviceGetAttribute(&cus, hipDeviceAttributeMultiprocessorCount, dev) != hipSuccess) { grid = -1; return; }
        if (hipOccupancyMaxActiveBlocksPerMultiprocessor(&per_cu, (const void*)fwd, NTHREADS, LDS_BYTES) != hipSuccess || per_cu < 1) { fprintf(stderr, "occupancy query failed (%d)\n", per_cu); grid = -1; return; }
        grid = cus;
        if (grid != 256) fprintf(stderr, "kernel_launch: note: %d CUs\n", grid);
    }
    if (grid < 0) return;
    Args a{};
    for (int i = 0; i < 20; ++i) a.in[i] = (const float*)d_in[i];
    a.out = (float*)d_out; a.ws = (unsigned char*)d_ws;
    (void)hipMemsetAsync((unsigned char*)d_ws + WS_CTL, 0, 1 * MiB, stream);
    if (N_LAUNCHES == 1) {
        a.ph_lo = 0; a.ph_hi = NPHASES;
        hipLaunchKernelGGL(fwd, dim3(grid), dim3(NTHREADS), LDS_BYTES, stream, a);
    } else {
        for (int p = 0; p < NPHASES; ++p) { a.ph_lo = p; a.ph_hi = p + 1; hipLaunchKernelGGL(fwd, dim3(grid), dim3(NTHREADS), LDS_BYTES, stream, a);
#ifdef DUP_PHASE
            if (p >= 1 && p < PH_FINAL && (p - 1) % 6 == DUP_PHASE) hipLaunchKernelGGL(fwd, dim3(grid), dim3(NTHREADS), LDS_BYTES, stream, a);
#endif
        }
    }
}
```

```cpp
#include <hip/hip_runtime.h>
#include <cstdio>
#include <cstdint>

constexpr int BATCH = 2, SEQ = 8192, DM = 1024, DEPTH = 2, MTOK = BATCH * SEQ;
constexpr int IN_COLS = 2724, DFF = 2816, NUP = 2 * DFF;
constexpr int HN = 2816;
constexpr int H_FQ = 0, H_FK = 256, H_FV = 512, H_DQ = 768, H_DK = 1280, H_DV = 1792, H_CQ = 2304, H_CKV = 2560, H_KR = 2688, H_FF = 2720;
constexpr float EPS = 1e-6f;
constexpr float LOG2E = 1.4426950408889634f;
constexpr float NEGV = -1e30f;

constexpr size_t MiB = 1u << 20;
constexpr size_t WS_CTL = 0;
constexpr size_t WS_W = 1 * MiB, WS_WL = 25 * MiB;
constexpr size_t W_IN = 0, W_UQ = 5632 * 1024, W_UKV = W_UQ + 256 * 1024, W_O = 6 * MiB, W_UP = 8 * MiB, W_DN = 19 * MiB;
constexpr size_t WS_XB = 51 * MiB;
constexpr size_t WS_SM = 83 * MiB;
constexpr size_t SM_RSTD1 = 0;
constexpr size_t SM_SSQ = 64 * 1024, SM_SSKV = 192 * 1024, SM_SS2 = 320 * 1024, SM_SS1N = 448 * 1024;
constexpr size_t SM_LOGF = 576 * 1024, SM_CUM = 832 * 1024;
constexpr size_t SM_ZERO_BEG = SM_SSQ, SM_ZERO_END = SM_LOGF;
constexpr size_t SM_KMAX = 1088 * 1024;
constexpr size_t WS_HB = 85 * MiB;
constexpr size_t WS_QM = 173 * MiB;
constexpr size_t WS_KVM = 185 * MiB;
constexpr size_t WS_KR = 201 * MiB;
constexpr size_t WS_AO = 202 * MiB;
constexpr size_t WS_END = 234 * MiB;

#define LAS __attribute__((address_space(3)))
typedef unsigned short bf16;
typedef float f32x16 __attribute__((ext_vector_type(16)));
typedef unsigned v4u __attribute__((ext_vector_type(4)));
typedef unsigned v2u __attribute__((ext_vector_type(2)));
__device__ __forceinline__ unsigned f2bf(float f) { unsigned u = __builtin_bit_cast(unsigned, f); return (u + 0x7fffu + ((u >> 16) & 1u)) >> 16; }
__device__ __forceinline__ unsigned pk2(float lo, float hi) { return f2bf(lo) | (f2bf(hi) << 16); }
__device__ __forceinline__ float bf2f(unsigned b) { return __builtin_bit_cast(float, (b & 0xffffu) << 16); }
__device__ __forceinline__ float bflo(unsigned w) { return __builtin_bit_cast(float, w << 16); }
__device__ __forceinline__ float bfhi(unsigned w) { return __builtin_bit_cast(float, w & 0xffff0000u); }

namespace pg8 {
#define PG8_LAS __attribute__((address_space(3)))
typedef unsigned short bf16_t;
typedef short bf16x8 __attribute__((ext_vector_type(8)));
typedef float f32x4 __attribute__((ext_vector_type(4)));
typedef unsigned u32x4 __attribute__((ext_vector_type(4)));
constexpr int BM = 256, BK = 64, HALF = 128, HTB = HALF * BK * 2  , STAGE_BYTES = 8 * HTB, NXCD = 8, WGM = 8;

__host__ __device__ __forceinline__ int lds_byte(int r, int c) { const int st = (r >> 4) * 2 + (c >> 5), rr = r & 15, cc = c & 31, ob = rr * 64 + cc * 2; return st * 1024 + (ob ^ (((ob >> 9) & 1) << 5)); }
__host__ __device__ __forceinline__ void stage_rc(int b, int& R, int& C) { const int st = b / 1024, sb = b % 1024, swz = sb ^ (((sb >> 9) & 1) << 5); R = (st >> 1) * 16 + swz / 64; C = (st & 1) * 32 + (swz % 64) / 2; }
__host__ __device__ __forceinline__ int perm32(int rho) { const int n = rho >> 4, i = rho & 15; return 8 * (i >> 2) + 4 * n + (i & 3); }

struct Unit { int pm, pn; };
struct Gemm { const bf16_t* A; const bf16_t* Bt; int M, N, K, lda; };

struct StaticOrder {
    int nM, nN, nwg, G, c;
    __host__ __device__ void init(int M, int N, int G_, int c_) { nM = M / BM; nN = N / BM; nwg = nM * nN; G = G_; c = c_; }
    __host__ __device__ bool next(int i, Unit& u) const {
        const long L = (long)i * G + c; if (L >= nwg) return false;
        int wgid = (int)L; { const int q = nwg / NXCD, r = nwg % NXCD, xcd = wgid % NXCD, off = wgid / NXCD; wgid = (xcd < r ? xcd * (q + 1) : r * (q + 1) + (xcd - r) * q) + off; }
        const int nig = WGM * nN, gid = wgid / nig, fm = gid * WGM, gsz = (nM - fm) < WGM ? (nM - fm) : WGM;
        u.pm = fm + ((wgid % nig) % gsz); u.pn = (wgid % nig) / gsz; return true;
    }
    __device__ __forceinline__ int arow(const Unit& u) const { return u.pm * BM; }
    __device__ __forceinline__ int arperm(int R) const { return R; }
    __device__ __forceinline__ int ahalf() const { return HALF; }
    __device__ __forceinline__ void a_ready(const Unit&) const {}
    __device__ __forceinline__ void done(const Unit&) const {}
};

__device__ __forceinline__ unsigned cvt_pk_bf16(float lo, float hi) { unsigned r; asm volatile("v_cvt_pk_bf16_f32 %0, %1, %2" : "=v"(r) : "v"(lo), "v"(hi)); return r; }
typedef float f32x2 __attribute__((ext_vector_type(2)));
__device__ __forceinline__ void glds16_s(unsigned voff, const void* sbase, unsigned ldsdst) {
    unsigned keep; ldsdst = __builtin_amdgcn_readfirstlane(ldsdst);
    { const unsigned long long p_ = (unsigned long long)sbase; sbase = (const void*)(((unsigned long long)(unsigned)__builtin_amdgcn_readfirstlane((unsigned)(p_ >> 32)) << 32) | (unsigned)__builtin_amdgcn_readfirstlane((unsigned)p_)); }
    asm volatile("s_mov_b32 %0, m0\n\ts_mov_b32 m0, %3\n\ts_nop 2\n\tglobal_load_lds_dwordx4 %1, %2\n\ts_mov_b32 m0, %0" : "=&s"(keep) : "v"(voff), "s"(sbase), "s"(ldsdst) : "memory");
}
template <class Epi, class Sched, bool ALIGN_EPI = false, bool SP2 = false>
__device__ __forceinline__ void gemm_phase(PG8_LAS unsigned char* lds, const Gemm g, const Sched& S, const Epi& E) {
    int tid_l = threadIdx.x; asm volatile("" : "+v"(tid_l));
    const int tid = tid_l, wid = __builtin_amdgcn_readfirstlane(tid >> 6), lane = tid & 63, wr = wid >> 2, wc = wid & 3, fr = lane & 15, fq = lane >> 4;
    const int K = g.K, nt = K / BK;
    unsigned voffA[2], voffB[2];
#pragma unroll
    for (int i = 0; i < 2; ++i) { int R, C; stage_rc(tid * 16 + i * 8192, R, C); const int Rb = Epi::PERM ? ((R & ~31) + perm32(R & 31)) : R;
        voffA[i] = (unsigned)(S.arperm(R) * g.lda + C) * 2u; voffB[i] = (unsigned)(Rb * K + C) * 2u; }
    const unsigned kstep = (unsigned)(BK * 2);
    const unsigned hstep = (unsigned)HALF * K * 2; const unsigned hstepA = (unsigned)S.ahalf() * g.lda * 2;
    const unsigned tstep = 2 * hstep;
    const unsigned ldsw = (unsigned)wid * 1024u;
    const int aoff = lds_byte(wr * 64 + fr, fq * 8), boff = lds_byte(wc * 32 + fr, fq * 8);
#define PG8_SA(b, h) (((b) * 2 + (h)) * HTB)
#define PG8_SB(b, h) ((4 + (b) * 2 + (h)) * HTB)
#define PG8_STAGE(bufoff, gbase, voff) do { _Pragma("unroll") for (int _i = 0; _i < 2; ++_i) \
        glds16_s((voff)[_i], (const char*)(gbase), (unsigned)(uintptr_t)(lds + (bufoff) + ldsw + _i * 8192)); } while (0)
#define PG8_LDA(dst, b, h) do { _Pragma("unroll") for (int m = 0; m < 4; ++m) _Pragma("unroll") for (int k = 0; k < 2; ++k) dst[m][k] = *(const PG8_LAS bf16x8*)(lds + PG8_SA(b, h) + aoff + m * 2048 + k * 1024); } while (0)
#define PG8_LDB(dst, b, h) do { _Pragma("unroll") for (int n = 0; n < 2; ++n) _Pragma("unroll") for (int k = 0; k < 2; ++k) dst[n][k] = *(const PG8_LAS bf16x8*)(lds + PG8_SB(b, h) + boff + n * 2048 + k * 1024); } while (0)
#define PG8_MMA(ai, bj, At, Bt) do { __builtin_amdgcn_s_setprio(1); _Pragma("unroll") for (int m = 0; m < 4; ++m) _Pragma("unroll") for (int n = 0; n < 2; ++n) _Pragma("unroll") for (int k = 0; k < 2; ++k) \
        acc[ai][bj][m][n] = __builtin_amdgcn_mfma_f32_16x16x32_bf16(Bt[n][k], At[m][k], acc[ai][bj][m][n], 0, 0, 0); __builtin_amdgcn_s_setprio(0); } while (0)
#define PG8_WAIT_V(n) asm volatile("s_waitcnt vmcnt(" #n ")" ::: "memory")
#define PG8_WAIT_L(n) asm volatile("s_waitcnt lgkmcnt(" #n ")" ::: "memory")
#define PG8_BAR __builtin_amdgcn_s_barrier()
#define PG8_SCHED __builtin_amdgcn_sched_barrier(0)
    Unit cur, nxt; int ui = 0;
    if (!S.next(0, cur)) return;
    f32x4 acc[2][2][4][2];
#pragma unroll
    for (int a = 0; a < 2; ++a)
#pragma unroll
        for (int b = 0; b < 2; ++b)
#pragma unroll
            for (int m = 0; m < 4; ++m)
#pragma unroll
                for (int n = 0; n < 2; ++n) acc[a][b][m][n] = (f32x4){0.f, 0.f, 0.f, 0.f};
    bf16x8 At[4][2], B0[2][2], B1[2][2];
    const char* cA = (const char*)g.A + (size_t)S.arow(cur) * g.lda * 2; const char* cB = (const char*)g.Bt + (size_t)cur.pn * tstep;
    S.a_ready(cur);
    if constexpr (SP2) {
        PG8_STAGE(PG8_SB(0, 0), cB, voffB); PG8_STAGE(PG8_SB(0, 1), cB + hstep, voffB); PG8_STAGE(PG8_SA(0, 0), cA, voffA); PG8_STAGE(PG8_SA(0, 1), cA + hstepA, voffA);
        if (wr == 1) PG8_BAR;
        PG8_WAIT_V(2); PG8_BAR;
        PG8_STAGE(PG8_SB(1, 0), cB + kstep, voffB); PG8_STAGE(PG8_SA(1, 0), cA + kstep, voffA); PG8_STAGE(PG8_SB(1, 1), cB + hstep + kstep, voffB);
        PG8_WAIT_V(6); PG8_BAR;
    } else {
        PG8_STAGE(PG8_SB(0, 0), cB, voffB); PG8_STAGE(PG8_SA(0, 0), cA, voffA); PG8_STAGE(PG8_SB(0, 1), cB + hstep, voffB); PG8_STAGE(PG8_SA(0, 1), cA + hstepA, voffA);
        if (wr == 1) PG8_BAR;
        PG8_WAIT_V(4); PG8_BAR;
        PG8_STAGE(PG8_SB(1, 0), cB + kstep, voffB); PG8_STAGE(PG8_SA(1, 0), cA + kstep, voffA); PG8_STAGE(PG8_SB(1, 1), cB + hstep + kstep, voffB);
        PG8_WAIT_V(6); PG8_BAR;
    }
    for (;;) {
        const bool has_next = S.next(ui + 1, nxt);
        const char* nA = has_next ? (const char*)g.A + (size_t)S.arow(nxt) * g.lda * 2 : cA; const char* nB = has_next ? (const char*)g.Bt + (size_t)nxt.pn * tstep : cB;
        for (int t = 0; t < nt; t += 2) {
            const bool last = (t == nt - 2);
            const char* a1 = cA + (size_t)(t + 1) * kstep;
            const char* a2 = last ? nA : cA + (size_t)(t + 2) * kstep; const char* b2 = last ? nB : cB + (size_t)(t + 2) * kstep;
            const char* a3 = a2 + kstep; const char* b3 = b2 + kstep;
            if (last && has_next) S.a_ready(nxt);
            if constexpr (SP2) {
            PG8_LDB(B0, 0, 0); PG8_LDB(B1, 0, 1); PG8_SCHED; PG8_LDA(At, 0, 0); PG8_STAGE(PG8_SA(1, 1), a1 + hstepA, voffA);
            PG8_WAIT_V(8); PG8_WAIT_L(0); PG8_BAR; PG8_MMA(0, 0, At, B0); PG8_MMA(0, 1, At, B1); PG8_BAR; PG8_SCHED;
            PG8_LDA(At, 0, 1); PG8_STAGE(PG8_SB(0, 0), b2, voffB); PG8_STAGE(PG8_SB(0, 1), b2 + hstep, voffB); PG8_STAGE(PG8_SA(0, 0), a2, voffA);
            PG8_WAIT_V(8); PG8_WAIT_L(0); PG8_BAR; PG8_MMA(1, 0, At, B0); PG8_MMA(1, 1, At, B1); PG8_BAR; PG8_SCHED;
            PG8_LDB(B0, 1, 0); PG8_LDB(B1, 1, 1); PG8_SCHED; PG8_LDA(At, 1, 0); PG8_STAGE(PG8_SA(0, 1), a2 + hstepA, voffA);
            PG8_WAIT_V(8); PG8_WAIT_L(0); PG8_BAR; PG8_MMA(0, 0, At, B0); PG8_MMA(0, 1, At, B1); PG8_BAR; PG8_SCHED;
            PG8_LDA(At, 1, 1); PG8_STAGE(PG8_SB(1, 0), b3, voffB); PG8_STAGE(PG8_SB(1, 1), b3 + hstep, voffB); PG8_STAGE(PG8_SA(1, 0), a3, voffA);
            PG8_WAIT_V(8); PG8_WAIT_L(0); PG8_BAR; PG8_MMA(1, 0, At, B0); PG8_MMA(1, 1, At, B1); PG8_BAR; PG8_SCHED;
            } else {
            PG8_LDB(B0, 0, 0); PG8_SCHED; PG8_LDA(At, 0, 0); PG8_STAGE(PG8_SA(1, 1), a1 + hstepA, voffA);
            PG8_WAIT_L(8); PG8_BAR; PG8_WAIT_L(0); PG8_MMA(0, 0, At, B0); PG8_BAR; PG8_SCHED;
            PG8_LDB(B1, 0, 1); PG8_STAGE(PG8_SB(0, 0), b2, voffB);
            PG8_BAR; PG8_WAIT_L(0); PG8_MMA(0, 1, At, B1); PG8_BAR;
            PG8_LDA(At, 0, 1); PG8_STAGE(PG8_SA(0, 0), a2, voffA);
            PG8_BAR; PG8_WAIT_L(0); PG8_MMA(1, 0, At, B0); PG8_BAR; PG8_SCHED;
            PG8_STAGE(PG8_SB(0, 1), b2 + hstep, voffB);
            PG8_WAIT_V(6); PG8_BAR; PG8_MMA(1, 1, At, B1); PG8_BAR;
            PG8_LDB(B0, 1, 0); PG8_SCHED; PG8_LDA(At, 1, 0); PG8_STAGE(PG8_SA(0, 1), a2 + hstepA, voffA);
            PG8_WAIT_L(8); PG8_BAR; PG8_WAIT_L(0); PG8_MMA(0, 0, At, B0); PG8_BAR; PG8_SCHED;
            PG8_LDB(B1, 1, 1); PG8_STAGE(PG8_SB(1, 0), b3, voffB);
            PG8_BAR; PG8_WAIT_L(0); PG8_MMA(0, 1, At, B1); PG8_BAR;
            PG8_LDA(At, 1, 1); PG8_STAGE(PG8_SA(1, 0), a3, voffA);
            PG8_BAR; PG8_WAIT_L(0); PG8_MMA(1, 0, At, B0); PG8_BAR; PG8_SCHED;
            PG8_STAGE(PG8_SB(1, 1), b3 + hstep, voffB);
            PG8_WAIT_V(6); PG8_BAR; PG8_MMA(1, 1, At, B1); PG8_BAR;
            }
        }
        if constexpr (ALIGN_EPI) { if (wr == 0) PG8_BAR; }
        if constexpr (!Epi::AFTER_DRAIN) { E(acc, cur, wr, wc, fr, fq); S.done(cur); }
        if (!has_next) break;
#pragma unroll
        for (int a = 0; a < 2; ++a)
#pragma unroll
            for (int b = 0; b < 2; ++b)
#pragma unroll
                for (int m = 0; m < 4; ++m)
#pragma unroll
                    for (int n = 0; n < 2; ++n) acc[a][b][m][n] = (f32x4){0.f, 0.f, 0.f, 0.f};
        cur = nxt; cA = nA; cB = nB; ++ui;
        if constexpr (ALIGN_EPI) { if (wr == 1) PG8_BAR; }
    }
    PG8_WAIT_V(0);
    if constexpr (!ALIGN_EPI) { if (wr == 0) PG8_BAR; }
    PG8_BAR;
    if constexpr (Epi::AFTER_DRAIN) { E.fused(acc, cur, wr, wc, fr, fq, lds, wid, lane); S.done(cur); }
#undef PG8_SA
#undef PG8_SB
#undef PG8_STAGE
#undef PG8_LDA
#undef PG8_LDB
#undef PG8_MMA
#undef PG8_WAIT_V
#undef PG8_WAIT_L
#undef PG8_BAR
#undef PG8_SCHED
}
}
constexpr int NWAVES = 8, NTHREADS = 512;
constexpr int RING_BYTES = 131072, LDS_BYTES = 147456;
struct Args { const float* in[20]; float* out; unsigned char* ws; int ph_lo, ph_hi, layer, pad; };
enum { I_X = 0, I_LN1G, I_WIN, I_FB, I_LQ1, I_LK1, I_LQ2, I_LK2, I_DNG, I_QNG, I_WUQ, I_KVNG, I_WUKV, I_WO, I_LN2G, I_WUP, I_CW, I_CB, I_WDN, I_FG };

__device__ __forceinline__ float wave_sum(float v) {
#pragma unroll
    for (int o = 1; o < 64; o <<= 1) v += __shfl_xor(v, o);
    return v;
}
struct MapIn {
    __device__ __forceinline__ int src(int n) const { return n < 768 ? n : (n < 2720 ? n + 4 : (n < 2724 ? n - 2720 + 768 : -1)); }
    __device__ __forceinline__ float scale(int n) const { return (n < 256 || (n >= H_DQ && n < H_DK)) ? 0.125f * LOG2E : 1.0f; }
};
struct MapUq {
    __device__ __forceinline__ int src(int n) const { if (n >= 384) return -1; const int h = n / 96, d = n % 96; if (d < 64) return n; const int jj = d - 64; return h * 96 + 64 + (jj >> 1) + 16 * (jj & 1); }
    __device__ __forceinline__ float scale(int) const { return 0.10206207261596577f * LOG2E; }
};
struct MapId {
    __device__ __forceinline__ int src(int n) const { return n; }
    __device__ __forceinline__ float scale(int) const { return 1.0f; }
};
struct MapUp {
    __device__ __forceinline__ int src(int n) const { return ((n >> 7) & 1) * DFF + 128 * (n >> 8) + (n & 127); }
    __device__ __forceinline__ float scale(int) const { return 1.0f; }
};
template <class Map>
__device__ __forceinline__ void wprep_item(const float* W, int ldw, int K, bf16* WT, int nblk, LAS float* scr, int item, int lane, const float* gk, const Map map) {
    const int kb = item / nblk, nb = item % nblk, k0 = 64 * kb, n0 = 32 * nb;
    const int nd = n0 + (lane & 31), sc = map.src(nd); const float cs = map.scale(nd);
#pragma unroll 8
    for (int i = 0; i < 32; ++i) { const int kk = 2 * i + (lane >> 5); float v = (sc >= 0) ? W[(size_t)(k0 + kk) * ldw + sc] : 0.f; if (gk) v *= gk[k0 + kk]; scr[kk * 33 + (lane & 31)] = v * cs; }
    asm volatile("s_waitcnt lgkmcnt(0)" ::: "memory");
    const int c = lane & 7;
#pragma unroll
    for (int j = 0; j < 4; ++j) { const int n = (lane >> 3) + 8 * j; const LAS float* s = scr + (8 * c) * 33 + n;
        v4u o; o.x = pk2(s[0 * 33], s[1 * 33]); o.y = pk2(s[2 * 33], s[3 * 33]); o.z = pk2(s[4 * 33], s[5 * 33]); o.w = pk2(s[6 * 33], s[7 * 33]);
        *(v4u*)(WT + (size_t)(n0 + n) * K + k0 + 8 * c) = o; }
    asm volatile("s_waitcnt lgkmcnt(0)" ::: "memory");
}
__device__ __forceinline__ void xprep_row(const float* xrow, bf16* orow, float* rstd, int lane) {
    const float4* xr = (const float4*)xrow + lane;
    float4 v[4]; float s = 0.f;
#pragma unroll
    for (int j = 0; j < 4; ++j) { v[j] = xr[64 * j]; s += (v[j].x * v[j].x + v[j].y * v[j].y) + (v[j].z * v[j].z + v[j].w * v[j].w); }
    s = wave_sum(s);
    if (lane == 0) *rstd = s;
    v2u* o8 = (v2u*)orow + lane;
#pragma unroll
    for (int j = 0; j < 4; ++j) { v2u w; w.x = pk2(v[j].x, v[j].y); w.y = pk2(v[j].z, v[j].w); o8[64 * j] = w; }
}
__device__ __forceinline__ void p0_prologue(const __attribute__((address_space(4))) Args* ap_, LAS unsigned char* lds, int gw, int ngw, int lane, int wave) {
    LAS float* scr = (LAS float*)(lds + wave * 16384);
    unsigned char* ws = ap_->ws;
    constexpr int I_IN = 16 * 88, I_UQ = 4 * 16, I_UKV = 2 * 16, I_O = 16 * 32, I_UP = 16 * 176, I_DN = 44 * 32, I_L = I_IN + I_UQ + I_UKV + I_O + I_UP + I_DN;
    for (int it = gw; it < 2 * I_L; it += ngw) {
        const int l = it / I_L; int r = it % I_L;
        unsigned char* wl = ws + WS_W + (size_t)l * WS_WL;
        if (r < I_IN) { wprep_item(ap_->in[I_WIN] + (size_t)l * DM * IN_COLS, IN_COLS, DM, (bf16*)(wl + W_IN), 88, scr, r, lane, ap_->in[I_LN1G] + l * DM, MapIn()); continue; } r -= I_IN;
        if (r < I_UQ) { wprep_item(ap_->in[I_WUQ] + (size_t)l * 256 * 384, 384, 256, (bf16*)(wl + W_UQ), 16, scr, r, lane, ap_->in[I_QNG] + l * 256, MapUq()); continue; } r -= I_UQ;
        if (r < I_UKV) { wprep_item(ap_->in[I_WUKV] + (size_t)l * 128 * 512, 512, 128, (bf16*)(wl + W_UKV), 16, scr, r, lane, ap_->in[I_KVNG] + l * 128, MapId()); continue; } r -= I_UKV;
        if (r < I_O) { wprep_item(ap_->in[I_WO] + (size_t)l * DM * DM, DM, DM, (bf16*)(wl + W_O), 32, scr, r, lane, (const float*)nullptr, MapId()); continue; } r -= I_O;
        if (r < I_UP) { wprep_item(ap_->in[I_WUP] + (size_t)l * DM * NUP, NUP, DM, (bf16*)(wl + W_UP), 176, scr, r, lane, ap_->in[I_LN2G] + l * DM, MapUp()); continue; } r -= I_UP;
        wprep_item(ap_->in[I_WDN] + (size_t)l * DFF * DM, DM, DFF, (bf16*)(wl + W_DN), 32, scr, r, lane, (const float*)nullptr, MapId());
    }
    float* rstd1 = (float*)(ws + WS_SM + SM_RSTD1);
    for (int m = gw; m < MTOK; m += ngw) xprep_row(ap_->in[I_X] + (size_t)m * DM, (bf16*)(ws + WS_XB) + (size_t)m * DM, rstd1 + m, lane);
    float* z = (float*)(ws + WS_SM + SM_ZERO_BEG); const int nz = (int)((SM_ZERO_END - SM_ZERO_BEG) / 4);
    for (int i = gw * 64 + lane; i < nz; i += ngw * 64) z[i] = 0.f;
    if (gw == 0) ((float*)(ws + WS_SM + SM_KMAX))[lane] = 0.f;
}
namespace pg8 {
__device__ __forceinline__ u32x4 pack8(const f32x4 v0, const f32x4 v1) { u32x4 w; w.x = cvt_pk_bf16(v0[0], v0[1]); w.y = cvt_pk_bf16(v0[2], v0[3]); w.z = cvt_pk_bf16(v1[0], v1[1]); w.w = cvt_pk_bf16(v1[2], v1[3]); return w; }
__device__ __forceinline__ float sq8(const f32x4 a, const f32x4 b) { return (a[0] * a[0] + a[1] * a[1]) + (a[2] * a[2] + a[3] * a[3]) + (b[0] * b[0] + b[1] * b[1]) + (b[2] * b[2] + b[3] * b[3]); }
__device__ __forceinline__ float log_sigmoid_d(float z) { return fminf(z, 0.f) - 0.6931471805599453f * __builtin_amdgcn_logf(1.0f + __builtin_amdgcn_exp2f(-1.4426950408889634f * fabsf(z))); }
struct EpiH {
    static constexpr bool PERM = true, AFTER_DRAIN = false;
    unsigned char* ws; const float* fb; int l;
    __device__ __forceinline__ void operator()(const f32x4 (&acc)[2][2][4][2], const Unit& u, int wr, int wc, int fr, int fq) const {
        { int t_ = threadIdx.x; asm volatile("" : "+v"(t_)); fr = t_ & 15; fq = (t_ >> 4) & 3; const int w_ = __builtin_amdgcn_readfirstlane(t_ >> 6); wr = w_ >> 2; wc = w_ & 3; }
        bf16_t* Hb = (bf16_t*)(ws + WS_HB); float* sm = (float*)(ws + WS_SM);
        const float* ssin = l == 0 ? sm + SM_RSTD1 / 4 : sm + SM_SS1N / 4 + (l - 1) * MTOK;
        float* logf = sm + SM_LOGF / 4; float* ssq = sm + SM_SSQ / 4 + l * MTOK; float* sskv = sm + SM_SSKV / 4 + l * MTOK;
        const bool isk = (u.pn == 1 || u.pn == 5 || u.pn == 6);
        float kmx0 = 0.f, kmx1 = 0.f;
        const int row0 = u.pm * BM + wr * 64 + fr, colw = wc * 32 + 8 * fq;
#pragma unroll
        for (int ai = 0; ai < 2; ++ai)
#pragma unroll
            for (int m = 0; m < 4; ++m) {
                const int row = row0 + ai * HALF + m * 16; const float rs = __builtin_amdgcn_rsqf(ssin[row] * (1.0f / DM) + EPS);
                float s = 0.f;
#pragma unroll
                for (int bj = 0; bj < 2; ++bj) {
                    const f32x4 v0 = acc[ai][bj][m][0] * rs, v1 = acc[ai][bj][m][1] * rs;
                    *(u32x4*)(Hb + (size_t)row * HN + u.pn * BM + bj * HALF + colw) = pack8(v0, v1);
                    if (u.pn == 9 || (u.pn == 10 && bj == 0)) s += sq8(v0, v1);
                    if (isk) { const float mx = __builtin_fmaxf(__builtin_fmaxf(__builtin_fmaxf(__builtin_fabsf(v0[0]), __builtin_fabsf(v0[1])), __builtin_fmaxf(__builtin_fabsf(v0[2]), __builtin_fabsf(v0[3]))), __builtin_fmaxf(__builtin_fmaxf(__builtin_fabsf(v1[0]), __builtin_fabsf(v1[1])), __builtin_fmaxf(__builtin_fabsf(v1[2]), __builtin_fabsf(v1[3])))); if (bj == 0) kmx0 = __builtin_fmaxf(kmx0, mx); else kmx1 = __builtin_fmaxf(kmx1, mx); }
                    if (u.pn == 10 && bj == 1 && wc == 1 && fq == 0) { f32x4 lf; lf[0] = log_sigmoid_d(v0[0] + fb[0]); lf[1] = log_sigmoid_d(v0[1] + fb[1]); lf[2] = log_sigmoid_d(v0[2] + fb[2]); lf[3] = log_sigmoid_d(v0[3] + fb[3]); *(f32x4*)(logf + (size_t)row * 4) = lf; }
                }
                if (u.pn == 9 || u.pn == 10) { s += __shfl_xor(s, 16); s += __shfl_xor(s, 32); if (fq == 0) atomicAdd((u.pn == 9 ? ssq : sskv) + row, s); }
                asm volatile("" ::: "memory");
            }
        if (isk) {
            unsigned* kmax = (unsigned*)(sm + SM_KMAX / 4) + l * 32 + (u.pm / 32) * 16;
#pragma unroll
            for (int o = 1; o < 64; o <<= 1) { kmx0 = __builtin_fmaxf(kmx0, __shfl_xor(kmx0, o)); kmx1 = __builtin_fmaxf(kmx1, __shfl_xor(kmx1, o)); }
            if (fr == 0 && fq == 0) {
                const int i0 = u.pn == 1 ? (wc >> 1) : 4 + (2 * (u.pn - 5)) * 2 + (wc >> 1), i1 = u.pn == 1 ? 2 + (wc >> 1) : 4 + (2 * (u.pn - 5) + 1) * 2 + (wc >> 1);
                atomicMax(kmax + i0, __float_as_uint(kmx0)); atomicMax(kmax + i1, __float_as_uint(kmx1));
            }
        }
    }
};
struct EpiQ {
    static constexpr bool PERM = true, AFTER_DRAIN = false;
    bf16_t* QM; const float* ssq; const float2* rope;
    __device__ __forceinline__ void operator()(const f32x4 (&acc)[2][2][4][2], const Unit& u, int wr, int wc, int fr, int fq) const {
        { int t_ = threadIdx.x; asm volatile("" : "+v"(t_)); fr = t_ & 15; fq = (t_ >> 4) & 3; const int w_ = __builtin_amdgcn_readfirstlane(t_ >> 6); wr = w_ >> 2; wc = w_ & 3; }
        const int row0 = u.pm * BM + wr * 64 + fr, colw = wc * 32 + 8 * fq;
#pragma unroll
        for (int ai = 0; ai < 2; ++ai)
#pragma unroll
            for (int m = 0; m < 4; ++m) {
                const int row = row0 + ai * HALF + m * 16; const float rs = __builtin_amdgcn_rsqf(ssq[row] * (1.0f / 256.0f) + EPS);
                const float2* rt = rope + (size_t)(row & (SEQ - 1)) * 16;
#pragma unroll
                for (int bj = 0; bj < 2; ++bj) {
                    const int col = u.pn * BM + bj * HALF + colw;
                    if (col < 384) {
                        f32x4 v0 = acc[ai][bj][m][0] * rs, v1 = acc[ai][bj][m][1] * rs;
                        const int d = col % 96;
                        if (d >= 64) { const int j0 = (d - 64) >> 1; const float2 c0 = rt[j0], c1 = rt[j0 + 1], c2 = rt[j0 + 2], c3 = rt[j0 + 3];
                            f32x4 r0, r1;
                            r0[0] = v0[0] * c0.x - v0[1] * c0.y; r0[1] = v0[0] * c0.y + v0[1] * c0.x; r0[2] = v0[2] * c1.x - v0[3] * c1.y; r0[3] = v0[2] * c1.y + v0[3] * c1.x;
                            r1[0] = v1[0] * c2.x - v1[1] * c2.y; r1[1] = v1[0] * c2.y + v1[1] * c2.x; r1[2] = v1[2] * c3.x - v1[3] * c3.y; r1[3] = v1[2] * c3.y + v1[3] * c3.x;
                            v0 = r0; v1 = r1; }
                        *(u32x4*)(QM + (size_t)row * 384 + col) = pack8(v0, v1);
                    }
                }
                asm volatile("" ::: "memory");
            }
    }
};
struct EpiKV {
    static constexpr bool PERM = true, AFTER_DRAIN = false;
    bf16_t* KVM; const float* sskv;
    __device__ __forceinline__ void operator()(const f32x4 (&acc)[2][2][4][2], const Unit& u, int wr, int wc, int fr, int fq) const {
        { int t_ = threadIdx.x; asm volatile("" : "+v"(t_)); fr = t_ & 15; fq = (t_ >> 4) & 3; const int w_ = __builtin_amdgcn_readfirstlane(t_ >> 6); wr = w_ >> 2; wc = w_ & 3; }
        const int row0 = u.pm * BM + wr * 64 + fr, colw = wc * 32 + 8 * fq;
#pragma unroll
        for (int ai = 0; ai < 2; ++ai)
#pragma unroll
            for (int m = 0; m < 4; ++m) {
                const int row = row0 + ai * HALF + m * 16; const float rs = __builtin_amdgcn_rsqf(sskv[row] * (1.0f / 128.0f) + EPS);
#pragma unroll
                for (int bj = 0; bj < 2; ++bj) *(u32x4*)(KVM + (size_t)row * 512 + u.pn * BM + bj * HALF + colw) = pack8(acc[ai][bj][m][0] * rs, acc[ai][bj][m][1] * rs);
                asm volatile("" ::: "memory");
            }
    }
};
struct EpiRes {
    static constexpr bool PERM = true, AFTER_DRAIN = false;
    const float* xold; float* xnew; bf16_t* xb; float* ss;
    __device__ __forceinline__ void operator()(const f32x4 (&acc)[2][2][4][2], const Unit& u, int wr, int wc, int fr, int fq) const {
        { int t_ = threadIdx.x; asm volatile("" : "+v"(t_)); fr = t_ & 15; fq = (t_ >> 4) & 3; const int w_ = __builtin_amdgcn_readfirstlane(t_ >> 6); wr = w_ >> 2; wc = w_ & 3; }
        const int row0 = u.pm * BM + wr * 64 + fr, colw = wc * 32 + 8 * fq;
#pragma unroll
        for (int ai = 0; ai < 2; ++ai)
#pragma unroll
            for (int m = 0; m < 4; ++m) {
                const int row = row0 + ai * HALF + m * 16; float s = 0.f;
#pragma unroll
                for (int bj = 0; bj < 2; ++bj) {
                    const size_t off = (size_t)row * DM + u.pn * BM + bj * HALF + colw;
                    const f32x4 v0 = *(const f32x4*)(xold + off) + acc[ai][bj][m][0], v1 = *(const f32x4*)(xold + off + 4) + acc[ai][bj][m][1];
                    *(f32x4*)(xnew + off) = v0; *(f32x4*)(xnew + off + 4) = v1; *(u32x4*)(xb + off) = pack8(v0, v1);
                    s += sq8(v0, v1);
                }
                s += __shfl_xor(s, 16); s += __shfl_xor(s, 32); if (fq == 0) atomicAdd(ss + row, s);
                asm volatile("" ::: "memory");
            }
    }
};
struct HalfOrder {
    int nN, nwg, G2, c2; bool active;
    __device__ void init(int M, int N, int G, int c, int half) { nN = N / BM; nwg = (M / BM) * nN; G2 = G / 2; active = (c / G2) == half; c2 = c % G2; }
    __device__ bool next(int i, Unit& u) const { if (!active) return false; const int L = i * G2 + c2; if (L >= nwg) return false; u.pm = L / nN; u.pn = L % nN; return true; }
    __device__ __forceinline__ int arow(const Unit& u) const { return u.pm * BM; }
    __device__ __forceinline__ int arperm(int R) const { return R; }
    __device__ __forceinline__ int ahalf() const { return HALF; }
    __device__ __forceinline__ void a_ready(const Unit&) const {}
    __device__ __forceinline__ void done(const Unit&) const {}
};
constexpr int UP_TILES_PER_B = 33, UP_NM = 2 * UP_TILES_PER_B, UP_NN = NUP / 256;
__device__ __forceinline__ int up_tile_start(int pm) { const int b = pm / UP_TILES_PER_B, i = pm % UP_TILES_PER_B; int s = 252 * i; s = s > SEQ - 254 ? SEQ - 254 : s; return b * SEQ + s; }
struct UpOrder : StaticOrder {
    __device__ void init_up(int G_, int c_) { nM = UP_NM; nN = UP_NN; nwg = nM * nN; G = G_; c = c_; }
    __device__ __forceinline__ int arow(const Unit& u) const { return up_tile_start(u.pm); }
    __device__ __forceinline__ int arperm(int R) const { return R < 64 ? R : R + 62; }
    __device__ __forceinline__ int ahalf() const { return 64; }
};
template <int CTRL> __device__ __forceinline__ float dppz(float src) {
    return __builtin_bit_cast(float, __builtin_amdgcn_update_dpp(0, __builtin_bit_cast(int, src), CTRL, 0xf, 0xf, false));
}
struct EpiUp {
    static constexpr bool PERM = true, AFTER_DRAIN = false;
    unsigned char* ws; const float* cw; const float* cb; int l;
    __device__ __forceinline__ void operator()(f32x4 (&acc)[2][2][4][2], const Unit& u, int wr, int wc, int fr, int fq) const {
        { int t_ = threadIdx.x; asm volatile("" : "+v"(t_)); fr = t_ & 15; fq = (t_ >> 4) & 3; const int w_ = __builtin_amdgcn_readfirstlane(t_ >> 6); wr = w_ >> 2; wc = w_ & 3; }
        const float* ss2 = (const float*)(ws + WS_SM) + SM_SS2 / 4 + l * MTOK; bf16_t* act = (bf16_t*)(ws + WS_HB);
        const int t0 = up_tile_start(u.pm) + 126 * wr + fr;
        const bool keep_head = (u.pm % UP_TILES_PER_B) == 0 && wr == 0;
#pragma unroll
        for (int ai = 0; ai < 2; ++ai)
#pragma unroll
            for (int m = 0; m < 4; ++m) { const float rs = __builtin_amdgcn_rsqf(ss2[t0 + ai * 64 + m * 16] * (1.0f / DM) + EPS);
#pragma unroll
                for (int bj = 0; bj < 2; ++bj) { acc[ai][bj][m][0] *= rs; acc[ai][bj][m][1] *= rs; } }
        const int cg0 = u.pn * 128 + wc * 32 + 8 * fq;
#pragma unroll
        for (int n = 0; n < 2; ++n) {
            const int cg = cg0 + 4 * n;
            const f32x4 wg0 = *(const f32x4*)(cw + cg), wg1 = *(const f32x4*)(cw + NUP + cg), wg2 = *(const f32x4*)(cw + 2 * NUP + cg), bg = *(const f32x4*)(cb + cg);
            const f32x4 wu0 = *(const f32x4*)(cw + DFF + cg), wu1 = *(const f32x4*)(cw + NUP + DFF + cg), wu2 = *(const f32x4*)(cw + 2 * NUP + DFF + cg), bu = *(const f32x4*)(cb + DFF + cg);
#pragma unroll
            for (int ai = 0; ai < 2; ++ai)
#pragma unroll
                for (int m = 0; m < 4; ++m) {
                    const f32x4 xg = acc[ai][0][m][n], xu = acc[ai][1][m][n];
                    f32x4 pg, pu;
                    if (m > 0) { pg = acc[ai][0][m - 1][n]; pu = acc[ai][1][m - 1][n]; }
                    else if (ai > 0) { pg = acc[0][0][3][n]; pu = acc[0][1][3][n]; }
                    else { pg = (f32x4){0.f, 0.f, 0.f, 0.f}; pu = pg; }
                    float a[4];
#pragma unroll
                    for (int c = 0; c < 4; ++c) {
                        const float g1 = dppz<0x111>(xg[c]) + dppz<0x10F>(pg[c]), g2 = dppz<0x112>(xg[c]) + dppz<0x10E>(pg[c]);
                        const float u1 = dppz<0x111>(xu[c]) + dppz<0x10F>(pu[c]), u2 = dppz<0x112>(xu[c]) + dppz<0x10E>(pu[c]);
                        const float G = bg[c] + wg2[c] * xg[c] + wg1[c] * g1 + wg0[c] * g2;
                        const float U = bu[c] + wu2[c] * xu[c] + wu1[c] * u1 + wu0[c] * u2;
                        a[c] = G * __builtin_amdgcn_rcpf(1.0f + __builtin_amdgcn_exp2f(-1.4426950408889634f * G)) * U;
                    }
                    typedef unsigned u32x2 __attribute__((ext_vector_type(2)));
                    u32x2 w; w.x = cvt_pk_bf16(a[0], a[1]); w.y = cvt_pk_bf16(a[2], a[3]);
                    const bool halo = (ai == 0 && m == 0 && fr < 2 && !keep_head);
                    if (!halo) *(u32x2*)(act + (size_t)(t0 + ai * 64 + m * 16) * DFF + cg) = w;
                }
            asm volatile("" ::: "memory");
        }
    }
};
}
namespace att {
typedef short bf16x8 __attribute__((ext_vector_type(8)));
typedef short s16x4 __attribute__((ext_vector_type(4)));
typedef float f32x4 __attribute__((ext_vector_type(4)));
constexpr int ST_K = 0, ST_V = 16384, ST_CK = 32768, ST_BYTES = 33280;
constexpr int SC_OFF = 2 * ST_BYTES;
constexpr float SKIP_MARGIN = 160.0f;
constexpr float THR = 8.0f;
constexpr float MASKV = -1.0e30f;
constexpr int N_FOX = 256, N_MLA = 256, N_DIFF = 512, N_ITEMS = N_FOX + N_MLA + N_DIFF;

__device__ __forceinline__ s16x4 vtr(LAS const unsigned char* p) { typedef short v4i16_t __attribute__((ext_vector_type(4))); return __builtin_bit_cast(s16x4, __builtin_amdgcn_ds_read_tr16_b64_v4i16((LAS v4i16_t*)p)); }
__device__ __forceinline__ unsigned cvtpk(float lo, float hi) { typedef float f32x2_t __attribute__((ext_vector_type(2))); typedef __bf16 bf16x2_t __attribute__((ext_vector_type(2))); f32x2_t v = {lo, hi}; bf16x2_t b = __builtin_convertvector(v, bf16x2_t); return __builtin_bit_cast(unsigned, b); }
__device__ __forceinline__ float max3f(float a, float b, float c) { return __builtin_fmaxf(__builtin_fmaxf(a, b), c); }
__device__ __forceinline__ float halfmax(float v) { auto rr = __builtin_amdgcn_permlane32_swap(__float_as_uint(v), __float_as_uint(v), false, false); return __builtin_fmaxf(__uint_as_float(rr[0]), __uint_as_float(rr[1])); }
__device__ __forceinline__ float halfsum(float v) { auto rr = __builtin_amdgcn_permlane32_swap(__float_as_uint(v), __float_as_uint(v), false, false); return __uint_as_float(rr[0]) + __uint_as_float(rr[1]); }

template <bool ISMAX> __device__ __forceinline__ float wave_red32(float v) {
#define RED_(x, y) (ISMAX ? __builtin_fmaxf((x), (y)) : __builtin_fminf((x), (y)))
    v = RED_(v, __builtin_bit_cast(float, __builtin_amdgcn_update_dpp(0, __builtin_bit_cast(int, v), 0xB1, 0xf, 0xf, false)));
    v = RED_(v, __builtin_bit_cast(float, __builtin_amdgcn_update_dpp(0, __builtin_bit_cast(int, v), 0x4E, 0xf, 0xf, false)));
    v = RED_(v, __builtin_bit_cast(float, __builtin_amdgcn_update_dpp(0, __builtin_bit_cast(int, v), 0x141, 0xf, 0xf, false)));
    v = RED_(v, __builtin_bit_cast(float, __builtin_amdgcn_update_dpp(0, __builtin_bit_cast(int, v), 0x140, 0xf, 0xf, false)));
    const float a = __builtin_bit_cast(float, __builtin_amdgcn_readlane(__builtin_bit_cast(int, v), 0)), b = __builtin_bit_cast(float, __builtin_amdgcn_readlane(__builtin_bit_cast(int, v), 16));
    return RED_(a, b);
#undef RED_
}
__device__ __forceinline__ void item_decode(int i, int& type, int& rem) { if (i < N_FOX) { type = 0; rem = i; } else if (i < N_FOX + N_DIFF) { type = 1; rem = i - N_FOX; } else { type = 2; rem = i - N_FOX - N_DIFF; } }
__device__ __forceinline__ int item_est(int i) {
    int type, rem; item_decode(i, type, rem);
    if (type == 0) { const int nt = 4 * (rem % 32) + 4; return 16 * (nt < 24 ? nt : 24); }
    if (type == 2) return 20 * (4 * (rem % 32) + 4);
    const int head = (rem / 64) & 3, nt = 2 * (rem % 64) + 2, w = head == 0 ? 14 : (head == 1 ? 40 : 128);
    return 24 * (nt < w ? nt : w);
}
__device__ __forceinline__ void build_items(int* list, LAS int* est, int bx, int tid) {
    if (bx >= 2) return;
    __syncthreads();
    est[tid] = item_est(tid); est[tid + 512] = item_est(tid + 512);
    __syncthreads();
    const int i = bx * 512 + tid, ci = est[i]; int rank = 0;
    for (int j = 0; j < N_ITEMS; ++j) { const int cj = est[j]; rank += (cj > ci || (cj == ci && j < i)) ? 1 : 0; }
    int type, rem; item_decode(i, type, rem);
    list[rank] = type | (rem << 2);
    __syncthreads();
}

struct Params { const bf16* HB; const bf16* QM; const bf16* KVM; const bf16* KR; bf16* AO; const float* cum; const unsigned* kmax; unsigned* ctr; const float* lq1; const float* lk1; const float* lq2; const float* lk2; const float* dng; float lam_init; int pad; };

template <int MODE>
__device__ __forceinline__ void attn_unit(const Params& P, LAS unsigned char* lds, const int b, const int head, const int qblk) {
    constexpr int DK = MODE == 2 ? 96 : 64, DV = MODE == 1 ? 128 : 64, NS = DK / 16, NDB = DV / 32;
    constexpr int KPITCH = MODE == 2 ? 256 : 128, VPITCH = DV * 2;
    int tid = threadIdx.x; asm volatile("" : "+v"(tid));
    const int lane = tid & 63, wave = __builtin_amdgcn_readfirstlane(tid >> 6), r = lane & 31, h = lane >> 5;
    const size_t rb = (size_t)b * SEQ;
    const int wq = MODE == 1 ? (wave & 3) : wave;
    const int map = MODE == 1 ? (wave >> 2) : 0;
    const int q0 = (MODE == 1 ? 128 : 256) * qblk, qrow = q0 + 32 * wq;
    const int NT = (MODE == 1 ? 2 : 4) * qblk + (MODE == 1 ? 2 : 4);
    const int jv = (MODE == 1 ? 2 : 4) * qblk + (wq >> 1);
    const bf16 *Qp, *Kp, *K2p = nullptr, *Vp; int qpitch, kpitch, vpitch; bf16* Op;
    if (MODE == 0) { Qp = P.HB + H_FQ + head * 64; Kp = P.HB + H_FK + head * 64; Vp = P.HB + H_FV + head * 64; qpitch = kpitch = vpitch = HN; Op = P.AO + head * 64; }
    else if (MODE == 1) { Qp = P.HB + H_DQ + head * 128 + map * 64; Kp = P.HB + H_DK + head * 128; Vp = P.HB + H_DV + head * 128; qpitch = kpitch = vpitch = HN; Op = P.AO + 256 + head * 128; }
    else { Qp = P.QM + head * 96; Kp = P.KVM + head * 128; K2p = P.KR; Vp = P.KVM + head * 128 + 64; qpitch = 384; kpitch = vpitch = 512; Op = P.AO + 768 + head * 64; }
    bf16x8 qf[NS];
#pragma unroll
    for (int s = 0; s < NS; ++s) qf[s] = *(const bf16x8*)(Qp + (rb + qrow + r) * qpitch + 16 * s + 8 * h);
    v4u kreg0, kreg1, vreg0, vreg1; f32x4 ckreg;
    kreg1 = (v4u){0u, 0u, 0u, 0u}; vreg1 = kreg1; ckreg = (f32x4){0.f, 0.f, 0.f, 0.f};
    const int skey = tid >> 3, sc = tid & 7;
    unsigned kw0, kw1 = 0, vw0, vw1 = 0;
    if (MODE == 2) { kw0 = ST_K + skey * 256 + ((sc ^ (skey & 15)) << 4); const int k2 = tid >> 2, c2 = 8 + (tid & 3); kw1 = ST_K + k2 * 256 + ((c2 ^ (k2 & 15)) << 4); }
    else { kw0 = ST_K + skey * 128 + ((sc ^ ((skey >> 1) & 7)) << 4); kw1 = kw0 + 8192; }
    if (DV == 64) vw0 = ST_V + skey * 128 + ((((sc >> 2) ^ ((skey >> 1) & 1))) << 6) + ((sc & 3) << 4);
    else { const int k0_ = tid >> 4, c0_ = tid & 15; vw0 = ST_V + k0_ * 256 + ((((c0_ >> 2) ^ (k0_ & 3))) << 6) + ((c0_ & 3) << 4); const int k1_ = k0_ + 32; vw1 = ST_V + k1_ * 256 + ((((c0_ >> 2) ^ (k1_ & 3))) << 6) + ((c0_ & 3) << 4); }
    const float cref = (MODE == 0) ? P.cum[(rb + q0) * 4 + head] : 0.f;
    LAS float* scf = (LAS float*)(lds + SC_OFF);
    __syncthreads();
    if (MODE != 2) {
        float qa = 0.f;
#pragma unroll
        for (int s = 0; s < NS; ++s)
#pragma unroll
            for (int e = 0; e < 8; ++e) qa += __builtin_fabsf(bf2f((unsigned short)qf[s][e]));
        qa = wave_red32<true>(halfsum(qa));
        if (lane == 0) { scf[8 + wave] = qa; scf[wave] = MASKV; scf[32 + wave] = MASKV; }
    }
#define ATT_LOAD(j) do { const size_t kr_ = rb + (size_t)(j) * 64; \
        if (MODE == 2) { kreg0 = *(const v4u*)(Kp + (kr_ + skey) * kpitch + sc * 8); if (tid < 256) kreg1 = *(const v4u*)(K2p + (kr_ + (tid >> 2)) * 32 + (tid & 3) * 8); } \
        else { kreg0 = *(const v4u*)(Kp + (kr_ + skey) * kpitch + sc * 8); if (MODE == 1) kreg1 = *(const v4u*)(Kp + 64 + (kr_ + skey) * kpitch + sc * 8); } \
        if (DV == 64) vreg0 = *(const v4u*)(Vp + (kr_ + skey) * vpitch + sc * 8); \
        else { vreg0 = *(const v4u*)(Vp + (kr_ + (tid >> 4)) * vpitch + (tid & 15) * 8); vreg1 = *(const v4u*)(Vp + (kr_ + 32 + (tid >> 4)) * vpitch + (tid & 15) * 8); } \
        if (MODE == 0 && tid < 16) { const float* cp_ = P.cum + (kr_ + tid * 4) * 4 + head; ckreg = (f32x4){cref - cp_[0], cref - cp_[4], cref - cp_[8], cref - cp_[12]}; } } while (0)
#define ATT_WRITE(st) do { LAS unsigned char* sb_ = lds + (st) * ST_BYTES; \
        *(LAS v4u*)(sb_ + kw0) = kreg0; if (MODE == 1 || (MODE == 2 && tid < 256)) *(LAS v4u*)(sb_ + kw1) = kreg1; \
        *(LAS v4u*)(sb_ + vw0) = vreg0; if (DV == 128) *(LAS v4u*)(sb_ + vw1) = vreg1; \
        if (MODE == 0 && tid < 16) { *(LAS f32x4*)(sb_ + ST_CK + tid * 16) = ckreg; if (tid == 15) scf[16 + (st)] = ckreg[3]; } } while (0)
    unsigned ka[NS];
#pragma unroll
    for (int s = 0; s < NS; ++s) ka[s] = ST_K + (MODE == 1 ? map * 8192 : 0) + r * KPITCH + (MODE == 2 ? (((2 * s + h) ^ (r & 15)) << 4) : (((2 * s + h) ^ ((r >> 1) & 7)) << 4));
    unsigned va[NDB];
    { const int qp = (lane & 15) >> 2, kb_ = 4 * h + qp, dby = 32 * ((lane >> 4) & 1) + 8 * (lane & 3);
#pragma unroll
      for (int d = 0; d < NDB; ++d) va[d] = ST_V + kb_ * VPITCH + (DV == 64 ? ((d ^ ((qp >> 1) & 1)) << 6) : ((d ^ qp) << 6)) + dby; }
    f32x16 o[NDB];
#pragma unroll
    for (int d = 0; d < NDB; ++d)
#pragma unroll
        for (int i = 0; i < 16; ++i) o[d][i] = 0.f;
    float m_run = MASKV, l_run = 0.f;
    const float slope2 = (MODE == 1) ? exp2f(-2.0f * (float)(head + 1)) * LOG2E : 0.f;
    ATT_LOAD(NT - 1); ATT_WRITE(0);
    __syncthreads();
    float qk_ub = 0.f;
    if (MODE != 2) {
        const f32x4 qa0 = *(LAS const f32x4*)(scf + 8), qa1 = *(LAS const f32x4*)(scf + 12);
        const float qmx = __builtin_fmaxf(__builtin_fmaxf(__builtin_fmaxf(qa0[0], qa0[1]), __builtin_fmaxf(qa0[2], qa0[3])), __builtin_fmaxf(__builtin_fmaxf(qa1[0], qa1[1]), __builtin_fmaxf(qa1[2], qa1[3])));
        const float km = MODE == 0 ? __uint_as_float(P.kmax[b * 16 + head]) : __builtin_fmaxf(__uint_as_float(P.kmax[b * 16 + 4 + head * 2]), __uint_as_float(P.kmax[b * 16 + 5 + head * 2]));
        qk_ub = qmx * km * 1.02f;
    }
    for (int t = 0; t < NT; ++t) {
        const int j = NT - 1 - t;
        if (t + 1 < NT) ATT_LOAD(j - 1);
        if (MODE != 2) {
            const int mr = (t & 1) ? 0 : 32; const f32x4 m0 = *(LAS const f32x4*)(scf + mr), m1 = *(LAS const f32x4*)(scf + mr + 4);
            const float mmin = __builtin_fminf(__builtin_fminf(__builtin_fminf(m0[0], m0[1]), __builtin_fminf(m0[2], m0[3])), __builtin_fminf(__builtin_fminf(m1[0], m1[1]), __builtin_fminf(m1[2], m1[3])));
            const float cm = MODE == 0 ? scf[16 + (t & 1)] : slope2 * (float)(64 * j + 63 - q0);
            if (qk_ub + cm < mmin - SKIP_MARGIN) break;
        }
        if (j <= jv) {
            LAS const unsigned char* sb = lds + (t & 1) * ST_BYTES;
            f32x16 p0, p1;
            if (MODE == 0) {
#pragma unroll
                for (int g = 0; g < 4; ++g) { const f32x4 c0 = *(LAS const f32x4*)(sb + ST_CK + 16 * h + 32 * g), c1 = *(LAS const f32x4*)(sb + ST_CK + 128 + 16 * h + 32 * g);
#pragma unroll
                    for (int i = 0; i < 4; ++i) { p0[4 * g + i] = c0[i]; p1[4 * g + i] = c1[i]; } }
            } else if (MODE == 1) {
                const float tb = slope2 * (float)(64 * j + 4 * h - (qrow + r));
#pragma unroll
                for (int i = 0; i < 16; ++i) { p0[i] = tb + slope2 * (float)((i & 3) + 8 * (i >> 2)); p1[i] = p0[i] + 32.0f * slope2; }
            } else {
#pragma unroll
                for (int i = 0; i < 16; ++i) { p0[i] = 0.f; p1[i] = 0.f; }
            }
            f32x16 c0s, c1s;
            if (MODE == 1) { c0s = p0; c1s = p1; }
#pragma unroll
            for (int s = 0; s < NS; ++s) {
                const bf16x8 k0 = *(LAS const bf16x8*)(sb + ka[s]), k1 = *(LAS const bf16x8*)(sb + ka[s] + 32 * KPITCH);
                p0 = __builtin_amdgcn_mfma_f32_32x32x16_bf16(k0, qf[s], p0, 0, 0, 0);
                p1 = __builtin_amdgcn_mfma_f32_32x32x16_bf16(k1, qf[s], p1, 0, 0, 0);
            }
            if (j == jv) {
                if (MODE == 0) {
                    const int qrel = (qrow + r) - 64 * j - 4 * h;
#pragma unroll
                    for (int i = 0; i < 16; ++i) { const int kr_ = (i & 3) + 8 * (i >> 2); if (kr_ > qrel) p0[i] = MASKV; if (kr_ + 32 > qrel) p1[i] = MASKV; }
                } else if (MODE == 1) {
#pragma unroll
                    for (int i = 0; i < 16; ++i) { p0[i] -= 2.0f * __builtin_fmaxf(c0s[i], 0.f); p1[i] -= 2.0f * __builtin_fmaxf(c1s[i], 0.f); }
                }
            }
            float tm;
            { float a = max3f(p0[0], p0[1], p1[0]), bq = max3f(p0[2], p0[3], p1[1]); a = max3f(a, p1[2], p1[3]);
#pragma unroll
              for (int i = 4; i < 16; i += 4) { a = max3f(a, p0[i], p0[i + 1]); bq = max3f(bq, p0[i + 2], p0[i + 3]); a = max3f(a, p1[i], p1[i + 1]); bq = max3f(bq, p1[i + 2], p1[i + 3]); }
              tm = halfmax(__builtin_fmaxf(a, bq)); }
            if (__any(tm > m_run + THR)) {
                const float mn = __builtin_fmaxf(m_run, tm), al = __builtin_amdgcn_exp2f(m_run - mn);
                m_run = mn; l_run *= al;
#pragma unroll
                for (int d = 0; d < NDB; ++d)
#pragma unroll
                    for (int i = 0; i < 16; ++i) o[d][i] *= al;
            }
            float ls = 0.f;
#pragma unroll
            for (int i = 0; i < 16; ++i) { p0[i] = __builtin_amdgcn_exp2f(p0[i] - m_run); p1[i] = __builtin_amdgcn_exp2f(p1[i] - m_run); ls += p0[i] + p1[i]; }
            l_run += ls;
            bf16x8 pf[4];
#pragma unroll
            for (int t = 0; t < 2; ++t) {
                v4u w0, w1;
                w0.x = cvtpk(p0[8 * t + 0], p0[8 * t + 1]); w0.y = cvtpk(p0[8 * t + 2], p0[8 * t + 3]); w0.z = cvtpk(p0[8 * t + 4], p0[8 * t + 5]); w0.w = cvtpk(p0[8 * t + 6], p0[8 * t + 7]);
                w1.x = cvtpk(p1[8 * t + 0], p1[8 * t + 1]); w1.y = cvtpk(p1[8 * t + 2], p1[8 * t + 3]); w1.z = cvtpk(p1[8 * t + 4], p1[8 * t + 5]); w1.w = cvtpk(p1[8 * t + 6], p1[8 * t + 7]);
                pf[t] = __builtin_bit_cast(bf16x8, w0); pf[2 + t] = __builtin_bit_cast(bf16x8, w1);
            }
#pragma unroll
            for (int d = 0; d < NDB; ++d)
#pragma unroll
                for (int ks = 0; ks < 4; ++ks) {
                    const s16x4 lo = vtr(sb + va[d] + ks * 16 * VPITCH), hi = vtr(sb + va[d] + ks * 16 * VPITCH + 8 * VPITCH);
                    const bf16x8 vf = (bf16x8){lo[0], lo[1], lo[2], lo[3], hi[0], hi[1], hi[2], hi[3]};
                    o[d] = __builtin_amdgcn_mfma_f32_32x32x16_bf16(vf, pf[ks], o[d], 0, 0, 0);
                }
            if (MODE != 2) { const float wmin = wave_red32<false>(m_run); if (lane == 0) scf[((t & 1) ? 32 : 0) + wave] = wmin; }
        }
        if (t + 1 < NT) ATT_WRITE((t + 1) & 1);
        __syncthreads();
    }
#undef ATT_LOAD
#undef ATT_WRITE
    const float linv = 1.0f / halfsum(l_run);
    if (MODE != 1) {
        bf16* orow = Op + (rb + qrow + r) * DM + 4 * h;
#pragma unroll
        for (int d = 0; d < NDB; ++d)
#pragma unroll
            for (int g = 0; g < 4; ++g) { v2u w; w.x = cvtpk(o[d][4 * g] * linv, o[d][4 * g + 1] * linv); w.y = cvtpk(o[d][4 * g + 2] * linv, o[d][4 * g + 3] * linv); *(v2u*)(orow + 32 * d + 8 * g) = w; }
    } else {
        LAS float* ex = (LAS float*)lds;
        __syncthreads();
        if (map == 1) {
#pragma unroll
            for (int d = 0; d < NDB; ++d)
#pragma unroll
                for (int i = 0; i < 16; ++i) ex[((wq * 4 + d) * 16 + i) * 64 + lane] = o[d][i] * linv;
        }
        __syncthreads();
        if (map == 0) {
            float s1 = P.lq1[lane] * P.lk1[lane], s2 = P.lq2[lane] * P.lk2[lane];
            s1 = wave_sum(s1); s2 = wave_sum(s2);
            const float lam = __expf(s1) - __expf(s2) + P.lam_init;
            float ss = 0.f;
#pragma unroll
            for (int d = 0; d < NDB; ++d)
#pragma unroll
                for (int i = 0; i < 16; ++i) { o[d][i] = o[d][i] * linv - lam * ex[((wq * 4 + d) * 16 + i) * 64 + lane]; ss += o[d][i] * o[d][i]; }
            ss = halfsum(ss);
            const float rn = __builtin_amdgcn_rsqf(ss * (1.0f / 128.0f) + EPS) * (1.0f - P.lam_init);
            bf16* orow = Op + (rb + qrow + r) * DM + 4 * h;
#pragma unroll
            for (int d = 0; d < NDB; ++d)
#pragma unroll
                for (int g = 0; g < 4; ++g) { const f32x4 gg = *(const f32x4*)(P.dng + 32 * d + 8 * g + 4 * h);
                    v2u w; w.x = cvtpk(o[d][4 * g] * rn * gg[0], o[d][4 * g + 1] * rn * gg[1]); w.y = cvtpk(o[d][4 * g + 2] * rn * gg[2], o[d][4 * g + 3] * rn * gg[3]); *(v2u*)(orow + 32 * d + 8 * g) = w; }
        }
        __syncthreads();
    }
}

__device__ __forceinline__ void attn_phase(const Params& P, LAS unsigned char* lds, const int* list) {
    LAS int* word = (LAS int*)(lds + SC_OFF + 96);
    for (;;) {
        __syncthreads();
        if (threadIdx.x == 0) *word = (int)atomicAdd(P.ctr, 1u);
        __syncthreads();
        const int idx = *word;
        if (idx >= N_ITEMS) break;
        const int code = list[idx], type = code & 3, rem = code >> 2;
        if (type == 0) attn_unit<0>(P, lds, (rem / 32) >> 2, (rem / 32) & 3, rem % 32);
        else if (type == 1) attn_unit<1>(P, lds, (rem / 64) >> 2, (rem / 64) & 3, rem % 64);
        else attn_unit<2>(P, lds, (rem / 32) >> 2, (rem / 32) & 3, rem % 32);
    }
}
}
#define XB_TMO      128
#define XB_XCNT(j)  (256  + 64 * (j))
#define XB_XSUB(j)  (1280 + 64 * (j))
#define XB_XGEN(j)  (2304 + 64 * (j))
#define XB_TOP      3328
#define XB_TOPGEN   3392
#define XCD_BAR_WORDS 3456
#define XB_SPIN_CAP (1u << 18)

__device__ __forceinline__ unsigned xb_ld(unsigned* p)              { return __hip_atomic_load(p, __ATOMIC_RELAXED, __HIP_MEMORY_SCOPE_AGENT); }
__device__ __forceinline__ unsigned xb_add(unsigned* p, unsigned v) { return __hip_atomic_fetch_add(p, v, __ATOMIC_RELAXED, __HIP_MEMORY_SCOPE_AGENT); }
__device__ __forceinline__ unsigned xb_xcc_id() { return (unsigned)__builtin_amdgcn_s_getreg((3 << 11) | 20) & 0xFu; }
#define XB_SPIN(cond, bar) do { unsigned _sp = 0; while (cond) { __builtin_amdgcn_s_sleep(1); \
    if ((++_sp & 255u) == 0u) { if (xb_ld(&(bar)[XB_TMO])) break; if (_sp > XB_SPIN_CAP) { atomicAdd(&(bar)[XB_TMO], 1u); break; } } } } while (0)

struct XcdBarrier {
    unsigned* bar; unsigned x;
    volatile LAS unsigned* st;
};

__device__ __forceinline__ XcdBarrier xcd_barrier_post(unsigned* bar, volatile LAS unsigned* st) {
    XcdBarrier b; b.bar = bar; b.x = xb_xcc_id(); b.st = st;
    if (threadIdx.x == 0) (void)xb_add(&bar[XB_XCNT(b.x)], 1u);
    return b;
}
__device__ __forceinline__ void xcd_barrier_complete(unsigned* bar, unsigned x, unsigned& nloc, unsigned& nx) {
    const unsigned G = gridDim.x * gridDim.y * gridDim.z;
    unsigned sum, cnt, mine, sp = 0u;
    for (;;) {
        sum = 0u; cnt = 0u; mine = 0u;
#pragma unroll
        for (unsigned j = 0; j < 16; ++j) { const unsigned c = xb_ld(&bar[XB_XCNT(j)]); sum += c; cnt += (c > 0u) ? 1u : 0u; mine = (j == x) ? c : mine; }
        if (sum == G) break;
        __builtin_amdgcn_s_sleep(1);
        if ((++sp & 255u) == 0u) { if (xb_ld(&bar[XB_TMO])) break; if (sp > XB_SPIN_CAP) { atomicAdd(&bar[XB_TMO], 1u); break; } }
    }
    nloc = mine > 0u ? mine : 1u; nx = cnt > 0u ? cnt : 1u;
}

__device__ __forceinline__ void xcd_barrier(const XcdBarrier& b) {
    asm volatile("s_waitcnt vmcnt(0)" ::: "memory");
    __syncthreads();
    if (threadIdx.x == 0) {
        unsigned* bar = b.bar;
        __builtin_amdgcn_s_waitcnt(0);
        unsigned nloc = b.st[0], nx = b.st[1];
        if (nloc == 0u) { xcd_barrier_complete(bar, b.x, nloc, nx); b.st[0] = nloc; b.st[1] = nx; }
        const unsigned old = xb_add(&bar[XB_XSUB(b.x)], 1u);
        const unsigned gen = old / nloc;
        if (old + 1u == (gen + 1u) * nloc) {
            __builtin_amdgcn_fence(__ATOMIC_RELEASE, "agent");
            asm volatile("s_waitcnt vmcnt(0)" ::: "memory");
            const unsigned og = xb_add(&bar[XB_TOP], 1u);
            const unsigned tg = og / nx;
            if (og + 1u == (tg + 1u) * nx) xb_add(&bar[XB_TOPGEN], 1u);
            else XB_SPIN(xb_ld(&bar[XB_TOPGEN]) == tg, bar);
            __builtin_amdgcn_fence(__ATOMIC_ACQUIRE, "agent");
            xb_add(&bar[XB_XGEN(b.x)], 1u);
            asm volatile("s_waitcnt vmcnt(0)" ::: "memory");
        } else {
            XB_SPIN(xb_ld(&bar[XB_XGEN(b.x)]) == gen, bar);
            __builtin_amdgcn_fence(__ATOMIC_ACQUIRE, "agent");
            asm volatile("s_waitcnt vmcnt(0)" ::: "memory");
        }
    }
    __syncthreads();
}

constexpr int CW_BAR = 4096;
constexpr int MISC_OFF = RING_BYTES + 320;
constexpr size_t WS_ROPE = 234 * MiB;
constexpr size_t WS_ITEMS = 235 * MiB;
constexpr size_t WS_END2 = 236 * MiB;
constexpr int PH_H = 0, PH_M = 1, PH_A = 2, PH_O = 3, PH_U = 4, PH_D = 5, PH_FINAL = 13, NPHASES = 14;

__device__ __forceinline__ void rope_cs(int t, int j, float& c, float& s) {
    const float inv = (float)(1.0 / pow(10000.0, (double)j / 16.0));
    const float ang = (float)t * inv;
    c = (float)cos((double)ang); s = (float)sin((double)ang);
}
__device__ __forceinline__ void rope_table(float2* tab, int gtid, int ngt) {
    for (int i = gtid; i < SEQ * 16; i += ngt) { float c, s; rope_cs(i >> 4, i & 15, c, s); tab[i] = make_float2(c, s); }
}
__device__ __forceinline__ void cum_scan(const float* logf, float* cum, int b, int h, LAS double* part, int tid) {
    double loc[16]; double s = 0.0;
#pragma unroll
    for (int i = 0; i < 16; ++i) { s += (double)logf[(size_t)(b * SEQ + tid * 16 + i) * 4 + h]; loc[i] = s; }
    part[tid] = s;
    __syncthreads();
    double pre = 0.0;
    for (int j = 0; j < tid; ++j) pre += part[j];
#pragma unroll
    for (int i = 0; i < 16; ++i) cum[(size_t)(b * SEQ + tid * 16 + i) * 4 + h] = (float)((pre + loc[i]) * 1.4426950408889634);
    __syncthreads();
}

#define CAS __attribute__((address_space(4)))
__global__ void __launch_bounds__(NTHREADS, 2) fwd(Args args) {
    extern __shared__ __attribute__((aligned(16))) unsigned char lds_raw[];
    LAS unsigned char* lds = (LAS unsigned char*)lds_raw;
    { volatile LAS unsigned* misc = (volatile LAS unsigned*)(lds + MISC_OFF); if (threadIdx.x < 32) misc[threadIdx.x] = 0u; __syncthreads(); }
    XcdBarrier bar; { CAS const Args* apb = (CAS const Args*)__builtin_amdgcn_kernarg_segment_ptr(); bar = xcd_barrier_post((unsigned*)(apb->ws + WS_CTL) + CW_BAR, (volatile LAS unsigned*)(lds + MISC_OFF) + 8); }
    int lo, hi; { CAS const Args* ap0 = (CAS const Args*)__builtin_amdgcn_kernarg_segment_ptr(); lo = ap0->ph_lo; hi = ap0->ph_hi; }
#define IN(k) (lo <= (k) && (k) < hi)
#define SEAM(k) do { if (IN(k) && IN((k) + 1)) xcd_barrier(bar); } while (0)
#define FRAME() \
    int tid = threadIdx.x; asm volatile("" : "+v"(tid)); \
    CAS const Args* ap = (CAS const Args*)__builtin_amdgcn_kernarg_segment_ptr(); asm volatile("" : "+s"(ap)); unsigned char* ws = ap->ws; \
    const int lane = tid & 63, wave = __builtin_amdgcn_readfirstlane(tid >> 6); \
    int G_ = gridDim.x, bx_ = blockIdx.x; asm volatile("" : "+s"(G_), "+s"(bx_)); const int G = __builtin_amdgcn_readfirstlane(G_), bx = __builtin_amdgcn_readfirstlane(bx_); \
    const int vcu = (G % 8 == 0) ? (bx % 8) * (G / 8) + bx / 8 : bx; \
    const int gw = vcu * NWAVES + wave, ngw = G * NWAVES; \
    float* sm = (float*)(ws + WS_SM); (void)lane; (void)gw; (void)ngw; (void)sm;
    if (IN(0)) { FRAME(); p0_prologue(ap, lds, gw, ngw, lane, wave); rope_table((float2*)(ws + WS_ROPE), gw * 64 + lane, ngw * 64); att::build_items((int*)(ws + WS_ITEMS), (LAS int*)lds, bx, tid); }
    SEAM(0);
    for (int l = 0; l < DEPTH; ++l) {
        const int pb = 1 + 6 * l;
        if (IN(pb + PH_H)) {
            FRAME();
            unsigned char* wl = ws + WS_W + (size_t)l * WS_WL;
            pg8::Gemm g{(const bf16*)(ws + WS_XB), (const bf16*)(wl + W_IN), MTOK, HN, DM, DM}; pg8::StaticOrder S; S.init(MTOK, HN, G, bx);
            pg8::EpiH E{ws, ap->in[I_FB] + l * 4, l};
            pg8::gemm_phase<pg8::EpiH, pg8::StaticOrder, true, true>(lds, g, S, E);
        }
        SEAM(pb + PH_H);
        if (IN(pb + PH_M)) {
            { FRAME(); unsigned char* wl = ws + WS_W + (size_t)l * WS_WL;
              pg8::Gemm g{(const bf16*)(ws + WS_HB) + H_CQ, (const bf16*)(wl + W_UQ), MTOK, 512, 256, HN}; pg8::HalfOrder S; S.init(MTOK, 512, G, bx, 0);
              pg8::EpiQ E{(bf16*)(ws + WS_QM), sm + SM_SSQ / 4 + l * MTOK, (const float2*)(ws + WS_ROPE)}; pg8::gemm_phase<pg8::EpiQ, pg8::HalfOrder, true, true>(lds, g, S, E); }
            { FRAME(); unsigned char* wl = ws + WS_W + (size_t)l * WS_WL;
              pg8::Gemm g{(const bf16*)(ws + WS_HB) + H_CKV, (const bf16*)(wl + W_UKV), MTOK, 512, 128, HN}; pg8::HalfOrder S; S.init(MTOK, 512, G, bx, 1);
              pg8::EpiKV E{(bf16*)(ws + WS_KVM), sm + SM_SSKV / 4 + l * MTOK}; pg8::gemm_phase<pg8::EpiKV, pg8::HalfOrder, true, true>(lds, g, S, E); }
            { FRAME(); const bf16* HB = (const bf16*)(ws + WS_HB); bf16* KR = (bf16*)(ws + WS_KR); const float2* rope = (const float2*)(ws + WS_ROPE);
              for (int i = (gw * 64 + lane); i < MTOK * 16; i += ngw * 64) {
                const int j = i & 15, row = i >> 4; const float2 cs = rope[(size_t)(row & (SEQ - 1)) * 16 + j];
                const float x1 = bf2f(HB[(size_t)row * HN + H_KR + j]), x2 = bf2f(HB[(size_t)row * HN + H_KR + 16 + j]);
                *(unsigned*)(KR + (size_t)row * 32 + 2 * j) = pk2(x1 * cs.x - x2 * cs.y, x1 * cs.y + x2 * cs.x);
              }
              __syncthreads();
              if (bx < 8) cum_scan(sm + SM_LOGF / 4, sm + SM_CUM / 4, bx >> 2, bx & 3, (LAS double*)lds, tid); }
        }
        SEAM(pb + PH_M);
        if (IN(pb + PH_A)) {
            FRAME();
            const float lam_init = l == 0 ? 0.2f : 0.35550906759096934f;
            att::Params P{(const bf16*)(ws + WS_HB), (const bf16*)(ws + WS_QM), (const bf16*)(ws + WS_KVM), (const bf16*)(ws + WS_KR), (bf16*)(ws + WS_AO), sm + SM_CUM / 4, (const unsigned*)(sm + SM_KMAX / 4) + l * 32, (unsigned*)(ws + WS_CTL) + 64 + 64 * l,
                          ap->in[I_LQ1] + l * 64, ap->in[I_LK1] + l * 64, ap->in[I_LQ2] + l * 64, ap->in[I_LK2] + l * 64, ap->in[I_DNG] + l * 128, lam_init, 0};
            att::attn_phase(P, lds, (const int*)(ws + WS_ITEMS));
        }
        SEAM(pb + PH_A);
        if (IN(pb + PH_O)) {
            FRAME(); unsigned char* wl = ws + WS_W + (size_t)l * WS_WL;
            pg8::Gemm g{(const bf16*)(ws + WS_AO), (const bf16*)(wl + W_O), MTOK, DM, DM, DM}; pg8::StaticOrder S; S.init(MTOK, DM, G, bx);
            pg8::EpiRes E{l == 0 ? ap->in[I_X] : ap->out, ap->out, (bf16*)(ws + WS_XB), sm + SM_SS2 / 4 + l * MTOK};
            pg8::gemm_phase<pg8::EpiRes, pg8::StaticOrder, true, true>(lds, g, S, E);
        }
        SEAM(pb + PH_O);
        if (IN(pb + PH_U)) {
            FRAME(); unsigned char* wl = ws + WS_W + (size_t)l * WS_WL;
            pg8::Gemm g{(const bf16*)(ws + WS_XB), (const bf16*)(wl + W_UP), MTOK, NUP, DM, DM}; pg8::UpOrder S; S.init_up(G, bx);
            pg8::EpiUp E{ws, ap->in[I_CW] + (size_t)l * 3 * NUP, ap->in[I_CB] + (size_t)l * NUP, l};
            pg8::gemm_phase<pg8::EpiUp, pg8::UpOrder, true, true>(lds, g, S, E);
        }
        SEAM(pb + PH_U);
        if (IN(pb + PH_D)) {
            FRAME(); unsigned char* wl = ws + WS_W + (size_t)l * WS_WL;
            pg8::Gemm g{(const bf16*)(ws + WS_HB), (const bf16*)(wl + W_DN), MTOK, DM, DFF, DFF}; pg8::StaticOrder S; S.init(MTOK, DM, G, bx);
            pg8::EpiRes E{ap->out, ap->out, (bf16*)(ws + WS_XB), sm + SM_SS1N / 4 + l * MTOK};
            pg8::gemm_phase<pg8::EpiRes, pg8::StaticOrder, true, true>(lds, g, S, E);
        }
        SEAM(pb + PH_D);
    }
    if (IN(PH_FINAL)) {
        FRAME();
        const float* ss = sm + SM_SS1N / 4 + (DEPTH - 1) * MTOK; const float4* gr = (const float4*)ap->in[I_FG] + lane;
        for (int row = gw; row < MTOK; row += ngw) {
            const float r = __builtin_amdgcn_rsqf(ss[row] * (1.0f / DM) + EPS);
            float4* xr = (float4*)(ap->out + (size_t)row * DM) + lane;
#pragma unroll
            for (int j = 0; j < 4; ++j) { float4 v = xr[64 * j]; const float4 gg = gr[64 * j]; v.x *= r * gg.x; v.y *= r * gg.y; v.z *= r * gg.z; v.w *= r * gg.w; xr[64 * j] = v; }
        }
    }
#undef IN
#undef SEAM
#undef FRAME
}
#ifndef N_LAUNCHES
#define N_LAUNCHES 1
#endif
extern "C" void kernel_launch(void* const* d_in, const int* in_sizes, int n_in, void* d_out, int out_size, void* d_ws, size_t ws_size, hipStream_t stream) {
    static int grid = 0;
    if (!grid) {
        if (n_in != 20 || ws_size < WS_END2 || out_size != MTOK * DM) { fprintf(stderr, "kernel_launch: unexpected n_in %d / out_size %d / ws_size %zu\n", n_in, out_size, ws_size); grid = -1; return; }
        if (hipFuncSetAttribute((const void*)fwd, hipFuncAttributeMaxDynamicSharedMemorySize, LDS_BYTES) != hipSuccess) { fprintf(stderr, "hipFuncSetAttribute failed\n"); grid = -1; return; }
        int dev = 0, cus = 0, per_cu = 0;
        if (hipGetDevice(&dev) != hipSuccess || hipDeviceGetAttribute(&cus, hipDeviceAttributeMultiprocessorCount, dev) != hipSuccess) { grid = -1; return; }
        if (hipOccupancyMaxActiveBlocksPerMultiprocessor(&per_cu, (const void*)fwd, NTHREADS, LDS_BYTES) != hipSuccess || per_cu < 1) { fprintf(stderr, "occupancy query failed (%d)\n", per_cu); grid = -1; return; }
        grid = cus;
        if (grid != 256) fprintf(stderr, "kernel_launch: note: %d CUs\n", grid);
    }
    if (grid < 0) return;
    Args a{};
    for (int i = 0; i < 20; ++i) a.in[i] = (const float*)d_in[i];
    a.out = (float*)d_out; a.ws = (unsigned char*)d_ws;
    (void)hipMemsetAsync((unsigned char*)d_ws + WS_CTL, 0, 1 * MiB, stream);
    if (N_LAUNCHES == 1) {
        a.ph_lo = 0; a.ph_hi = NPHASES;
        hipLaunchKernelGGL(fwd, dim3(grid), dim3(NTHREADS), LDS_BYTES, stream, a);
    } else {
        for (int p = 0; p < NPHASES; ++p) { a.ph_lo = p; a.ph_hi = p + 1; hipLaunchKernelGGL(fwd, dim3(grid), dim3(NTHREADS), LDS_BYTES, stream, a);
#ifdef DUP_PHASE
            if (p >= 1 && p < PH_FINAL && (p - 1) % 6 == DUP_PHASE) hipLaunchKernelGGL(fwd, dim3(grid), dim3(NTHREADS), LDS_BYTES, stream, a);
#endif
        }
    }
}
```

```cpp
#include <hip/hip_runtime.h>
#include <cstdio>
#include <cstdint>

constexpr int BATCH = 2, SEQ = 8192, DM = 1024, DEPTH = 2, MTOK = BATCH * SEQ;
constexpr int IN_COLS = 2724, DFF = 2816, NUP = 2 * DFF;
constexpr int HN = 2816;
constexpr int H_FQ = 0, H_FK = 256, H_FV = 512, H_DQ = 768, H_DK = 1280, H_DV = 1792, H_CQ = 2304, H_CKV = 2560, H_KR = 2688, H_FF = 2720;
constexpr float EPS = 1e-6f;
constexpr float LOG2E = 1.4426950408889634f;
constexpr float NEGV = -1e30f;

constexpr size_t MiB = 1u << 20;
constexpr size_t WS_CTL = 0;
constexpr size_t WS_W = 1 * MiB, WS_WL = 25 * MiB;
constexpr size_t W_IN = 0, W_UQ = 5632 * 1024, W_UKV = W_UQ + 256 * 1024, W_O = 6 * MiB, W_UP = 8 * MiB, W_DN = 19 * MiB;
constexpr size_t WS_XB = 51 * MiB;
constexpr size_t WS_SM = 83 * MiB;
constexpr size_t SM_RSTD1 = 0;
constexpr size_t SM_SSQ = 64 * 1024, SM_SSKV = 192 * 1024, SM_SS2 = 320 * 1024, SM_SS1N = 448 * 1024;
constexpr size_t SM_LOGF = 576 * 1024, SM_CUM = 832 * 1024;
constexpr size_t SM_ZERO_BEG = SM_SSQ, SM_ZERO_END = SM_LOGF;
constexpr size_t SM_PARAMS = 1092 * 1024;
constexpr size_t SM_KMAX = 1088 * 1024;
constexpr size_t WS_HB = 85 * MiB;
constexpr size_t WS_QM = 173 * MiB;
constexpr size_t WS_KVM = 185 * MiB;
constexpr size_t WS_KR = 201 * MiB;
constexpr size_t WS_AO = 202 * MiB;
constexpr size_t WS_END = 234 * MiB;
constexpr size_t WS_ROPE = 234 * MiB;
constexpr int CW_READYA = 16384;
constexpr int CW_READY = 8192;

#define LAS __attribute__((address_space(3)))
typedef unsigned short bf16;
typedef float f32x16 __attribute__((ext_vector_type(16)));
typedef unsigned v4u __attribute__((ext_vector_type(4)));
typedef unsigned v2u __attribute__((ext_vector_type(2)));
__device__ __forceinline__ unsigned f2bf(float f) { unsigned u = __builtin_bit_cast(unsigned, f); return (u + 0x7fffu + ((u >> 16) & 1u)) >> 16; }
__device__ __forceinline__ unsigned pk2(float lo, float hi) { return f2bf(lo) | (f2bf(hi) << 16); }
__device__ __forceinline__ float bf2f(unsigned b) { return __builtin_bit_cast(float, (b & 0xffffu) << 16); }
__device__ __forceinline__ float bflo(unsigned w) { return __builtin_bit_cast(float, w << 16); }
__device__ __forceinline__ float bfhi(unsigned w) { return __builtin_bit_cast(float, w & 0xffff0000u); }

namespace pg8 {
#define PG8_LAS __attribute__((address_space(3)))
typedef unsigned short bf16_t;
typedef short bf16x8 __attribute__((ext_vector_type(8)));
typedef float f32x4 __attribute__((ext_vector_type(4)));
typedef unsigned u32x4 __attribute__((ext_vector_type(4)));
constexpr int BM = 256, BK = 64, HALF = 128, HTB = HALF * BK * 2  , STAGE_BYTES = 8 * HTB, NXCD = 8, WGM = 8;

__host__ __device__ __forceinline__ int lds_byte(int r, int c) { const int st = (r >> 4) * 2 + (c >> 5), rr = r & 15, cc = c & 31, ob = rr * 64 + cc * 2; return st * 1024 + (ob ^ (((ob >> 9) & 1) << 5)); }
__host__ __device__ __forceinline__ void stage_rc(int b, int& R, int& C) { const int st = b / 1024, sb = b % 1024, swz = sb ^ (((sb >> 9) & 1) << 5); R = (st >> 1) * 16 + swz / 64; C = (st & 1) * 32 + (swz % 64) / 2; }
__host__ __device__ __forceinline__ int perm32(int rho) { const int n = rho >> 4, i = rho & 15; return 8 * (i >> 2) + 4 * n + (i & 3); }

struct Unit { int pm, pn; };
struct Gemm { const bf16_t* A; const bf16_t* Bt; int M, N, K, lda; };

struct StaticOrder {
    int nM, nN, nwg, G, c;
    __host__ __device__ void init(int M, int N, int G_, int c_) { nM = M / BM; nN = N / BM; nwg = nM * nN; G = G_; c = c_; }
    __host__ __device__ bool next(int i, Unit& u) const {
        const long L = (long)i * G + c; if (L >= nwg) return false;
        int wgid = (int)L; { const int q = nwg / NXCD, r = nwg % NXCD, xcd = wgid % NXCD, off = wgid / NXCD; wgid = (xcd < r ? xcd * (q + 1) : r * (q + 1) + (xcd - r) * q) + off; }
        const int nig = WGM * nN, gid = wgid / nig, fm = gid * WGM, gsz = (nM - fm) < WGM ? (nM - fm) : WGM;
        u.pm = fm + ((wgid % nig) % gsz); u.pn = (wgid % nig) / gsz; return true;
    }
    __device__ __forceinline__ int arow(const Unit& u) const { return u.pm * BM; }
    __device__ __forceinline__ int arperm(int R) const { return R; }
    __device__ __forceinline__ int ahalf() const { return HALF; }
    __device__ __forceinline__ void a_ready(const Unit&) const {}
    __device__ __forceinline__ void done(const Unit&) const {}
};

__device__ __forceinline__ unsigned cvt_pk_bf16(float lo, float hi) { unsigned r; asm volatile("v_cvt_pk_bf16_f32 %0, %1, %2" : "=v"(r) : "v"(lo), "v"(hi)); return r; }
typedef float f32x2 __attribute__((ext_vector_type(2)));
__device__ __forceinline__ void glds16_s(unsigned voff, const void* sbase, unsigned ldsdst) {
    unsigned keep; ldsdst = __builtin_amdgcn_readfirstlane(ldsdst);
    { const unsigned long long p_ = (unsigned long long)sbase; sbase = (const void*)(((unsigned long long)(unsigned)__builtin_amdgcn_readfirstlane((unsigned)(p_ >> 32)) << 32) | (unsigned)__builtin_amdgcn_readfirstlane((unsigned)p_)); }
    asm volatile("s_mov_b32 %0, m0\n\ts_mov_b32 m0, %3\n\ts_nop 2\n\tglobal_load_lds_dwordx4 %1, %2\n\ts_mov_b32 m0, %0" : "=&s"(keep) : "v"(voff), "s"(sbase), "s"(ldsdst) : "memory");
}
__device__ __forceinline__ void glds4_s(unsigned voff, const void* sbase, unsigned ldsdst) {
    unsigned keep; ldsdst = __builtin_amdgcn_readfirstlane(ldsdst);
    { const unsigned long long p_ = (unsigned long long)sbase; sbase = (const void*)(((unsigned long long)(unsigned)__builtin_amdgcn_readfirstlane((unsigned)(p_ >> 32)) << 32) | (unsigned)__builtin_amdgcn_readfirstlane((unsigned)p_)); }
    asm volatile("s_mov_b32 %0, m0\n\ts_mov_b32 m0, %3\n\ts_nop 2\n\tglobal_load_lds_dword %1, %2\n\ts_mov_b32 m0, %0" : "=&s"(keep) : "v"(voff), "s"(sbase), "s"(ldsdst) : "memory");
}
template <class Epi, class Sched, bool ALIGN_EPI = false, bool SP2 = false>
__device__ __forceinline__ void gemm_phase(PG8_LAS unsigned char* lds, const Gemm g, const Sched& S, const Epi& E) {
    int tid_l = threadIdx.x; asm volatile("" : "+v"(tid_l));
    const int tid = tid_l, wid = __builtin_amdgcn_readfirstlane(tid >> 6), lane = tid & 63, wr = wid >> 2, wc = wid & 3, fr = lane & 15, fq = lane >> 4;
    const int K = g.K, nt = K / BK;
    unsigned voffA[2], voffB[2];
#pragma unroll
    for (int i = 0; i < 2; ++i) { int R, C; stage_rc(tid * 16 + i * 8192, R, C); const int Rb = Epi::PERM ? ((R & ~31) + perm32(R & 31)) : R;
        voffA[i] = (unsigned)(S.arperm(R) * g.lda + C) * 2u; voffB[i] = (unsigned)(Rb * K + C) * 2u; }
    const unsigned kstep = (unsigned)(BK * 2);
    const unsigned hstep = (unsigned)HALF * K * 2; const unsigned hstepA = (unsigned)S.ahalf() * g.lda * 2;
    const unsigned tstep = 2 * hstep;
    const unsigned ldsw = (unsigned)wid * 1024u;
    const int aoff = lds_byte(wr * 64 + fr, fq * 8), boff = lds_byte(wc * 32 + fr, fq * 8);
#define PG8_SA(b, h) (((b) * 2 + (h)) * HTB)
#define PG8_SB(b, h) ((4 + (b) * 2 + (h)) * HTB)
#define PG8_STAGE(bufoff, gbase, voff) do { _Pragma("unroll") for (int _i = 0; _i < 2; ++_i) \
        glds16_s((voff)[_i], (const char*)(gbase), (unsigned)(uintptr_t)(lds + (bufoff) + ldsw + _i * 8192)); } while (0)
#define PG8_LDA(dst, b, h) do { _Pragma("unroll") for (int m = 0; m < 4; ++m) _Pragma("unroll") for (int k = 0; k < 2; ++k) dst[m][k] = *(const PG8_LAS bf16x8*)(lds + PG8_SA(b, h) + aoff + m * 2048 + k * 1024); } while (0)
#define PG8_LDB(dst, b, h) do { _Pragma("unroll") for (int n = 0; n < 2; ++n) _Pragma("unroll") for (int k = 0; k < 2; ++k) dst[n][k] = *(const PG8_LAS bf16x8*)(lds + PG8_SB(b, h) + boff + n * 2048 + k * 1024); } while (0)
#define PG8_MMA(ai, bj, At, Bt) do { __builtin_amdgcn_s_setprio(1); _Pragma("unroll") for (int m = 0; m < 4; ++m) _Pragma("unroll") for (int n = 0; n < 2; ++n) _Pragma("unroll") for (int k = 0; k < 2; ++k) \
        acc[ai][bj][m][n] = __builtin_amdgcn_mfma_f32_16x16x32_bf16(Bt[n][k], At[m][k], acc[ai][bj][m][n], 0, 0, 0); __builtin_amdgcn_s_setprio(0); } while (0)
#define PG8_WAIT_V(n) asm volatile("s_waitcnt vmcnt(" #n ")" ::: "memory")
#define PG8_WAIT_L(n) asm volatile("s_waitcnt lgkmcnt(" #n ")" ::: "memory")
#define PG8_BAR __builtin_amdgcn_s_barrier()
#define PG8_SCHED __builtin_amdgcn_sched_barrier(0)
    Unit cur, nxt; int ui = 0;
    if (!S.next(0, cur)) return;
    f32x4 acc[2][2][4][2];
#pragma unroll
    for (int a = 0; a < 2; ++a)
#pragma unroll
        for (int b = 0; b < 2; ++b)
#pragma unroll
            for (int m = 0; m < 4; ++m)
#pragma unroll
                for (int n = 0; n < 2; ++n) acc[a][b][m][n] = (f32x4){0.f, 0.f, 0.f, 0.f};
    bf16x8 At[4][2], B0[2][2], B1[2][2];
    const char* cA = (const char*)g.A + (size_t)S.arow(cur) * g.lda * 2; const char* cB = (const char*)g.Bt + (size_t)cur.pn * tstep;
    S.a_ready(cur);
    if constexpr (SP2) {
        PG8_STAGE(PG8_SB(0, 0), cB, voffB); PG8_STAGE(PG8_SB(0, 1), cB + hstep, voffB); PG8_STAGE(PG8_SA(0, 0), cA, voffA); PG8_STAGE(PG8_SA(0, 1), cA + hstepA, voffA);
        if (wr == 1) PG8_BAR;
        PG8_WAIT_V(2); PG8_BAR;
        PG8_STAGE(PG8_SB(1, 0), cB + kstep, voffB); PG8_STAGE(PG8_SA(1, 0), cA + kstep, voffA); PG8_STAGE(PG8_SB(1, 1), cB + hstep + kstep, voffB);
        PG8_WAIT_V(6); PG8_BAR;
    } else {
        PG8_STAGE(PG8_SB(0, 0), cB, voffB); PG8_STAGE(PG8_SA(0, 0), cA, voffA); PG8_STAGE(PG8_SB(0, 1), cB + hstep, voffB); PG8_STAGE(PG8_SA(0, 1), cA + hstepA, voffA);
        if (wr == 1) PG8_BAR;
        PG8_WAIT_V(4); PG8_BAR;
        PG8_STAGE(PG8_SB(1, 0), cB + kstep, voffB); PG8_STAGE(PG8_SA(1, 0), cA + kstep, voffA); PG8_STAGE(PG8_SB(1, 1), cB + hstep + kstep, voffB);
        PG8_WAIT_V(6); PG8_BAR;
    }
    for (;;) {
        const bool has_next = S.next(ui + 1, nxt);
        const char* nA = has_next ? (const char*)g.A + (size_t)S.arow(nxt) * g.lda * 2 : cA; const char* nB = has_next ? (const char*)g.Bt + (size_t)nxt.pn * tstep : cB;
        for (int t = 0; t < nt; t += 2) {
            const bool last = (t == nt - 2);
            const char* a1 = cA + (size_t)(t + 1) * kstep;
            const char* a2 = last ? nA : cA + (size_t)(t + 2) * kstep; const char* b2 = last ? nB : cB + (size_t)(t + 2) * kstep;
            const char* a3 = a2 + kstep; const char* b3 = b2 + kstep;
            if (last && has_next) S.a_ready(nxt);
            if constexpr (SP2) {
            PG8_LDB(B0, 0, 0); PG8_LDB(B1, 0, 1); PG8_SCHED; PG8_LDA(At, 0, 0); PG8_STAGE(PG8_SA(1, 1), a1 + hstepA, voffA);
            PG8_WAIT_V(8); PG8_WAIT_L(0); PG8_BAR; PG8_MMA(0, 0, At, B0); PG8_MMA(0, 1, At, B1); PG8_BAR; PG8_SCHED;
            PG8_LDA(At, 0, 1); PG8_STAGE(PG8_SB(0, 0), b2, voffB); PG8_STAGE(PG8_SB(0, 1), b2 + hstep, voffB); PG8_STAGE(PG8_SA(0, 0), a2, voffA);
            PG8_WAIT_V(8); PG8_WAIT_L(0); PG8_BAR; PG8_MMA(1, 0, At, B0); PG8_MMA(1, 1, At, B1); PG8_BAR; PG8_SCHED;
            PG8_LDB(B0, 1, 0); PG8_LDB(B1, 1, 1); PG8_SCHED; PG8_LDA(At, 1, 0); PG8_STAGE(PG8_SA(0, 1), a2 + hstepA, voffA);
            PG8_WAIT_V(8); PG8_WAIT_L(0); PG8_BAR; PG8_MMA(0, 0, At, B0); PG8_MMA(0, 1, At, B1); PG8_BAR; PG8_SCHED;
            PG8_LDA(At, 1, 1); PG8_STAGE(PG8_SB(1, 0), b3, voffB); PG8_STAGE(PG8_SB(1, 1), b3 + hstep, voffB); PG8_STAGE(PG8_SA(1, 0), a3, voffA);
            PG8_WAIT_V(8); PG8_WAIT_L(0); PG8_BAR; PG8_MMA(1, 0, At, B0); PG8_MMA(1, 1, At, B1); PG8_BAR; PG8_SCHED;
            } else {
            PG8_LDB(B0, 0, 0); PG8_SCHED; PG8_LDA(At, 0, 0); PG8_STAGE(PG8_SA(1, 1), a1 + hstepA, voffA);
            PG8_WAIT_L(8); PG8_BAR; PG8_WAIT_L(0); PG8_MMA(0, 0, At, B0); PG8_BAR; PG8_SCHED;
            PG8_LDB(B1, 0, 1); PG8_STAGE(PG8_SB(0, 0), b2, voffB);
            PG8_BAR; PG8_WAIT_L(0); PG8_MMA(0, 1, At, B1); PG8_BAR;
            PG8_LDA(At, 0, 1); PG8_STAGE(PG8_SA(0, 0), a2, voffA);
            PG8_BAR; PG8_WAIT_L(0); PG8_MMA(1, 0, At, B0); PG8_BAR; PG8_SCHED;
            PG8_STAGE(PG8_SB(0, 1), b2 + hstep, voffB);
            PG8_WAIT_V(6); PG8_BAR; PG8_MMA(1, 1, At, B1); PG8_BAR;
            PG8_LDB(B0, 1, 0); PG8_SCHED; PG8_LDA(At, 1, 0); PG8_STAGE(PG8_SA(0, 1), a2 + hstepA, voffA);
            PG8_WAIT_L(8); PG8_BAR; PG8_WAIT_L(0); PG8_MMA(0, 0, At, B0); PG8_BAR; PG8_SCHED;
            PG8_LDB(B1, 1, 1); PG8_STAGE(PG8_SB(1, 0), b3, voffB);
            PG8_BAR; PG8_WAIT_L(0); PG8_MMA(0, 1, At, B1); PG8_BAR;
            PG8_LDA(At, 1, 1); PG8_STAGE(PG8_SA(1, 0), a3, voffA);
            PG8_BAR; PG8_WAIT_L(0); PG8_MMA(1, 0, At, B0); PG8_BAR; PG8_SCHED;
            PG8_STAGE(PG8_SB(1, 1), b3 + hstep, voffB);
            PG8_WAIT_V(6); PG8_BAR; PG8_MMA(1, 1, At, B1); PG8_BAR;
            }
        }
        if constexpr (ALIGN_EPI) { if (wr == 0) PG8_BAR; }
        if constexpr (!Epi::AFTER_DRAIN) { E(acc, cur, wr, wc, fr, fq); S.done(cur); }
        if (!has_next) break;
#pragma unroll
        for (int a = 0; a < 2; ++a)
#pragma unroll
            for (int b = 0; b < 2; ++b)
#pragma unroll
                for (int m = 0; m < 4; ++m)
#pragma unroll
                    for (int n = 0; n < 2; ++n) acc[a][b][m][n] = (f32x4){0.f, 0.f, 0.f, 0.f};
        cur = nxt; cA = nA; cB = nB; ++ui;
        if constexpr (ALIGN_EPI) { if (wr == 1) PG8_BAR; }
    }
    PG8_WAIT_V(0);
    if constexpr (!ALIGN_EPI) { if (wr == 0) PG8_BAR; }
    PG8_BAR;
    if constexpr (Epi::AFTER_DRAIN) { E.fused(acc, cur, wr, wc, fr, fq, lds, wid, lane); S.done(cur); }
#undef PG8_SA
#undef PG8_SB
#undef PG8_STAGE
#undef PG8_LDA
#undef PG8_LDB
#undef PG8_MMA
#undef PG8_WAIT_V
#undef PG8_WAIT_L
#undef PG8_BAR
#undef PG8_SCHED
}
}
constexpr int NWAVES = 8, NTHREADS = 512;
constexpr int RING_BYTES = 131072, LDS_BYTES = 163840;
struct Args { const float* in[20]; float* out; unsigned char* ws; int ph_lo, ph_hi, layer, pad; };
enum { I_X = 0, I_LN1G, I_WIN, I_FB, I_LQ1, I_LK1, I_LQ2, I_LK2, I_DNG, I_QNG, I_WUQ, I_KVNG, I_WUKV, I_WO, I_LN2G, I_WUP, I_CW, I_CB, I_WDN, I_FG };

__device__ __forceinline__ float wave_sum(float v) {
#pragma unroll
    for (int o = 1; o < 64; o <<= 1) v += __shfl_xor(v, o);
    return v;
}
struct MapIn {
    __device__ __forceinline__ int src(int n) const { return n < 768 ? n : (n < 2720 ? n + 4 : (n < 2724 ? n - 2720 + 768 : -1)); }
    __device__ __forceinline__ float scale(int n) const { return (n < 256 || (n >= H_DQ && n < H_DK)) ? 0.125f * LOG2E : 1.0f; }
};
struct MapUq {
    __device__ __forceinline__ int src(int n) const { if (n >= 384) return -1; const int h = n / 96, d = n % 96; if (d < 64) return n; const int jj = d - 64; return h * 96 + 64 + (jj >> 1) + 16 * (jj & 1); }
    __device__ __forceinline__ float scale(int) const { return 0.10206207261596577f * LOG2E; }
};
struct MapId {
    __device__ __forceinline__ int src(int n) const { return n; }
    __device__ __forceinline__ float scale(int) const { return 1.0f; }
};
struct MapUp {
    __device__ __forceinline__ int src(int n) const { return ((n >> 7) & 1) * DFF + 128 * (n >> 8) + (n & 127); }
    __device__ __forceinline__ float scale(int) const { return 1.0f; }
};
template <class Map>
__device__ __forceinline__ void wprep_item(const float* W, int ldw, int K, bf16* WT, int nblk, LAS float* scr, int item, int lane, const float* gk, const Map map) {
    const int kb = item / nblk, nb = item % nblk, k0 = 64 * kb, n0 = 32 * nb;
    const int nd = n0 + (lane & 31), sc = map.src(nd); const float cs = map.scale(nd);
    float wv[32];
#pragma unroll
    for (int i = 0; i < 32; ++i) { const int kk = 2 * i + (lane >> 5); wv[i] = (sc >= 0) ? W[(size_t)(k0 + kk) * ldw + sc] : 0.f; }
#pragma unroll
    for (int i = 0; i < 32; ++i) { const int kk = 2 * i + (lane >> 5); float v = wv[i]; if (gk) v *= gk[k0 + kk]; scr[kk * 33 + (lane & 31)] = v * cs; }
    asm volatile("s_waitcnt lgkmcnt(0)" ::: "memory");
    const int c = lane & 7;
#pragma unroll
    for (int j = 0; j < 4; ++j) { const int n = (lane >> 3) + 8 * j; const LAS float* s = scr + (8 * c) * 33 + n;
        v4u o; o.x = pk2(s[0 * 33], s[1 * 33]); o.y = pk2(s[2 * 33], s[3 * 33]); o.z = pk2(s[4 * 33], s[5 * 33]); o.w = pk2(s[6 * 33], s[7 * 33]);
        *(v4u*)(WT + (size_t)(n0 + n) * K + k0 + 8 * c) = o; }
    asm volatile("s_waitcnt lgkmcnt(0)" ::: "memory");
}
__device__ __forceinline__ void xprep_row(const float* xrow, bf16* orow, float* rstd, int lane) {
    const float4* xr = (const float4*)xrow + lane;
    float4 v[4]; float s = 0.f;
#pragma unroll
    for (int j = 0; j < 4; ++j) { v[j] = xr[64 * j]; s += (v[j].x * v[j].x + v[j].y * v[j].y) + (v[j].z * v[j].z + v[j].w * v[j].w); }
    s = wave_sum(s);
    if (lane == 0) *rstd = s;
    v2u* o8 = (v2u*)orow + lane;
#pragma unroll
    for (int j = 0; j < 4; ++j) { v2u w; w.x = pk2(v[j].x, v[j].y); w.y = pk2(v[j].z, v[j].w); o8[64 * j] = w; }
}
constexpr int WI_IN = 16 * 88, WI_UQ = 4 * 16, WI_UKV = 2 * 16, WI_O = 16 * 32, WI_UP = 16 * 176, WI_DN = 44 * 32, WI_L = WI_IN + WI_UQ + WI_UKV + WI_O + WI_UP + WI_DN;
constexpr int WI_P0 = WI_IN + WI_UQ + WI_UKV;
constexpr int WI_EARLY = WI_IN + WI_UQ + WI_UKV + WI_O;
constexpr int WI_A = WI_EARLY + WI_UP;
constexpr int WI_B = WI_L + WI_IN + WI_UQ + WI_UKV;
constexpr int WI_C = WI_B + WI_O + WI_UP;
__device__ __forceinline__ void wprep_range(const __attribute__((address_space(4))) Args* ap_, LAS unsigned char* lds, int it_lo, int it_hi, int wv, int nwv, int lane, int wave) {
    LAS float* scr = (LAS float*)(lds + wave * 16384);
    unsigned char* ws = ap_->ws;
    for (int it = it_lo + wv; it < it_hi; it += nwv) {
        const int l = it / WI_L; int r = it % WI_L;
        unsigned char* wl = ws + WS_W + (size_t)l * WS_WL;
        if (r < WI_IN) { wprep_item(ap_->in[I_WIN] + (size_t)l * DM * IN_COLS, IN_COLS, DM, (bf16*)(wl + W_IN), 88, scr, r, lane, ap_->in[I_LN1G] + l * DM, MapIn()); continue; } r -= WI_IN;
        if (r < WI_UQ) { wprep_item(ap_->in[I_WUQ] + (size_t)l * 256 * 384, 384, 256, (bf16*)(wl + W_UQ), 16, scr, r, lane, ap_->in[I_QNG] + l * 256, MapUq()); continue; } r -= WI_UQ;
        if (r < WI_UKV) { wprep_item(ap_->in[I_WUKV] + (size_t)l * 128 * 512, 512, 128, (bf16*)(wl + W_UKV), 16, scr, r, lane, ap_->in[I_KVNG] + l * 128, MapId()); continue; } r -= WI_UKV;
        if (r < WI_O) { wprep_item(ap_->in[I_WO] + (size_t)l * DM * DM, DM, DM, (bf16*)(wl + W_O), 32, scr, r, lane, (const float*)nullptr, MapId()); continue; } r -= WI_O;
        if (r < WI_UP) { wprep_item(ap_->in[I_WUP] + (size_t)l * DM * NUP, NUP, DM, (bf16*)(wl + W_UP), 176, scr, r, lane, ap_->in[I_LN2G] + l * DM, MapUp()); continue; } r -= WI_UP;
        wprep_item(ap_->in[I_WDN] + (size_t)l * DFF * DM, DM, DFF, (bf16*)(wl + W_DN), 32, scr, r, lane, (const float*)nullptr, MapId());
    }
}
__device__ __forceinline__ void p0_prologue(const __attribute__((address_space(4))) Args* ap_, LAS unsigned char* lds, int gw, int ngw, int lane, int wave, bool defer) {
    unsigned char* ws = ap_->ws;
    wprep_range(ap_, lds, 0, defer ? WI_P0 : 2 * WI_L, gw, ngw, lane, wave);
    float* rstd1 = (float*)(ws + WS_SM + SM_RSTD1);
    for (int m = 4 * gw; m < MTOK; m += 4 * ngw) {
        const float4* xr = (const float4*)(ap_->in[I_X] + (size_t)m * DM) + lane;
        float4 v[4][4]; float s[4];
#pragma unroll
        for (int r = 0; r < 4; ++r)
#pragma unroll
            for (int j = 0; j < 4; ++j) v[r][j] = xr[r * (DM / 4) + 64 * j];
#pragma unroll
        for (int r = 0; r < 4; ++r) { s[r] = 0.f;
#pragma unroll
            for (int j = 0; j < 4; ++j) s[r] += (v[r][j].x * v[r][j].x + v[r][j].y * v[r][j].y) + (v[r][j].z * v[r][j].z + v[r][j].w * v[r][j].w);
            s[r] = wave_sum(s[r]); }
        if (lane == 0) { rstd1[m] = s[0]; rstd1[m + 1] = s[1]; rstd1[m + 2] = s[2]; rstd1[m + 3] = s[3]; }
        v2u* o0 = (v2u*)((bf16*)(ws + WS_XB) + (size_t)m * DM) + lane;
#pragma unroll
        for (int r = 0; r < 4; ++r)
#pragma unroll
            for (int j = 0; j < 4; ++j) { v2u w; w.x = pk2(v[r][j].x, v[r][j].y); w.y = pk2(v[r][j].z, v[r][j].w); o0[r * (DM / 4) + 64 * j] = w; }
    }
    float* z = (float*)(ws + WS_SM + SM_ZERO_BEG); const int nz = (int)((SM_ZERO_END - SM_ZERO_BEG) / 4);
    for (int i = gw * 64 + lane; i < nz; i += ngw * 64) z[i] = 0.f;
    if (gw == 0) { ((float*)(ws + WS_SM + SM_KMAX))[lane] = 0.f; ((float*)(ws + WS_SM + SM_KMAX))[64 + lane] = 0.f; }
    if (gw == 1) { float* pp = (float*)(ws + WS_SM + SM_PARAMS);
        for (int l = 0; l < DEPTH; ++l) { pp[l * 384 + lane] = ap_->in[I_LQ1][l * 64 + lane]; pp[l * 384 + 64 + lane] = ap_->in[I_LK1][l * 64 + lane]; pp[l * 384 + 128 + lane] = ap_->in[I_LQ2][l * 64 + lane];
            pp[l * 384 + 192 + lane] = ap_->in[I_LK2][l * 64 + lane]; pp[l * 384 + 256 + lane] = ap_->in[I_DNG][l * 128 + lane]; pp[l * 384 + 320 + lane] = ap_->in[I_DNG][l * 128 + 64 + lane]; } }
}
namespace pg8 {
__device__ __forceinline__ u32x4 pack8(const f32x4 v0, const f32x4 v1) { u32x4 w; w.x = cvt_pk_bf16(v0[0], v0[1]); w.y = cvt_pk_bf16(v0[2], v0[3]); w.z = cvt_pk_bf16(v1[0], v1[1]); w.w = cvt_pk_bf16(v1[2], v1[3]); return w; }
__device__ __forceinline__ float sq8(const f32x4 a, const f32x4 b) { return (a[0] * a[0] + a[1] * a[1]) + (a[2] * a[2] + a[3] * a[3]) + (b[0] * b[0] + b[1] * b[1]) + (b[2] * b[2] + b[3] * b[3]); }
__device__ __forceinline__ float log_sigmoid_d(float z) { return fminf(z, 0.f) - 0.6931471805599453f * __builtin_amdgcn_logf(1.0f + __builtin_amdgcn_exp2f(-1.4426950408889634f * fabsf(z))); }
__device__ __forceinline__ void store16_sc1(void* p, const u32x4 v) { asm volatile("global_store_dwordx4 %0, %1, off sc1\n\ts_nop 1" :: "v"(p), "v"(v) : "memory"); }
struct EpiH {
    static constexpr bool PERM = true, AFTER_DRAIN = false;
    unsigned char* ws; const float* fb; int l;
    __device__ __forceinline__ void operator()(const f32x4 (&acc)[2][2][4][2], const Unit& u, int wr, int wc, int fr, int fq) const {
        { int t_ = threadIdx.x; asm volatile("" : "+v"(t_)); fr = t_ & 15; fq = (t_ >> 4) & 3; const int w_ = __builtin_amdgcn_readfirstlane(t_ >> 6); wr = w_ >> 2; wc = w_ & 3; }
        bf16_t* Hb = (bf16_t*)(ws + WS_HB); float* sm = (float*)(ws + WS_SM);
        const float* ssin = l == 0 ? sm + SM_RSTD1 / 4 : sm + SM_SS1N / 4 + (l - 1) * MTOK;
        float* logf = sm + SM_LOGF / 4; float* ssq = sm + SM_SSQ / 4 + l * MTOK; float* sskv = sm + SM_SSKV / 4 + l * MTOK;
        const bool isk = (u.pn == 1 || u.pn == 5 || u.pn == 6);
        float kmx0 = 0.f, kmx1 = 0.f;
        const int row0 = u.pm * BM + wr * 64 + fr, colw = wc * 32 + 8 * fq;
        float rsv[8];
#pragma unroll
        for (int g = 0; g < 8; ++g) rsv[g] = ssin[row0 + (g >> 2) * HALF + (g & 3) * 16];
#pragma unroll
        for (int ai = 0; ai < 2; ++ai)
#pragma unroll
            for (int m = 0; m < 4; ++m) {
                const int row = row0 + ai * HALF + m * 16; const float rs = __builtin_amdgcn_rsqf(rsv[ai * 4 + m] * (1.0f / DM) + EPS);
                float s = 0.f;
#pragma unroll
                for (int bj = 0; bj < 2; ++bj) {
                    const f32x4 v0 = acc[ai][bj][m][0] * rs, v1 = acc[ai][bj][m][1] * rs;
                    if (u.pn == 9 || (u.pn == 10 && bj == 0)) { store16_sc1(Hb + (size_t)row * HN + u.pn * BM + bj * HALF + colw, pack8(v0, v1)); s += sq8(v0, v1); }
                    else *(u32x4*)(Hb + (size_t)row * HN + u.pn * BM + bj * HALF + colw) = pack8(v0, v1);
                    if (u.pn == 10 && bj == 1 && wc == 0) {
                        f32x4 w0, w1;
#pragma unroll
                        for (int i = 0; i < 4; ++i) { w0[i] = __shfl_xor(v0[i], 32); w1[i] = __shfl_xor(v1[i], 32); }
                        if (fq < 2) { const float2* rt = (const float2*)(ws + WS_ROPE) + (size_t)(row & (SEQ - 1)) * 16 + 8 * fq; u32x4 ka, kb;
                            const float2 c0 = rt[0], c1 = rt[1], c2 = rt[2], c3 = rt[3], c4 = rt[4], c5 = rt[5], c6 = rt[6], c7 = rt[7];
                            ka.x = cvt_pk_bf16(v0[0] * c0.x - w0[0] * c0.y, v0[0] * c0.y + w0[0] * c0.x); ka.y = cvt_pk_bf16(v0[1] * c1.x - w0[1] * c1.y, v0[1] * c1.y + w0[1] * c1.x);
                            ka.z = cvt_pk_bf16(v0[2] * c2.x - w0[2] * c2.y, v0[2] * c2.y + w0[2] * c2.x); ka.w = cvt_pk_bf16(v0[3] * c3.x - w0[3] * c3.y, v0[3] * c3.y + w0[3] * c3.x);
                            kb.x = cvt_pk_bf16(v1[0] * c4.x - w1[0] * c4.y, v1[0] * c4.y + w1[0] * c4.x); kb.y = cvt_pk_bf16(v1[1] * c5.x - w1[1] * c5.y, v1[1] * c5.y + w1[1] * c5.x);
                            kb.z = cvt_pk_bf16(v1[2] * c6.x - w1[2] * c6.y, v1[2] * c6.y + w1[2] * c6.x); kb.w = cvt_pk_bf16(v1[3] * c7.x - w1[3] * c7.y, v1[3] * c7.y + w1[3] * c7.x);
                            bf16_t* kr = (bf16_t*)(ws + WS_KR) + (size_t)row * 32 + 16 * fq; *(u32x4*)kr = ka; *(u32x4*)(kr + 8) = kb; }
                    }
                    if (isk) { float p2 = sq8(v0, v1); p2 += __shfl_xor(p2, 16); p2 += __shfl_xor(p2, 32); if (bj == 0) kmx0 = __builtin_fmaxf(kmx0, p2); else kmx1 = __builtin_fmaxf(kmx1, p2); }
                    if (u.pn == 10 && bj == 1 && wc == 1 && fq == 0) { f32x4 lf; lf[0] = log_sigmoid_d(v0[0] + fb[0]); lf[1] = log_sigmoid_d(v0[1] + fb[1]); lf[2] = log_sigmoid_d(v0[2] + fb[2]); lf[3] = log_sigmoid_d(v0[3] + fb[3]); store16_sc1(logf + (size_t)row * 4, __builtin_bit_cast(u32x4, lf)); }
                }
                if (u.pn == 9 || u.pn == 10) { s += __shfl_xor(s, 16); s += __shfl_xor(s, 32); if (fq == 0) atomicAdd((u.pn == 9 ? ssq : sskv) + row, s); }
                asm volatile("" ::: "memory");
            }
        if (isk) {
            unsigned* kmax = (unsigned*)(sm + SM_KMAX / 4) + l * 64 + (u.pm / 32) * 32;
#pragma unroll
            for (int o = 1; o < 64; o <<= 1) { kmx0 = __builtin_fmaxf(kmx0, __shfl_xor(kmx0, o)); kmx1 = __builtin_fmaxf(kmx1, __shfl_xor(kmx1, o)); }
            if (fr == 0 && fq == 0) {
                const int i0 = u.pn == 1 ? (wc >> 1) : 4 + (2 * (u.pn - 5)) * 2 + (wc >> 1), i1 = u.pn == 1 ? 2 + (wc >> 1) : 4 + (2 * (u.pn - 5) + 1) * 2 + (wc >> 1);
                atomicMax(kmax + 2 * i0 + (wc & 1), __float_as_uint(kmx0)); atomicMax(kmax + 2 * i1 + (wc & 1), __float_as_uint(kmx1));
            }
        }
        if (u.pn == 9 || u.pn == 10) {
            asm volatile("s_waitcnt vmcnt(0)" ::: "memory");
            if (fr == 0 && fq == 0) __hip_atomic_fetch_add((unsigned*)(ws + WS_CTL) + CW_READY + l * 64 * 64 + 64 * u.pm, 1u, __ATOMIC_RELAXED, __HIP_MEMORY_SCOPE_AGENT);
        }
    }
};
struct EpiQ {
    static constexpr bool PERM = true, AFTER_DRAIN = false;
    bf16_t* QM; const float* ssq; const float2* rope;
    __device__ __forceinline__ void operator()(const f32x4 (&acc)[2][2][4][2], const Unit& u, int wr, int wc, int fr, int fq) const {
        { int t_ = threadIdx.x; asm volatile("" : "+v"(t_)); fr = t_ & 15; fq = (t_ >> 4) & 3; const int w_ = __builtin_amdgcn_readfirstlane(t_ >> 6); wr = w_ >> 2; wc = w_ & 3; }
        const int row0 = u.pm * BM + wr * 64 + fr, colw = wc * 32 + 8 * fq;
        float rsv[8];
#pragma unroll
        for (int g = 0; g < 8; ++g) rsv[g] = ssq[row0 + (g >> 2) * HALF + (g & 3) * 16];
#pragma unroll
        for (int ai = 0; ai < 2; ++ai)
#pragma unroll
            for (int m = 0; m < 4; ++m) {
                const int row = row0 + ai * HALF + m * 16; const float rs = __builtin_amdgcn_rsqf(rsv[ai * 4 + m] * (1.0f / 256.0f) + EPS);
                const float2* rt = rope + (size_t)(row & (SEQ - 1)) * 16;
#pragma unroll
                for (int bj = 0; bj < 2; ++bj) {
                    const int col = u.pn * BM + bj * HALF + colw;
                    if (col < 384) {
                        f32x4 v0 = acc[ai][bj][m][0] * rs, v1 = acc[ai][bj][m][1] * rs;
                        const int d = col % 96;
                        if (d >= 64) { const int j0 = (d - 64) >> 1; const float2 c0 = rt[j0], c1 = rt[j0 + 1], c2 = rt[j0 + 2], c3 = rt[j0 + 3];
                            f32x4 r0, r1;
                            r0[0] = v0[0] * c0.x - v0[1] * c0.y; r0[1] = v0[0] * c0.y + v0[1] * c0.x; r0[2] = v0[2] * c1.x - v0[3] * c1.y; r0[3] = v0[2] * c1.y + v0[3] * c1.x;
                            r1[0] = v1[0] * c2.x - v1[1] * c2.y; r1[1] = v1[0] * c2.y + v1[1] * c2.x; r1[2] = v1[2] * c3.x - v1[3] * c3.y; r1[3] = v1[2] * c3.y + v1[3] * c3.x;
                            v0 = r0; v1 = r1; }
                        *(u32x4*)(QM + (size_t)row * 384 + col) = pack8(v0, v1);
                    }
                }
                asm volatile("" ::: "memory");
            }
    }
};
struct EpiKV {
    static constexpr bool PERM = true, AFTER_DRAIN = false;
    bf16_t* KVM; const float* sskv;
    __device__ __forceinline__ void operator()(const f32x4 (&acc)[2][2][4][2], const Unit& u, int wr, int wc, int fr, int fq) const {
        { int t_ = threadIdx.x; asm volatile("" : "+v"(t_)); fr = t_ & 15; fq = (t_ >> 4) & 3; const int w_ = __builtin_amdgcn_readfirstlane(t_ >> 6); wr = w_ >> 2; wc = w_ & 3; }
        const int row0 = u.pm * BM + wr * 64 + fr, colw = wc * 32 + 8 * fq;
        float rsv[8];
#pragma unroll
        for (int g = 0; g < 8; ++g) rsv[g] = sskv[row0 + (g >> 2) * HALF + (g & 3) * 16];
#pragma unroll
        for (int ai = 0; ai < 2; ++ai)
#pragma unroll
            for (int m = 0; m < 4; ++m) {
                const int row = row0 + ai * HALF + m * 16; const float rs = __builtin_amdgcn_rsqf(rsv[ai * 4 + m] * (1.0f / 128.0f) + EPS);
#pragma unroll
                for (int bj = 0; bj < 2; ++bj) *(u32x4*)(KVM + (size_t)row * 512 + u.pn * BM + bj * HALF + colw) = pack8(acc[ai][bj][m][0] * rs, acc[ai][bj][m][1] * rs);
                asm volatile("" ::: "memory");
            }
    }
};
struct EpiRes {
    static constexpr bool PERM = true, AFTER_DRAIN = false;
    const float* xold; float* xnew; bf16_t* xb; float* ss;
    __device__ __forceinline__ void operator()(const f32x4 (&acc)[2][2][4][2], const Unit& u, int wr, int wc, int fr, int fq) const {
        { int t_ = threadIdx.x; asm volatile("" : "+v"(t_)); fr = t_ & 15; fq = (t_ >> 4) & 3; const int w_ = __builtin_amdgcn_readfirstlane(t_ >> 6); wr = w_ >> 2; wc = w_ & 3; }
        const int row0 = u.pm * BM + wr * 64 + fr, colw = wc * 32 + 8 * fq;
#pragma unroll
        for (int ai = 0; ai < 2; ++ai)
#pragma unroll
            for (int m = 0; m < 4; ++m) {
                const int row = row0 + ai * HALF + m * 16; float s = 0.f;
#pragma unroll
                for (int bj = 0; bj < 2; ++bj) {
                    const size_t off = (size_t)row * DM + u.pn * BM + bj * HALF + colw;
                    const f32x4 v0 = *(const f32x4*)(xold + off) + acc[ai][bj][m][0], v1 = *(const f32x4*)(xold + off + 4) + acc[ai][bj][m][1];
                    *(f32x4*)(xnew + off) = v0; *(f32x4*)(xnew + off + 4) = v1; *(u32x4*)(xb + off) = pack8(v0, v1);
                    s += sq8(v0, v1);
                }
                s += __shfl_xor(s, 16); s += __shfl_xor(s, 32); if (fq == 0) atomicAdd(ss + row, s);
                if (m & 1) asm volatile("" ::: "memory");
            }
    }
};
struct EpiResFinal {
    static constexpr bool PERM = true, AFTER_DRAIN = true;
    const float* xold; float* out; float* ss; const float* g; unsigned* cnt;
    __device__ __forceinline__ void fused(f32x4 (&acc)[2][2][4][2], const Unit& u, int wr, int wc, int fr, int fq, PG8_LAS unsigned char* lds, int wid, int lane) const {
        { int t_ = threadIdx.x; asm volatile("" : "+v"(t_)); fr = t_ & 15; fq = (t_ >> 4) & 3; const int w_ = __builtin_amdgcn_readfirstlane(t_ >> 6); wr = w_ >> 2; wc = w_ & 3; }
        const int row0 = u.pm * BM + wr * 64 + fr, colw = wc * 32 + 8 * fq;
#pragma unroll
        for (int ai = 0; ai < 2; ++ai)
#pragma unroll
            for (int m = 0; m < 4; ++m) {
                const int row = row0 + ai * HALF + m * 16; float s = 0.f;
#pragma unroll
                for (int bj = 0; bj < 2; ++bj) {
                    const size_t off = (size_t)row * DM + u.pn * BM + bj * HALF + colw;
                    acc[ai][bj][m][0] += *(const f32x4*)(xold + off); acc[ai][bj][m][1] += *(const f32x4*)(xold + off + 4);
                    s += sq8(acc[ai][bj][m][0], acc[ai][bj][m][1]);
                }
                s += __shfl_xor(s, 16); s += __shfl_xor(s, 32); if (fq == 0) atomicAdd(ss + row, s);
                if (m & 1) asm volatile("" ::: "memory");
            }
        asm volatile("s_waitcnt vmcnt(0)" ::: "memory");
        __syncthreads();
        if (threadIdx.x == 0) {
            unsigned* c = cnt + 16 * u.pm;
            __hip_atomic_fetch_add(c, 1u, __ATOMIC_RELAXED, __HIP_MEMORY_SCOPE_AGENT);
            unsigned spins = 0;
            while (__hip_atomic_load(c, __ATOMIC_RELAXED, __HIP_MEMORY_SCOPE_AGENT) < 4u && ++spins < (1u << 22)) __builtin_amdgcn_s_sleep(2);
        }
        __syncthreads();
#pragma unroll
        for (int ai = 0; ai < 2; ++ai)
#pragma unroll
            for (int m = 0; m < 4; ++m) {
                const int row = row0 + ai * HALF + m * 16;
                const float rs = __builtin_amdgcn_rsqf(__hip_atomic_load(ss + row, __ATOMIC_RELAXED, __HIP_MEMORY_SCOPE_AGENT) * (1.0f / DM) + EPS);
#pragma unroll
                for (int bj = 0; bj < 2; ++bj) {
                    const int col = u.pn * BM + bj * HALF + colw; const size_t off = (size_t)row * DM + col;
                    const f32x4 g0 = *(const f32x4*)(g + col), g1 = *(const f32x4*)(g + col + 4);
                    *(f32x4*)(out + off) = acc[ai][bj][m][0] * rs * g0; *(f32x4*)(out + off + 4) = acc[ai][bj][m][1] * rs * g1;
                }
            }
    }
};
struct HOrder : StaticOrder {
    __device__ void init_h(int G_, int c_) { nM = MTOK / BM; nN = 9; nwg = nM * nN; G = G_; c = c_; }
    __device__ bool next(int i, Unit& u) const {
        const int L = i * G + c; if (L >= 128 + nwg) return false;
        if (L < 128) { u.pm = L >> 1; u.pn = 9 + (L & 1); return true; }
        int wgid = L - 128; { const int q = nwg / NXCD, r = nwg % NXCD, xcd = wgid % NXCD, off = wgid / NXCD; wgid = (xcd < r ? xcd * (q + 1) : r * (q + 1) + (xcd - r) * q) + off; }
        const int nig = WGM * nN, gid = wgid / nig, fm = gid * WGM, gsz = (nM - fm) < WGM ? (nM - fm) : WGM;
        u.pm = fm + ((wgid % nig) % gsz); u.pn = (wgid % nig) / gsz; return true;
    }
};
struct MOrder {
    int nwg, Gm, cm; bool active; const unsigned* ready; unsigned need;
    __device__ void init(int G, int c, int c0, const unsigned* ready_, unsigned need_) { nwg = 128; Gm = G; cm = (c + G - c0) % G; active = true; ready = ready_; need = need_; }
    __device__ bool next(int i, Unit& u) const { if (!active) return false; const int L = i * Gm + cm; if (L >= nwg) return false; u.pm = L >> 1; u.pn = L & 1; return true; }
    __device__ __forceinline__ int arow(const Unit& u) const { return u.pm * BM; }
    __device__ __forceinline__ int arperm(int R) const { return R; }
    __device__ __forceinline__ int ahalf() const { return HALF; }
    __device__ __forceinline__ void a_ready(const Unit& u) const {
        if (threadIdx.x < 64) {
            unsigned polls = 0;
            while ((unsigned)__builtin_amdgcn_readfirstlane(__hip_atomic_load(ready + 64 * u.pm, __ATOMIC_RELAXED, __HIP_MEMORY_SCOPE_AGENT)) < need && ++polls < (1u << 22)) __builtin_amdgcn_s_sleep(2);
            __builtin_amdgcn_fence(__ATOMIC_ACQUIRE, "agent");
            asm volatile("s_waitcnt vmcnt(0)" ::: "memory");
        }
        asm volatile("" ::: "memory"); __builtin_amdgcn_s_barrier(); asm volatile("" ::: "memory");
    }
    __device__ __forceinline__ void done(const Unit&) const {}
};
struct HalfOrder {
    int nN, nwg, G2, c2; bool active;
    __device__ void init(int M, int N, int G, int c, int half) { nN = N / BM; nwg = (M / BM) * nN; G2 = G / 2; active = (c / G2) == half; c2 = c % G2; }
    __device__ bool next(int i, Unit& u) const { if (!active) return false; const int L = i * G2 + c2; if (L >= nwg) return false; u.pm = L / nN; u.pn = L % nN; return true; }
    __device__ __forceinline__ int arow(const Unit& u) const { return u.pm * BM; }
    __device__ __forceinline__ int arperm(int R) const { return R; }
    __device__ __forceinline__ int ahalf() const { return HALF; }
    __device__ __forceinline__ void a_ready(const Unit&) const {}
    __device__ __forceinline__ void done(const Unit&) const {}
};
constexpr int UP_TILES_PER_B = 33, UP_NM = 2 * UP_TILES_PER_B, UP_NN = NUP / 256;
__device__ __forceinline__ int up_tile_start(int pm) { const int b = pm / UP_TILES_PER_B, i = pm % UP_TILES_PER_B; int s = 252 * i; s = s > SEQ - 254 ? SEQ - 254 : s; return b * SEQ + s; }
struct UpOrder : StaticOrder {
    __device__ void init_up(int G_, int c_) { nM = UP_NM; nN = UP_NN; nwg = nM * nN; G = G_; c = c_; }
    __device__ __forceinline__ int arow(const Unit& u) const { return up_tile_start(u.pm); }
    __device__ __forceinline__ int arperm(int R) const { return R < 64 ? R : R + 62; }
    __device__ __forceinline__ int ahalf() const { return 64; }
};
template <int CTRL> __device__ __forceinline__ float dppz(float src) {
    return __builtin_bit_cast(float, __builtin_amdgcn_update_dpp(0, __builtin_bit_cast(int, src), CTRL, 0xf, 0xf, false));
}
struct EpiUp {
    static constexpr bool PERM = true, AFTER_DRAIN = false;
    unsigned char* ws; const float* cw; const float* cb; int l;
    __device__ __forceinline__ void operator()(f32x4 (&acc)[2][2][4][2], const Unit& u, int wr, int wc, int fr, int fq) const {
        { int t_ = threadIdx.x; asm volatile("" : "+v"(t_)); fr = t_ & 15; fq = (t_ >> 4) & 3; const int w_ = __builtin_amdgcn_readfirstlane(t_ >> 6); wr = w_ >> 2; wc = w_ & 3; }
        const float* ss2 = (const float*)(ws + WS_SM) + SM_SS2 / 4 + l * MTOK; bf16_t* act = (bf16_t*)(ws + WS_HB);
        const int t0 = up_tile_start(u.pm) + 126 * wr + fr;
        const bool keep_head = (u.pm % UP_TILES_PER_B) == 0 && wr == 0;
#pragma unroll
        for (int ai = 0; ai < 2; ++ai)
#pragma unroll
            for (int m = 0; m < 4; ++m) { const float rs = __builtin_amdgcn_rsqf(ss2[t0 + ai * 64 + m * 16] * (1.0f / DM) + EPS);
#pragma unroll
                for (int bj = 0; bj < 2; ++bj) { acc[ai][bj][m][0] *= rs; acc[ai][bj][m][1] *= rs; } }
        const int cg0 = u.pn * 128 + wc * 32 + 8 * fq;
#pragma unroll
        for (int n = 0; n < 2; ++n) {
            const int cg = cg0 + 4 * n;
            const f32x4 wg0 = *(const f32x4*)(cw + cg), wg1 = *(const f32x4*)(cw + NUP + cg), wg2 = *(const f32x4*)(cw + 2 * NUP + cg), bg = *(const f32x4*)(cb + cg);
            const f32x4 wu0 = *(const f32x4*)(cw + DFF + cg), wu1 = *(const f32x4*)(cw + NUP + DFF + cg), wu2 = *(const f32x4*)(cw + 2 * NUP + DFF + cg), bu = *(const f32x4*)(cb + DFF + cg);
#pragma unroll
            for (int ai = 0; ai < 2; ++ai)
#pragma unroll
                for (int m = 0; m < 4; ++m) {
                    const f32x4 xg = acc[ai][0][m][n], xu = acc[ai][1][m][n];
                    f32x4 pg, pu;
                    if (m > 0) { pg = acc[ai][0][m - 1][n]; pu = acc[ai][1][m - 1][n]; }
                    else if (ai > 0) { pg = acc[0][0][3][n]; pu = acc[0][1][3][n]; }
                    else { pg = (f32x4){0.f, 0.f, 0.f, 0.f}; pu = pg; }
                    float a[4];
#pragma unroll
                    for (int c = 0; c < 4; ++c) {
                        float G = __builtin_fmaf(wg2[c], xg[c], bg[c]), U = __builtin_fmaf(wu2[c], xu[c], bu[c]);
                        asm volatile("s_nop 1\n\tv_fmac_f32_dpp %0, %1, %3 row_shr:1 row_mask:0xf bank_mask:0xf bound_ctrl:1\n\tv_fmac_f32_dpp %0, %2, %3 row_shl:15 row_mask:0xf bank_mask:0xf bound_ctrl:1\n\t"
                                     "v_fmac_f32_dpp %0, %1, %4 row_shr:2 row_mask:0xf bank_mask:0xf bound_ctrl:1\n\tv_fmac_f32_dpp %0, %2, %4 row_shl:14 row_mask:0xf bank_mask:0xf bound_ctrl:1"
                                     : "+v"(G) : "v"(xg[c]), "v"(pg[c]), "v"(wg1[c]), "v"(wg0[c]));
                        asm volatile("s_nop 1\n\tv_fmac_f32_dpp %0, %1, %3 row_shr:1 row_mask:0xf bank_mask:0xf bound_ctrl:1\n\tv_fmac_f32_dpp %0, %2, %3 row_shl:15 row_mask:0xf bank_mask:0xf bound_ctrl:1\n\t"
                                     "v_fmac_f32_dpp %0, %1, %4 row_shr:2 row_mask:0xf bank_mask:0xf bound_ctrl:1\n\tv_fmac_f32_dpp %0, %2, %4 row_shl:14 row_mask:0xf bank_mask:0xf bound_ctrl:1"
                                     : "+v"(U) : "v"(xu[c]), "v"(pu[c]), "v"(wu1[c]), "v"(wu0[c]));
                        a[c] = G * __builtin_amdgcn_rcpf(1.0f + __builtin_amdgcn_exp2f(-1.4426950408889634f * G)) * U;
                    }
                    typedef unsigned u32x2 __attribute__((ext_vector_type(2)));
                    u32x2 w; w.x = cvt_pk_bf16(a[0], a[1]); w.y = cvt_pk_bf16(a[2], a[3]);
                    const bool halo = (ai == 0 && m == 0 && fr < 2 && !keep_head);
                    if (!halo) *(u32x2*)(act + (size_t)(t0 + ai * 64 + m * 16) * DFF + cg) = w;
                }
            asm volatile("" ::: "memory");
        }
    }
};
}
namespace att {
typedef short bf16x8 __attribute__((ext_vector_type(8)));
typedef short s16x4 __attribute__((ext_vector_type(4)));
typedef float f32x4 __attribute__((ext_vector_type(4)));
constexpr int ST_K = 0, ST_V = 16384, ST_CK = 32768, ST_BYTES = 33280;
constexpr int NSTAGE = 4, SC_OFF = NSTAGE * ST_BYTES;
constexpr float SKIP_MARGIN = 152.0f;
constexpr float THR = 8.0f;
constexpr float MASKV = -1.0e30f;
constexpr int N_FOX = 256, N_MLA = 256, N_DIFF = 512, N_ITEMS = N_FOX + N_MLA + N_DIFF;

__device__ __forceinline__ s16x4 vtr(LAS const unsigned char* p) { typedef short v4i16_t __attribute__((ext_vector_type(4))); return __builtin_bit_cast(s16x4, __builtin_amdgcn_ds_read_tr16_b64_v4i16((LAS v4i16_t*)p)); }
__device__ __forceinline__ unsigned cvtpk(float lo, float hi) { typedef float f32x2_t __attribute__((ext_vector_type(2))); typedef __bf16 bf16x2_t __attribute__((ext_vector_type(2))); f32x2_t v = {lo, hi}; bf16x2_t b = __builtin_convertvector(v, bf16x2_t); return __builtin_bit_cast(unsigned, b); }
__device__ __forceinline__ float max3f(float a, float b, float c) { return __builtin_fmaxf(__builtin_fmaxf(a, b), c); }
__device__ __forceinline__ float halfmax(float v) { auto rr = __builtin_amdgcn_permlane32_swap(__float_as_uint(v), __float_as_uint(v), false, false); return __builtin_fmaxf(__uint_as_float(rr[0]), __uint_as_float(rr[1])); }
__device__ __forceinline__ float halfsum(float v) { auto rr = __builtin_amdgcn_permlane32_swap(__float_as_uint(v), __float_as_uint(v), false, false); return __uint_as_float(rr[0]) + __uint_as_float(rr[1]); }

template <bool ISMAX> __device__ __forceinline__ float wave_red32(float v) {
#define RED_(x, y) (ISMAX ? __builtin_fmaxf((x), (y)) : __builtin_fminf((x), (y)))
    v = RED_(v, __builtin_bit_cast(float, __builtin_amdgcn_update_dpp(0, __builtin_bit_cast(int, v), 0xB1, 0xf, 0xf, false)));
    v = RED_(v, __builtin_bit_cast(float, __builtin_amdgcn_update_dpp(0, __builtin_bit_cast(int, v), 0x4E, 0xf, 0xf, false)));
    v = RED_(v, __builtin_bit_cast(float, __builtin_amdgcn_update_dpp(0, __builtin_bit_cast(int, v), 0x141, 0xf, 0xf, false)));
    v = RED_(v, __builtin_bit_cast(float, __builtin_amdgcn_update_dpp(0, __builtin_bit_cast(int, v), 0x140, 0xf, 0xf, false)));
    const float a = __builtin_bit_cast(float, __builtin_amdgcn_readlane(__builtin_bit_cast(int, v), 0)), b = __builtin_bit_cast(float, __builtin_amdgcn_readlane(__builtin_bit_cast(int, v), 16));
    return RED_(a, b);
#undef RED_
}
__device__ __forceinline__ void item_decode(int i, int& type, int& rem) { if (i < N_FOX) { type = 0; rem = i; } else if (i < N_FOX + N_DIFF) { type = 1; rem = i - N_FOX; } else { type = 2; rem = i - N_FOX - N_DIFF; } }
__device__ __forceinline__ int item_est(int i) {
    int type, rem; item_decode(i, type, rem);
    if (type == 0) { const int nt = 4 * (rem % 32) + 4; return 16 * (nt < 20 ? nt : 20); }
    if (type == 2) return 20 * (4 * (rem % 32) + 4);
    const int head = (rem / 64) & 3, nt = 2 * (rem % 64) + 2, w = head == 0 ? 10 : (head == 1 ? 32 : 128);
    return 24 * (nt < w ? nt : w);
}
__device__ __forceinline__ void build_items(int* list, LAS int* red, int bx, int tid, int G) {
    const int e0 = item_est(tid), e1 = item_est(tid + 512);
    for (int i = bx; i < N_ITEMS; i += G) {
        __syncthreads();
        const int ci = item_est(i);
        const int c = __builtin_popcountll(__ballot(e0 > ci || (e0 == ci && tid < i))) + __builtin_popcountll(__ballot(e1 > ci || (e1 == ci && tid + 512 < i)));
        if ((tid & 63) == 0) red[tid >> 6] = c;
        __syncthreads();
        if (tid == 0) { int type, rem; item_decode(i, type, rem); list[red[0] + red[1] + red[2] + red[3] + red[4] + red[5] + red[6] + red[7]] = type | (rem << 2); }
    }
    __syncthreads();
}

struct Params { unsigned char* ws; int l; float lam_init; };

#ifndef PROBE_FLAGS
#define PROBE_FLAGS 0
#endif
template <int MODE, int PRB = 0>
__device__ __forceinline__ void attn_unit(const Params& P, LAS unsigned char* lds, const int b, const int head, const int qblk, unsigned* qctr) {
    constexpr int DK = MODE == 2 ? 96 : 64, DV = MODE == 1 ? 128 : 64, NS = DK / 16, NDB = DV / 32;
    constexpr int KPITCH = MODE == 2 ? 256 : 128, VPITCH = DV * 2;
    int tid = threadIdx.x; asm volatile("" : "+v"(tid));
    const int lane = tid & 63, wave = __builtin_amdgcn_readfirstlane(tid >> 6), r = lane & 31, h = lane >> 5;
    const size_t rb = (size_t)b * SEQ;
    const int wq = MODE == 1 ? (wave & 3) : wave;
    const int map = MODE == 1 ? (wave >> 2) : 0;
    const int q0 = (MODE == 1 ? 128 : 256) * qblk, qrow = q0 + 32 * wq;
    const int NT = (MODE == 1 ? 2 : 4) * qblk + (MODE == 1 ? 2 : 4);
    const int jv = (MODE == 1 ? 2 : 4) * qblk + (wq >> 1);
    const bf16 *Qp, *Kp, *K2p = nullptr, *Vp; int qpitch, kpitch, vpitch; bf16* Op;
    const bf16* P_HB = (const bf16*)(P.ws + WS_HB); bf16* P_AO = (bf16*)(P.ws + WS_AO); const float* P_cum = (const float*)(P.ws + WS_SM + SM_CUM);
    const unsigned* P_kmax = (const unsigned*)(P.ws + WS_SM + SM_KMAX) + P.l * 64;
    constexpr int PFL = PRB ? PROBE_FLAGS : 0;
    if (PRB) P_AO = (bf16*)(P.ws + WS_XB);
    if (MODE == 0) { Qp = P_HB + H_FQ + head * 64; Kp = P_HB + H_FK + head * 64; Vp = P_HB + H_FV + head * 64; qpitch = kpitch = vpitch = HN; Op = P_AO + head * 64; }
    else if (MODE == 1) { Qp = P_HB + H_DQ + head * 128 + map * 64; Kp = P_HB + H_DK + head * 128; Vp = P_HB + H_DV + head * 128; qpitch = kpitch = vpitch = HN; Op = P_AO + 256 + head * 128; }
    else { const bf16* P_KVM = (const bf16*)(P.ws + WS_KVM); Qp = (const bf16*)(P.ws + WS_QM) + head * 96; Kp = P_KVM + head * 128; K2p = (const bf16*)(P.ws + WS_KR); Vp = P_KVM + head * 128 + 64; qpitch = 384; kpitch = vpitch = 512; Op = P_AO + 768 + head * 64; }
    bf16x8 qf[NS];
#pragma unroll
    for (int s = 0; s < NS; ++s) qf[s] = *(const bf16x8*)(Qp + (rb + qrow + r) * qpitch + 16 * s + 8 * h);
    unsigned dv0 = 0, dv1 = 0, dv2 = 0, dv3 = 0, ds0 = 0, ds1 = 0;
    const void* dbaseK = Kp; const void* dbaseV = Vp;
    if (MODE != 2) {
        const int row = 8 * wave + (lane >> 3), ch = (lane & 7) ^ ((row >> 1) & 7);
        dv0 = (unsigned)((rb + row) * kpitch * 2 + ch * 16); dv1 = dv0 + 128; ds0 = ds1 = 64 * kpitch * 2;
    } else {
#pragma unroll
        for (int i = 0; i < 2; ++i) { const int row = 4 * (2 * wave + i) + (lane >> 4), c = (lane & 15) ^ (row & 15);
            const unsigned off = (c >= 8 && c < 12) ? (unsigned)((const char*)K2p - (const char*)Kp) + (unsigned)((rb + row) * 64 + (c - 8) * 16) : (unsigned)((rb + row) * kpitch * 2 + (c < 8 ? c : 0) * 16);
            const unsigned st = (c >= 8 && c < 12) ? 64 * 64 : 64 * kpitch * 2;
            if (i == 0) { dv0 = off; ds0 = st; } else { dv1 = off; ds1 = st; } }
    }
    if (DV == 64) { const int row = 8 * wave + (lane >> 3), p = lane & 7; dv2 = (unsigned)((rb + row) * vpitch * 2 + ((((p >> 2) ^ ((row >> 1) & 1)) << 2) | (p & 3)) * 16); }
    else {
#pragma unroll
        for (int i = 0; i < 2; ++i) { const int row = 4 * (2 * wave + i) + (lane >> 4), p = lane & 15; const unsigned off = (unsigned)((rb + row) * vpitch * 2 + ((((p >> 2) ^ (row & 3)) << 2) | (p & 3)) * 16); if (i == 0) dv2 = off; else dv3 = off; }
    }
    const unsigned dck = (MODE == 0) ? (unsigned)(((rb + lane) * 4 + head) * 4) : 0u;
    const unsigned ldsb = (unsigned)(uintptr_t)lds;
#define ATT_DMA(j, st) do { const unsigned sb_ = ldsb + (st) * ST_BYTES; const unsigned jc_ = (unsigned)(j); const unsigned jj_ = (PFL & 64) ? 0u : jc_; \
        if (MODE == 2) { pg8::glds16_s(dv0 + jj_ * ds0, dbaseK, sb_ + ST_K + (2 * wave) * 1024); pg8::glds16_s(dv1 + jj_ * ds1, dbaseK, sb_ + ST_K + (2 * wave + 1) * 1024); } \
        else { pg8::glds16_s(dv0 + jj_ * ds0, dbaseK, sb_ + ST_K + wave * 1024); if (MODE == 1) pg8::glds16_s(dv1 + jj_ * ds1, dbaseK, sb_ + ST_K + 8192 + wave * 1024); } \
        if (DV == 64) pg8::glds16_s(dv2 + jj_ * (64 * vpitch * 2), dbaseV, sb_ + ST_V + wave * 1024); \
        else { pg8::glds16_s(dv2 + jj_ * (64 * vpitch * 2), dbaseV, sb_ + ST_V + (2 * wave) * 1024); pg8::glds16_s(dv3 + jj_ * (64 * vpitch * 2), dbaseV, sb_ + ST_V + (2 * wave + 1) * 1024); } \
        if (MODE == 0 && wave == 0) pg8::glds4_s(dck + jc_ * (64 * 16), (const void*)P_cum, sb_ + ST_CK); } while (0)
#define ATT_WAIT_1() do { if (MODE == 1) asm volatile("s_waitcnt vmcnt(4)" ::: "memory"); else if (MODE == 2 || wave == 0) asm volatile("s_waitcnt vmcnt(3)" ::: "memory"); else asm volatile("s_waitcnt vmcnt(2)" ::: "memory"); } while (0)
#define ATT_WAIT_0() asm volatile("s_waitcnt vmcnt(0)" ::: "memory")
    LAS float* scf = (LAS float*)(lds + SC_OFF);
    ATT_DMA(NT - 1, 0); ATT_DMA(NT - 2, 1);
    if (MODE != 2) {
        float qA = 0.f, qB = 0.f;
#pragma unroll
        for (int s = 0; s < NS; ++s)
#pragma unroll
            for (int e = 0; e < 8; ++e) { const float x = bf2f((unsigned short)qf[s][e]); if (s < NS / 2) qA += x * x; else qB += x * x; }
        qA = halfsum(qA); qB = halfsum(qB);
        const int ki = 2 * (MODE == 0 ? head : 4 + 2 * head + map);
        const float kA = __uint_as_float(P_kmax[b * 32 + ki]), kB = __uint_as_float(P_kmax[b * 32 + ki + 1]);
        const float ub = wave_red32<true>(__builtin_sqrtf(qA * kA) + __builtin_sqrtf(qB * kB));
        if (lane == 0) { scf[8 + wave] = ub; scf[wave] = MASKV; scf[32 + wave] = MASKV; }
    }
    unsigned ka[NS];
#pragma unroll
    for (int s = 0; s < NS; ++s) ka[s] = ST_K + (MODE == 1 ? map * 8192 : 0) + r * KPITCH + (MODE == 2 ? (((2 * s + h) ^ (r & 15)) << 4) : (((2 * s + h) ^ ((r >> 1) & 7)) << 4));
    unsigned va[NDB];
    { const int qp = (lane & 15) >> 2, kb_ = 4 * h + qp, dby = 32 * ((lane >> 4) & 1) + 8 * (lane & 3);
#pragma unroll
      for (int d = 0; d < NDB; ++d) va[d] = ST_V + kb_ * VPITCH + (DV == 64 ? ((d ^ ((qp >> 1) & 1)) << 6) : ((d ^ qp) << 6)) + dby; }
    f32x16 o[NDB];
#pragma unroll
    for (int d = 0; d < NDB; ++d)
#pragma unroll
        for (int i = 0; i < 16; ++i) o[d][i] = 0.f;
    float mref = 0.f, l_run = 0.f;
    const float slope2 = (MODE == 1) ? exp2f(-2.0f * (float)(head + 1)) * LOG2E : 0.f;
    f32x16 cini;
#pragma unroll
    for (int i = 0; i < 16; ++i) cini[i] = (MODE == 1) ? slope2 * (float)(64 * (NT - 1) + 4 * h - (qrow + r) + (i & 3) + 8 * (i >> 2)) : 0.f;
    ATT_WAIT_0(); __syncthreads();
    float qk_ub = 0.f;
    if (MODE != 2) {
        const f32x4 qa0 = *(LAS const f32x4*)(scf + 8), qa1 = *(LAS const f32x4*)(scf + 12);
        const float qmx = __builtin_fmaxf(__builtin_fmaxf(__builtin_fmaxf(qa0[0], qa0[1]), __builtin_fmaxf(qa0[2], qa0[3])), __builtin_fmaxf(__builtin_fmaxf(qa1[0], qa1[1]), __builtin_fmaxf(qa1[2], qa1[3])));
        qk_ub = qmx * 1.02f;
    }
    for (int tp = 0; tp < NT / 2; ++tp) {
        const int sg = (tp & 1) * 2;
        if (2 * tp + 2 < NT) { ATT_DMA(NT - 3 - 2 * tp, 2 - sg); ATT_DMA(NT - 4 - 2 * tp, 3 - sg); }
        if (MODE != 2) {
            const int mr = (tp & 1) ? 0 : 32; const f32x4 m0 = *(LAS const f32x4*)(scf + mr), m1 = *(LAS const f32x4*)(scf + mr + 4);
            const float mmin = __builtin_fminf(__builtin_fminf(__builtin_fminf(m0[0], m0[1]), __builtin_fminf(m0[2], m0[3])), __builtin_fminf(__builtin_fminf(m1[0], m1[1]), __builtin_fminf(m1[2], m1[3])));
            const float cm = MODE == 0 ? *(LAS const float*)(lds + sg * ST_BYTES + ST_CK + 63 * 4) : slope2 * (float)(64 * (NT - 1 - 2 * tp) + 63 - q0);
            if (qk_ub + cm < mmin - SKIP_MARGIN) break;
        }
#pragma nounroll
      for (int u2 = 0; u2 < 2; ++u2) {
        const int t = 2 * tp + u2, j = NT - 1 - t;
        if (j <= jv) {
            LAS const unsigned char* sb = lds + (sg + u2) * ST_BYTES;
            f32x16 p0, p1;
            if (MODE == 0) {
#pragma unroll
                for (int g = 0; g < 4; ++g) { const f32x4 c0 = *(LAS const f32x4*)(sb + ST_CK + 16 * h + 32 * g), c1 = *(LAS const f32x4*)(sb + ST_CK + 128 + 16 * h + 32 * g);
#pragma unroll
                    for (int i = 0; i < 4; ++i) { p0[4 * g + i] = c0[i]; p1[4 * g + i] = c1[i]; } }
            } else {
                p0 = cini;
#pragma unroll
                for (int i = 0; i < 16; ++i) p1[i] = (MODE == 1) ? cini[i] + 32.0f * slope2 : cini[i];
            }
            bf16x8 kf0[NS], kf1[NS];
#pragma unroll
            for (int s = 0; s < NS; ++s) { kf0[s] = *(LAS const bf16x8*)(sb + ka[s]); kf1[s] = *(LAS const bf16x8*)(sb + ka[s] + 32 * KPITCH); }
            s16x4 vloA[NDB][2], vhiA[NDB][2], vloB[NDB][2], vhiB[NDB][2];
#define ATT_VREAD(LO, HI, KS0) do { _Pragma("unroll") for (int d = 0; d < NDB; ++d) _Pragma("unroll") for (int k2 = 0; k2 < 2; ++k2) { \
                LO[d][k2] = vtr(sb + va[d] + ((KS0) + k2) * 16 * VPITCH); HI[d][k2] = vtr(sb + va[d] + ((KS0) + k2) * 16 * VPITCH + 8 * VPITCH); } } while (0)
            if (NDB == 2) { ATT_VREAD(vloA, vhiA, 0); ATT_VREAD(vloB, vhiB, 2); }
            __builtin_amdgcn_sched_barrier(0);
#pragma unroll
            for (int s = 0; s < NS; ++s) p0 = __builtin_amdgcn_mfma_f32_32x32x16_bf16(kf0[s], qf[s], p0, 0, 0, 0);
#pragma unroll
            for (int s = 0; s < NS; ++s) p1 = __builtin_amdgcn_mfma_f32_32x32x16_bf16(kf1[s], qf[s], p1, 0, 0, 0);
            if (NDB == 4) { __builtin_amdgcn_sched_barrier(0); ATT_VREAD(vloA, vhiA, 0); __builtin_amdgcn_sched_barrier(0); }
            if (j == jv) {
                if (MODE == 0) {
                    const int qrel = (qrow + r) - 64 * j - 4 * h;
#pragma unroll
                    for (int i = 0; i < 16; ++i) { const int kr_ = (i & 3) + 8 * (i >> 2); if (kr_ > qrel) p0[i] = MASKV; if (kr_ + 32 > qrel) p1[i] = MASKV; }
                } else if (MODE == 1) {
#pragma unroll
                    for (int i = 0; i < 16; ++i) { p0[i] -= 2.0f * __builtin_fmaxf(cini[i], 0.f); p1[i] -= 2.0f * __builtin_fmaxf(cini[i] + 32.0f * slope2, 0.f); }
                }
                float a = max3f(p0[0], p0[1], p1[0]), bq = max3f(p0[2], p0[3], p1[1]); a = max3f(a, p1[2], p1[3]);
#pragma unroll
                for (int i = 4; i < 16; i += 4) { a = max3f(a, p0[i], p0[i + 1]); bq = max3f(bq, p0[i + 2], p0[i + 3]); a = max3f(a, p1[i], p1[i + 1]); bq = max3f(bq, p1[i + 2], p1[i + 3]); }
                mref = halfmax(__builtin_fmaxf(a, bq));
                if (MODE != 0) {
#pragma unroll
                    for (int i = 0; i < 16; ++i) { p0[i] -= mref; p1[i] -= mref; cini[i] -= mref; }
                }
            }
            bf16x8 pf[4]; float ls = 0.f;
#define ATT_HALF(PX, T0) do { \
                _Pragma("unroll") for (int i = 0; i < 16; ++i) { PX[i] = __builtin_amdgcn_exp2f(MODE == 0 ? PX[i] - mref : PX[i]); ls += PX[i]; } \
                _Pragma("unroll") for (int t2 = 0; t2 < 2; ++t2) { v4u w_; w_.x = cvtpk(PX[8 * t2 + 0], PX[8 * t2 + 1]); w_.y = cvtpk(PX[8 * t2 + 2], PX[8 * t2 + 3]); w_.z = cvtpk(PX[8 * t2 + 4], PX[8 * t2 + 5]); w_.w = cvtpk(PX[8 * t2 + 6], PX[8 * t2 + 7]); \
                    pf[(T0) + t2] = __builtin_bit_cast(bf16x8, w_); } } while (0)
#define ATT_PV(LO, HI, KS0) do { _Pragma("unroll") for (int d = 0; d < NDB; ++d) _Pragma("unroll") for (int k2 = 0; k2 < 2; ++k2) { \
                const bf16x8 vf_ = (bf16x8){LO[d][k2][0], LO[d][k2][1], LO[d][k2][2], LO[d][k2][3], HI[d][k2][0], HI[d][k2][1], HI[d][k2][2], HI[d][k2][3]}; \
                o[d] = __builtin_amdgcn_mfma_f32_32x32x16_bf16(vf_, pf[(KS0) + k2], o[d], 0, 0, 0); } } while (0)
            ATT_HALF(p0, 0);
            ATT_PV(vloA, vhiA, 0);
            if (NDB == 4) { __builtin_amdgcn_sched_barrier(0); ATT_VREAD(vloB, vhiB, 2); __builtin_amdgcn_sched_barrier(0); }
            ATT_HALF(p1, 2);
            ATT_PV(vloB, vhiB, 2);
#undef ATT_VREAD
#undef ATT_HALF
#undef ATT_PV
            l_run += ls;
            if (__any(ls > 1.0e30f)) {
                const float f = 7.888609052210118e-31f;
                l_run *= f; mref += 100.0f;
#pragma unroll
                for (int d = 0; d < NDB; ++d)
#pragma unroll
                    for (int i = 0; i < 16; ++i) o[d][i] *= f;
                if (MODE != 0) {
#pragma unroll
                    for (int i = 0; i < 16; ++i) cini[i] -= 100.0f;
                }
            }
            if (MODE != 2 && u2 == 1) { const float wmin = wave_red32<false>(mref + __builtin_amdgcn_logf(halfsum(l_run))); if (lane == 0) scf[((tp & 1) ? 32 : 0) + wave] = wmin; }
        }
        if (MODE == 1) {
#pragma unroll
            for (int i = 0; i < 16; ++i) cini[i] -= 64.0f * slope2;
        }
      }
        ATT_WAIT_0();
        __syncthreads();
    }
#undef ATT_DMA
#undef ATT_WAIT_1
#undef ATT_WAIT_0
    int nxt = 0; if (tid == 0) nxt = (int)atomicAdd(qctr, 1u);
    LAS int* word = (LAS int*)(lds + SC_OFF + 96);
    const float linv = 1.0f / halfsum(l_run);
    if (MODE != 1) {
        bf16* orow = Op + (rb + qrow + r) * DM + 4 * h;
#pragma unroll
        for (int d = 0; d < NDB; ++d)
#pragma unroll
            for (int g = 0; g < 4; ++g) { v2u w; w.x = cvtpk(o[d][4 * g] * linv, o[d][4 * g + 1] * linv); w.y = cvtpk(o[d][4 * g + 2] * linv, o[d][4 * g + 3] * linv); *(v2u*)(orow + 32 * d + 8 * g) = w; }
        if (tid == 0) *word = nxt;
        asm volatile("s_waitcnt vmcnt(0)" ::: "memory"); __syncthreads();
    } else {
        LAS float* ex = (LAS float*)lds;
        asm volatile("s_waitcnt vmcnt(0)" ::: "memory"); __syncthreads();
        if (map == 1) {
#pragma unroll
            for (int d = 0; d < NDB; ++d)
#pragma unroll
                for (int i = 0; i < 16; ++i) ex[((wq * 4 + d) * 16 + i) * 64 + lane] = o[d][i] * linv;
        }
        __syncthreads();
        if (map == 0) {
            const float* pp = (const float*)(P.ws + WS_SM + SM_PARAMS) + P.l * 384;
            float s1 = pp[lane] * pp[64 + lane], s2 = pp[128 + lane] * pp[192 + lane];
            s1 = wave_sum(s1); s2 = wave_sum(s2);
            const float lam = __expf(s1) - __expf(s2) + P.lam_init;
            float ss = 0.f;
#pragma unroll
            for (int d = 0; d < NDB; ++d)
#pragma unroll
                for (int i = 0; i < 16; ++i) { o[d][i] = o[d][i] * linv - lam * ex[((wq * 4 + d) * 16 + i) * 64 + lane]; ss += o[d][i] * o[d][i]; }
            ss = halfsum(ss);
            const float rn = __builtin_amdgcn_rsqf(ss * (1.0f / 128.0f) + EPS) * (1.0f - P.lam_init);
            bf16* orow = Op + (rb + qrow + r) * DM + 4 * h;
#pragma unroll
            for (int d = 0; d < NDB; ++d)
#pragma unroll
                for (int g = 0; g < 4; ++g) { const f32x4 gg = *(const f32x4*)(pp + 256 + 32 * d + 8 * g + 4 * h);
                    v2u w; w.x = cvtpk(o[d][4 * g] * rn * gg[0], o[d][4 * g + 1] * rn * gg[1]); w.y = cvtpk(o[d][4 * g + 2] * rn * gg[2], o[d][4 * g + 3] * rn * gg[3]); *(v2u*)(orow + 32 * d + 8 * g) = w; }
        }
        if (tid == 0) *word = nxt;
        asm volatile("s_waitcnt vmcnt(0)" ::: "memory"); __syncthreads();
    }
}

template <int PRB = 0>
__device__ __forceinline__ void attn_phase(const Params& P, LAS unsigned char* lds, const int* list, const int ctr_off = 0, const int cv_lo = 0, const int cv_hi = 0) {
    LAS int* word = (LAS int*)(lds + SC_OFF + 96); LAS int* ll = (LAS int*)(lds + SC_OFF + 2048);
    unsigned* qctr = (unsigned*)(P.ws + WS_CTL) + 64 + 64 * P.l + ctr_off;
    { int t_ = threadIdx.x; asm volatile("" : "+v"(t_)); ll[t_] = list[t_]; ll[t_ + 512] = list[t_ + 512]; if (t_ == 0) *word = (int)atomicAdd(qctr, 1u); }
    asm volatile("s_waitcnt vmcnt(0)" ::: "memory"); __syncthreads();
    for (;;) {
        const int idx = __builtin_amdgcn_readfirstlane(*word);
        if (idx >= N_ITEMS) {
            const int c0 = cv_lo + (idx - N_ITEMS) * 16;
            if (c0 >= cv_hi) break;
            int t_ = threadIdx.x; asm volatile("" : "+v"(t_)); const int wv_ = __builtin_amdgcn_readfirstlane(t_ >> 6);
            int nxt = 0; if (t_ == 0) nxt = (int)atomicAdd(qctr, 1u);
            wprep_range((const __attribute__((address_space(4))) Args*)__builtin_amdgcn_kernarg_segment_ptr(), lds, c0, c0 + 16 < cv_hi ? c0 + 16 : cv_hi, wv_, NWAVES, t_ & 63, wv_);
            __syncthreads();
            if (t_ == 0) *word = nxt;
            asm volatile("s_waitcnt vmcnt(0)" ::: "memory"); __syncthreads();
            continue;
        }
        const int code = __builtin_amdgcn_readfirstlane(ll[idx]), type = code & 3, rem = code >> 2;
        if (type == 0) attn_unit<0, PRB>(P, lds, (rem / 32) >> 2, (rem / 32) & 3, rem % 32, qctr);
        else if (type == 1) attn_unit<1, PRB>(P, lds, (rem / 64) >> 2, (rem / 64) & 3, rem % 64, qctr);
        else attn_unit<2, PRB>(P, lds, (rem / 32) >> 2, (rem / 32) & 3, rem % 32, qctr);
    }
}
}
#define XB_TMO      128
#define XB_XCNT(j)  (256  + 64 * (j))
#define XB_XSUB(j)  (1280 + 64 * (j))
#define XB_XGEN(j)  (2304 + 64 * (j))
#define XB_TOP      3328
#define XB_TOPGEN   3392
#define XCD_BAR_WORDS 3456
#define XB_SPIN_CAP (1u << 18)

__device__ __forceinline__ unsigned xb_ld(unsigned* p)              { return __hip_atomic_load(p, __ATOMIC_RELAXED, __HIP_MEMORY_SCOPE_AGENT); }
__device__ __forceinline__ unsigned xb_add(unsigned* p, unsigned v) { return __hip_atomic_fetch_add(p, v, __ATOMIC_RELAXED, __HIP_MEMORY_SCOPE_AGENT); }
__device__ __forceinline__ unsigned xb_xcc_id() { return (unsigned)__builtin_amdgcn_s_getreg((3 << 11) | 20) & 0xFu; }
#define XB_SPIN(cond, bar) do { unsigned _sp = 0; while (cond) { __builtin_amdgcn_s_sleep(1); \
    if ((++_sp & 255u) == 0u) { if (xb_ld(&(bar)[XB_TMO])) break; if (_sp > XB_SPIN_CAP) { atomicAdd(&(bar)[XB_TMO], 1u); break; } } } } while (0)

struct XcdBarrier {
    unsigned* bar; unsigned x;
    volatile LAS unsigned* st;
};

__device__ __forceinline__ XcdBarrier xcd_barrier_post(unsigned* bar, volatile LAS unsigned* st) {
    XcdBarrier b; b.bar = bar; b.x = xb_xcc_id(); b.st = st;
    if (threadIdx.x == 0) (void)xb_add(&bar[XB_XCNT(b.x)], 1u);
    return b;
}
__device__ __forceinline__ void xcd_barrier_complete(unsigned* bar, unsigned x, unsigned& nloc, unsigned& nx) {
    const unsigned G = gridDim.x * gridDim.y * gridDim.z;
    unsigned sum, cnt, mine, sp = 0u;
    for (;;) {
        sum = 0u; cnt = 0u; mine = 0u;
#pragma unroll
        for (unsigned j = 0; j < 16; ++j) { const unsigned c = xb_ld(&bar[XB_XCNT(j)]); sum += c; cnt += (c > 0u) ? 1u : 0u; mine = (j == x) ? c : mine; }
        if (sum == G) break;
        __builtin_amdgcn_s_sleep(1);
        if ((++sp & 255u) == 0u) { if (xb_ld(&bar[XB_TMO])) break; if (sp > XB_SPIN_CAP) { atomicAdd(&bar[XB_TMO], 1u); break; } }
    }
    nloc = mine > 0u ? mine : 1u; nx = cnt > 0u ? cnt : 1u;
}

__device__ __forceinline__ void xcd_barrier(const XcdBarrier& b) {
    asm volatile("s_waitcnt vmcnt(0)" ::: "memory");
    __syncthreads();
    if (threadIdx.x == 0) {
        unsigned* bar = b.bar;
        __builtin_amdgcn_s_waitcnt(0);
        unsigned nloc = b.st[0], nx = b.st[1];
        if (nloc == 0u) { xcd_barrier_complete(bar, b.x, nloc, nx); b.st[0] = nloc; b.st[1] = nx; }
        const unsigned old = xb_add(&bar[XB_XSUB(b.x)], 1u);
        const unsigned gen = old / nloc;
        if (old + 1u == (gen + 1u) * nloc) {
            __builtin_amdgcn_fence(__ATOMIC_RELEASE, "agent");
            asm volatile("s_waitcnt vmcnt(0)" ::: "memory");
            const unsigned og = xb_add(&bar[XB_TOP], 1u);
            const unsigned tg = og / nx;
            if (og + 1u == (tg + 1u) * nx) xb_add(&bar[XB_TOPGEN], 1u);
            else XB_SPIN(xb_ld(&bar[XB_TOPGEN]) == tg, bar);
            __builtin_amdgcn_fence(__ATOMIC_ACQUIRE, "agent");
            xb_add(&bar[XB_XGEN(b.x)], 1u);
            asm volatile("s_waitcnt vmcnt(0)" ::: "memory");
        } else {
            XB_SPIN(xb_ld(&bar[XB_XGEN(b.x)]) == gen, bar);
            __builtin_amdgcn_fence(__ATOMIC_ACQUIRE, "agent");
            asm volatile("s_waitcnt vmcnt(0)" ::: "memory");
        }
    }
    __syncthreads();
}

constexpr int CW_BAR = 4096;
constexpr int MISC_OFF = LDS_BYTES - 512;
constexpr size_t WS_ITEMS = 235 * MiB;
constexpr size_t WS_END2 = 236 * MiB;
constexpr int PH_H = 0, PH_M = 1, PH_A = 2, PH_O = 3, PH_U = 4, PH_D = 5, PH_FINAL = 13, NPHASES = 14;

static __device__ const float ROPE_INV[16] = {1.0f, 0.5623413324356079f, 0.3162277638912201f, 0.17782793939113617f, 0.10000000149011612f, 0.05623413249850273f, 0.03162277489900589f, 0.017782794311642647f,
    0.009999999776482582f, 0.005623413249850273f, 0.003162277629598975f, 0.0017782794311642647f, 0.0010000000474974513f, 0.000562341301701963f, 0.0003162277571391314f, 0.00017782794020604342f};
__device__ __forceinline__ void rope_cs(int t, int j, float& c, float& s) {
    const float ang = (float)t * ROPE_INV[j];
    c = (float)cos((double)ang); s = (float)sin((double)ang);
}
__device__ __forceinline__ void rope_table(float2* tab, int gtid, int ngt) {
    for (int i = gtid; i < SEQ * 16; i += ngt) { float c, s; rope_cs(i >> 4, i & 15, c, s); tab[i] = make_float2(c, s); }
}
__device__ __forceinline__ void cum_scan(const float* logf, float* cum, int b, int h, LAS double* part, int tid) {
    double loc[16]; double s = 0.0;
#pragma unroll
    for (int i = 0; i < 16; ++i) { s += (double)logf[(size_t)(b * SEQ + tid * 16 + i) * 4 + h]; loc[i] = s; }
    const int lane = tid & 63, wave = tid >> 6;
    double sc = s;
#pragma unroll
    for (int o = 1; o < 64; o <<= 1) { const double t = __shfl_up(sc, o); if (lane >= o) sc += t; }
    if (lane == 63) part[wave] = sc;
    __syncthreads();
    double pre = sc - s;
    for (int w = 0; w < wave; ++w) pre += part[w];
#pragma unroll
    for (int i = 0; i < 16; ++i) cum[(size_t)(b * SEQ + tid * 16 + i) * 4 + h] = (float)((pre + loc[i]) * -1.4426950408889634);
    __syncthreads();
}

#define CAS __attribute__((address_space(4)))
__global__ void __launch_bounds__(NTHREADS, 2) fwd(Args args) {
    extern __shared__ __attribute__((aligned(16))) unsigned char lds_raw[];
    LAS unsigned char* lds = (LAS unsigned char*)lds_raw;
    { volatile LAS unsigned* misc = (volatile LAS unsigned*)(lds + MISC_OFF); if (threadIdx.x < 32) misc[threadIdx.x] = 0u; __syncthreads(); }
    XcdBarrier bar; { CAS const Args* apb = (CAS const Args*)__builtin_amdgcn_kernarg_segment_ptr(); bar = xcd_barrier_post((unsigned*)(apb->ws + WS_CTL) + CW_BAR, (volatile LAS unsigned*)(lds + MISC_OFF) + 8); }
    int lo, hi; { CAS const Args* ap0 = (CAS const Args*)__builtin_amdgcn_kernarg_segment_ptr(); lo = ap0->ph_lo; hi = ap0->ph_hi; }
#define IN(k) (lo <= (k) && (k) < hi)
#ifdef PROBE_STAMP
#define STAMP(k) do { if (blockIdx.x == 0 && threadIdx.x == 0) { CAS const Args* aps = (CAS const Args*)__builtin_amdgcn_kernarg_segment_ptr(); ((unsigned long long*)(aps->ws + WS_CTL + 512 * 1024))[k] = __builtin_amdgcn_s_memrealtime(); } } while (0)
#else
#define STAMP(k) do {} while (0)
#endif
#ifdef PROBE_SLEEP
#ifndef PROBE_MUL
#define PROBE_MUL 1
#endif
#define PSLEEP(k) do { if (threadIdx.x == 0) { volatile LAS unsigned long long* ts_ = (volatile LAS unsigned long long*)(lds + MISC_OFF + 256); unsigned long long t1_ = __builtin_amdgcn_s_memrealtime(); \
        if ((k) == PROBE_SLEEP) { const unsigned long long t0_ = *ts_; while (__builtin_amdgcn_s_memrealtime() < t1_ + PROBE_MUL * (t1_ - t0_)) __builtin_amdgcn_s_sleep(8); t1_ = __builtin_amdgcn_s_memrealtime(); } *ts_ = t1_; } \
        if ((k) == PROBE_SLEEP) __syncthreads(); } while (0)
#else
#define PSLEEP(k) do {} while (0)
#endif
#define SEAM(k) do { if (IN(k) && IN((k) + 1)) xcd_barrier(bar); PSLEEP(k); STAMP((k) + 1); } while (0)
#define FRAME() \
    int tid = threadIdx.x; asm volatile("" : "+v"(tid)); \
    CAS const Args* ap = (CAS const Args*)__builtin_amdgcn_kernarg_segment_ptr(); asm volatile("" : "+s"(ap)); unsigned char* ws = ap->ws; \
    const int lane = tid & 63, wave = __builtin_amdgcn_readfirstlane(tid >> 6); \
    int G_ = gridDim.x, bx_ = blockIdx.x; asm volatile("" : "+s"(G_), "+s"(bx_)); const int G = __builtin_amdgcn_readfirstlane(G_), bx = __builtin_amdgcn_readfirstlane(bx_); \
    const int vcu = (G % 8 == 0) ? (bx % 8) * (G / 8) + bx / 8 : bx; \
    const int gw = vcu * NWAVES + wave, ngw = G * NWAVES; \
    float* sm = (float*)(ws + WS_SM); (void)lane; (void)gw; (void)ngw; (void)sm;
    STAMP(0);
#ifdef PROBE_SLEEP
    if (threadIdx.x == 0) *(volatile LAS unsigned long long*)(lds + MISC_OFF + 256) = __builtin_amdgcn_s_memrealtime();
#endif
    if (IN(0)) { FRAME(); p0_prologue(ap, lds, gw, ngw, lane, wave, G == 256); rope_table((float2*)(ws + WS_ROPE), gw * 64 + lane, ngw * 64); att::build_items((int*)(ws + WS_ITEMS), (LAS int*)lds, bx, tid, G); }
    SEAM(0);
    for (int l = 0; l < DEPTH; ++l) {
        const int pb = 1 + 6 * l;
        if (IN(pb + PH_H)) {
            FRAME();
            unsigned char* wl = ws + WS_W + (size_t)l * WS_WL;
            { pg8::Gemm g{(const bf16*)(ws + WS_XB), (const bf16*)(wl + W_IN), MTOK, HN, DM, DM}; pg8::HOrder S; S.init_h(G, bx);
              pg8::EpiH E{ws, ap->in[I_FB] + l * 4, l};
              pg8::gemm_phase<pg8::EpiH, pg8::HOrder, true, true>(lds, g, S, E); }
        }
        if (IN(pb + PH_H)) {
            const int c0 = 704 % 256;
            { FRAME(); unsigned char* wl = ws + WS_W + (size_t)l * WS_WL; const unsigned* ready = (const unsigned*)(ws + WS_CTL) + CW_READY + l * 64 * 64;
              pg8::Gemm g{(const bf16*)(ws + WS_HB) + H_CQ, (const bf16*)(wl + W_UQ), MTOK, 512, 256, HN}; pg8::MOrder S; S.init(G, bx, 0, ready, 16u);
              pg8::EpiQ E{(bf16*)(ws + WS_QM), sm + SM_SSQ / 4 + l * MTOK, (const float2*)(ws + WS_ROPE)}; pg8::gemm_phase<pg8::EpiQ, pg8::MOrder, true, true>(lds, g, S, E); }
            { FRAME(); unsigned char* wl = ws + WS_W + (size_t)l * WS_WL; const unsigned* ready = (const unsigned*)(ws + WS_CTL) + CW_READY + l * 64 * 64;
              pg8::Gemm g{(const bf16*)(ws + WS_HB) + H_CKV, (const bf16*)(wl + W_UKV), MTOK, 512, 128, HN}; pg8::MOrder S; S.init(G, bx, 128, ready, 16u);
              pg8::EpiKV E{(bf16*)(ws + WS_KVM), sm + SM_SSKV / 4 + l * MTOK}; pg8::gemm_phase<pg8::EpiKV, pg8::MOrder, true, true>(lds, g, S, E); }
            { FRAME();
              if (bx >= c0 && bx < c0 + 8) { const int sb = (bx - c0) >> 2, sh = (bx - c0) & 3; const unsigned* ready = (const unsigned*)(ws + WS_CTL) + CW_READY + l * 64 * 64;
                if (tid < 64) { unsigned polls = 0;
                    for (int p = 32 * sb; p < 32 * sb + 32; ++p) while ((unsigned)__builtin_amdgcn_readfirstlane(__hip_atomic_load(ready + 64 * p, __ATOMIC_RELAXED, __HIP_MEMORY_SCOPE_AGENT)) < 16u && ++polls < (1u << 22)) __builtin_amdgcn_s_sleep(2);
                    __builtin_amdgcn_fence(__ATOMIC_ACQUIRE, "agent"); asm volatile("s_waitcnt vmcnt(0)" ::: "memory"); }
                __syncthreads();
                cum_scan(sm + SM_LOGF / 4, sm + SM_CUM / 4, sb, sh, (LAS double*)lds, tid); } }
        }
        SEAM(pb + PH_H);
        if (IN(pb + PH_A)) {
            FRAME();
            const float lam_init = l == 0 ? 0.2f : 0.35550906759096934f;
            att::Params P{ws, l, lam_init};
            att::attn_phase(P, lds, (const int*)(ws + WS_ITEMS), 0, G == 256 ? (l == 0 ? WI_P0 : WI_B) : 0, G == 256 ? (l == 0 ? WI_B : 2 * WI_L) : 0);
#ifdef PROBE_PHASE
            if (l == 0) { xcd_barrier(bar); att::attn_phase<1>(P, lds, (const int*)(ws + WS_ITEMS), 32); }
#endif
        }
        SEAM(pb + PH_A);
        if (IN(pb + PH_O)) {
            FRAME(); unsigned char* wl = ws + WS_W + (size_t)l * WS_WL;
            pg8::Gemm g{(const bf16*)(ws + WS_AO), (const bf16*)(wl + W_O), MTOK, DM, DM, DM}; pg8::StaticOrder S; S.init(MTOK, DM, G, bx);
            pg8::EpiRes E{l == 0 ? ap->in[I_X] : ap->out, ap->out, (bf16*)(ws + WS_XB), sm + SM_SS2 / 4 + l * MTOK};
            pg8::gemm_phase<pg8::EpiRes, pg8::StaticOrder, true, true>(lds, g, S, E);
        }
        SEAM(pb + PH_O);
        if (IN(pb + PH_U)) {
            FRAME(); unsigned char* wl = ws + WS_W + (size_t)l * WS_WL;
            pg8::Gemm g{(const bf16*)(ws + WS_XB), (const bf16*)(wl + W_UP), MTOK, NUP, DM, DM}; pg8::UpOrder S; S.init_up(G, bx);
            pg8::EpiUp E{ws, ap->in[I_CW] + (size_t)l * 3 * NUP, ap->in[I_CB] + (size_t)l * NUP, l};
            pg8::gemm_phase<pg8::EpiUp, pg8::UpOrder, true, true>(lds, g, S, E);
        }
        SEAM(pb + PH_U);
        if (IN(pb + PH_D)) {
            FRAME(); unsigned char* wl = ws + WS_W + (size_t)l * WS_WL;
            pg8::Gemm g{(const bf16*)(ws + WS_HB), (const bf16*)(wl + W_DN), MTOK, DM, DFF, DFF}; pg8::StaticOrder S; S.init(MTOK, DM, G, bx);
            if (l == DEPTH - 1 && G == 256) {
                pg8::EpiResFinal E{ap->out, ap->out, sm + SM_SS1N / 4 + l * MTOK, ap->in[I_FG], (unsigned*)(ws + WS_CTL) + 1024};
                pg8::gemm_phase<pg8::EpiResFinal, pg8::StaticOrder, false, true>(lds, g, S, E);
            } else {
                pg8::EpiRes E{ap->out, ap->out, (bf16*)(ws + WS_XB), sm + SM_SS1N / 4 + l * MTOK};
                pg8::gemm_phase<pg8::EpiRes, pg8::StaticOrder, true, true>(lds, g, S, E);
            }
        }
        if (!(l == DEPTH - 1 && gridDim.x == 256)) SEAM(pb + PH_D); else PSLEEP(pb + PH_D);
    }
    if (IN(PH_FINAL) && gridDim.x != 256) {
        FRAME();
        const float* ss = sm + SM_SS1N / 4 + (DEPTH - 1) * MTOK; const float4* gr = (const float4*)ap->in[I_FG] + lane;
        for (int row = 2 * gw; row < MTOK; row += 2 * ngw) {
            const float r0 = __builtin_amdgcn_rsqf(ss[row] * (1.0f / DM) + EPS), r1 = __builtin_amdgcn_rsqf(ss[row + 1] * (1.0f / DM) + EPS);
            float4* x0 = (float4*)(ap->out + (size_t)row * DM) + lane; float4* x1 = x0 + DM / 4;
            float4 a[4], b[4];
#pragma unroll
            for (int j = 0; j < 4; ++j) { a[j] = x0[64 * j]; b[j] = x1[64 * j]; }
#pragma unroll
            for (int j = 0; j < 4; ++j) { const float4 gg = gr[64 * j];
                a[j].x *= r0 * gg.x; a[j].y *= r0 * gg.y; a[j].z *= r0 * gg.z; a[j].w *= r0 * gg.w; b[j].x *= r1 * gg.x; b[j].y *= r1 * gg.y; b[j].z *= r1 * gg.z; b[j].w *= r1 * gg.w;
                x0[64 * j] = a[j]; x1[64 * j] = b[j]; }
        }
    }
#ifdef PROBE_STAMP
    if (IN(PH_FINAL)) { xcd_barrier(bar); STAMP(PH_FINAL + 1);
        FRAME(); if (bx == 0) { __syncthreads(); const unsigned long long* st = (const unsigned long long*)(ws + WS_CTL + 512 * 1024);
            const float da = (float)(st[PROBE_A + 1] - st[PROBE_A]) * 0.01f, db = (float)(st[PROBE_B + 1] - st[PROBE_B]) * 0.01f;
            if (tid == 0) ap->out[0] = da;
            for (int i = tid; i < 16384; i += NTHREADS) ap->out[1024 + i] = db; } }
#endif
#undef IN
#undef SEAM
#undef FRAME
}

#ifndef N_LAUNCHES
#define N_LAUNCHES 1
#endif
extern "C" void kernel_launch(void* const* d_in, const int* in_sizes, int n_in, void* d_out, int out_size, void* d_ws, size_t ws_size, hipStream_t stream) {
    static int grid = 0;
    if (!grid) {
        if (n_in != 20 || ws_size < WS_END2 || out_size != MTOK * DM) { fprintf(stderr, "kernel_launch: unexpected n_in %d / out_size %d / ws_size %zu\n", n_in, out_size, ws_size); grid = -1; return; }
        if (hipFuncSetAttribute((const void*)fwd, hipFuncAttributeMaxDynamicSharedMemorySize, LDS_BYTES) != hipSuccess) { fprintf(stderr, "hipFuncSetAttribute failed\n"); grid = -1; return; }
        int dev = 0, cus = 0, per_cu = 0;
        if (hipGetDevice(&dev) != hipSuccess || hipDeviceGetAttribute(&cus, hipDeviceAttributeMultiprocessorCount, dev) != hipSuccess) { grid = -1; return; }
        if (hipOccupancyMaxActiveBlocksPerMultiprocessor(&per_cu, (const void*)fwd, NTHREADS, LDS_BYTES) != hipSuccess || per_cu < 1) { fprintf(stderr, "occupancy query failed (%d)\n", per_cu); grid = -1; return; }
        grid = cus;
        if (grid != 256) fprintf(stderr, "kernel_launch: note: %d CUs\n", grid);
    }
    if (grid < 0) return;
    Args a{};
    for (int i = 0; i < 20; ++i) a.in[i] = (const float*)d_in[i];
    a.out = (float*)d_out; a.ws = (unsigned char*)d_ws;
    (void)hipMemsetAsync((unsigned char*)d_ws + WS_CTL, 0, 1 * MiB, stream);
    if (N_LAUNCHES == 1) {
        a.ph_lo = 0; a.ph_hi = NPHASES;
        hipLaunchKernelGGL(fwd, dim3(grid), dim3(NTHREADS), LDS_BYTES, stream, a);
#ifdef PROBE_UNIT
        { static int once = 0; if (!once) { (void)hipFuncSetAttribute((const void*)probe_k, hipFuncAttributeMaxDynamicSharedMemorySize, LDS_BYTES); once = 1; }
          hipLaunchKernelGGL(probe_k, dim3(8), dim3(NTHREADS), LDS_BYTES, stream, a); }
#endif
    } else {
        for (int p = 0; p < NPHASES; ++p) { a.ph_lo = p; a.ph_hi = p + 1; hipLaunchKernelGGL(fwd, dim3(grid), dim3(NTHREADS), LDS_BYTES, stream, a);
#ifdef DUP_P0
            if (p == 0 || p == PH_FINAL) { if (p == 0) hipLaunchKernelGGL(fwd, dim3(grid), dim3(NTHREADS), LDS_BYTES, stream, a); }
#endif
#ifdef DUP_PHASE
            if (p >= 1 && p < PH_FINAL && (p - 1) % 6 == DUP_PHASE) hipLaunchKernelGGL(fwd, dim3(grid), dim3(NTHREADS), LDS_BYTES, stream, a);
#endif
        }
    }
}
```

```cpp
#include <hip/hip_runtime.h>
#include <cstdio>
#include <cstdint>

constexpr int BATCH = 2, SEQ = 8192, DM = 1024, DEPTH = 2, MTOK = BATCH * SEQ;
constexpr int IN_COLS = 2724, DFF = 2816, NUP = 2 * DFF;
constexpr int HN = 2816;
constexpr int H_FQ = 0, H_FK = 256, H_FV = 512, H_DQ = 768, H_DK = 1280, H_DV = 1792, H_CQ = 2304, H_CKV = 2560, H_KR = 2688, H_FF = 2720;
constexpr float EPS = 1e-6f;
constexpr float LOG2E = 1.4426950408889634f;
constexpr float NEGV = -1e30f;

constexpr size_t MiB = 1u << 20;
constexpr size_t WS_CTL = 0;
constexpr size_t WS_W = 1 * MiB, WS_WL = 25 * MiB;
constexpr size_t W_IN = 0, W_UQ = 5632 * 1024, W_UKV = W_UQ + 256 * 1024, W_O = 6 * MiB, W_UP = 8 * MiB, W_DN = 19 * MiB;
constexpr size_t WS_XB = 51 * MiB;
constexpr size_t WS_SM = 83 * MiB;
constexpr size_t SM_RSTD1 = 0;
constexpr size_t SM_SSQ = 64 * 1024, SM_SSKV = 192 * 1024, SM_SS2 = 320 * 1024, SM_SS1N = 448 * 1024;
constexpr size_t SM_LOGF = 576 * 1024, SM_CUM = 832 * 1024;
constexpr size_t SM_ZERO_BEG = SM_SSQ, SM_ZERO_END = SM_LOGF;
constexpr size_t SM_PARAMS = 1092 * 1024;
constexpr size_t SM_KMAX = 1088 * 1024;
constexpr size_t WS_HB = 85 * MiB;
constexpr size_t WS_QM = 173 * MiB;
constexpr size_t WS_KVM = 185 * MiB;
constexpr size_t WS_KR = 201 * MiB;
constexpr size_t WS_AO = 202 * MiB;
constexpr size_t WS_END = 234 * MiB;
constexpr size_t WS_ROPE = 234 * MiB;
constexpr int CW_READYA = 16384;
constexpr int CW_READY = 8192;

#define LAS __attribute__((address_space(3)))
typedef unsigned short bf16;
typedef float f32x16 __attribute__((ext_vector_type(16)));
typedef unsigned v4u __attribute__((ext_vector_type(4)));
typedef unsigned v2u __attribute__((ext_vector_type(2)));
__device__ __forceinline__ unsigned f2bf(float f) { unsigned u = __builtin_bit_cast(unsigned, f); return (u + 0x7fffu + ((u >> 16) & 1u)) >> 16; }
__device__ __forceinline__ unsigned pk2(float lo, float hi) { return f2bf(lo) | (f2bf(hi) << 16); }
__device__ __forceinline__ float bf2f(unsigned b) { return __builtin_bit_cast(float, (b & 0xffffu) << 16); }
__device__ __forceinline__ float bflo(unsigned w) { return __builtin_bit_cast(float, w << 16); }
__device__ __forceinline__ float bfhi(unsigned w) { return __builtin_bit_cast(float, w & 0xffff0000u); }

namespace pg8 {
#define PG8_LAS __attribute__((address_space(3)))
typedef unsigned short bf16_t;
typedef short bf16x8 __attribute__((ext_vector_type(8)));
typedef float f32x4 __attribute__((ext_vector_type(4)));
typedef unsigned u32x4 __attribute__((ext_vector_type(4)));
constexpr int BM = 256, BK = 64, HALF = 128, HTB = HALF * BK * 2  , STAGE_BYTES = 8 * HTB, NXCD = 8, WGM = 4;

__host__ __device__ __forceinline__ int lds_byte(int r, int c) { const int st = (r >> 4) * 2 + (c >> 5), rr = r & 15, cc = c & 31, ob = rr * 64 + cc * 2; return st * 1024 + (ob ^ (((ob >> 9) & 1) << 5)); }
__host__ __device__ __forceinline__ void stage_rc(int b, int& R, int& C) { const int st = b / 1024, sb = b % 1024, swz = sb ^ (((sb >> 9) & 1) << 5); R = (st >> 1) * 16 + swz / 64; C = (st & 1) * 32 + (swz % 64) / 2; }
__host__ __device__ __forceinline__ int perm32(int rho) { const int n = rho >> 4, i = rho & 15; return 8 * (i >> 2) + 4 * n + (i & 3); }

struct Unit { int pm, pn; };
struct Gemm { const bf16_t* A; const bf16_t* Bt; int M, N, K, lda; };

struct StaticOrder {
    int nM, nN, nwg, G, c;
    __host__ __device__ void init(int M, int N, int G_, int c_) { nM = M / BM; nN = N / BM; nwg = nM * nN; G = G_; c = c_; }
    __host__ __device__ bool next(int i, Unit& u) const {
        const long L = (long)i * G + c; if (L >= nwg) return false;
        int wgid = (int)L; { const int q = nwg / NXCD, r = nwg % NXCD, xcd = wgid % NXCD, off = wgid / NXCD; wgid = (xcd < r ? xcd * (q + 1) : r * (q + 1) + (xcd - r) * q) + off; }
        const int nig = WGM * nN, gid = wgid / nig, fm = gid * WGM, gsz = (nM - fm) < WGM ? (nM - fm) : WGM;
        u.pm = fm + ((wgid % nig) % gsz); u.pn = (wgid % nig) / gsz; return true;
    }
    __device__ __forceinline__ int arow(const Unit& u) const { return u.pm * BM; }
    __device__ __forceinline__ int arperm(int R) const { return R; }
    __device__ __forceinline__ int ahalf() const { return HALF; }
    __device__ __forceinline__ void a_ready(const Unit&) const {}
    __device__ __forceinline__ void done(const Unit&) const {}
};

__device__ __forceinline__ unsigned cvt_pk_bf16(float lo, float hi) { unsigned r; asm volatile("v_cvt_pk_bf16_f32 %0, %1, %2" : "=v"(r) : "v"(lo), "v"(hi)); return r; }
typedef float f32x2 __attribute__((ext_vector_type(2)));
__device__ __forceinline__ void glds16_s(unsigned voff, const void* sbase, unsigned ldsdst) {
    unsigned keep; ldsdst = __builtin_amdgcn_readfirstlane(ldsdst);
    { const unsigned long long p_ = (unsigned long long)sbase; sbase = (const void*)(((unsigned long long)(unsigned)__builtin_amdgcn_readfirstlane((unsigned)(p_ >> 32)) << 32) | (unsigned)__builtin_amdgcn_readfirstlane((unsigned)p_)); }
    asm volatile("s_mov_b32 %0, m0\n\ts_mov_b32 m0, %3\n\ts_nop 2\n\tglobal_load_lds_dwordx4 %1, %2\n\ts_mov_b32 m0, %0" : "=&s"(keep) : "v"(voff), "s"(sbase), "s"(ldsdst) : "memory");
}
__device__ __forceinline__ void glds4_s(unsigned voff, const void* sbase, unsigned ldsdst) {
    unsigned keep; ldsdst = __builtin_amdgcn_readfirstlane(ldsdst);
    { const unsigned long long p_ = (unsigned long long)sbase; sbase = (const void*)(((unsigned long long)(unsigned)__builtin_amdgcn_readfirstlane((unsigned)(p_ >> 32)) << 32) | (unsigned)__builtin_amdgcn_readfirstlane((unsigned)p_)); }
    asm volatile("s_mov_b32 %0, m0\n\ts_mov_b32 m0, %3\n\ts_nop 2\n\tglobal_load_lds_dword %1, %2\n\ts_mov_b32 m0, %0" : "=&s"(keep) : "v"(voff), "s"(sbase), "s"(ldsdst) : "memory");
}
template <class Epi, class Sched, bool ALIGN_EPI = false, bool SP2 = false>
__device__ __forceinline__ void gemm_phase(PG8_LAS unsigned char* lds, const Gemm g, const Sched& S, const Epi& E) {
    int tid_l = threadIdx.x; asm volatile("" : "+v"(tid_l));
    const int tid = tid_l, wid = __builtin_amdgcn_readfirstlane(tid >> 6), lane = tid & 63, wr = wid >> 2, wc = wid & 3, fr = lane & 15, fq = lane >> 4;
    const int K = g.K, nt = K / BK;
    unsigned voffA[2], voffB[2];
#pragma unroll
    for (int i = 0; i < 2; ++i) { int R, C; stage_rc(tid * 16 + i * 8192, R, C); const int Rb = Epi::PERM ? ((R & ~31) + perm32(R & 31)) : R;
        voffA[i] = (unsigned)(S.arperm(R) * g.lda + C) * 2u; voffB[i] = (unsigned)(Rb * K + C) * 2u; }
    const unsigned kstep = (unsigned)(BK * 2);
    const unsigned hstep = (unsigned)HALF * K * 2; const unsigned hstepA = (unsigned)S.ahalf() * g.lda * 2;
    const unsigned tstep = 2 * hstep;
    const unsigned ldsw = (unsigned)wid * 1024u;
    const int aoff = lds_byte(wr * 64 + fr, fq * 8), boff = lds_byte(wc * 32 + fr, fq * 8);
#define PG8_SA(b, h) (((b) * 2 + (h)) * HTB)
#define PG8_SB(b, h) ((4 + (b) * 2 + (h)) * HTB)
#define PG8_STAGE(bufoff, gbase, voff) do { _Pragma("unroll") for (int _i = 0; _i < 2; ++_i) \
        glds16_s((voff)[_i], (const char*)(gbase), (unsigned)(uintptr_t)(lds + (bufoff) + ldsw + _i * 8192)); } while (0)
#define PG8_LDA(dst, b, h) do { _Pragma("unroll") for (int m = 0; m < 4; ++m) _Pragma("unroll") for (int k = 0; k < 2; ++k) dst[m][k] = *(const PG8_LAS bf16x8*)(lds + PG8_SA(b, h) + aoff + m * 2048 + k * 1024); } while (0)
#define PG8_LDB(dst, b, h) do { _Pragma("unroll") for (int n = 0; n < 2; ++n) _Pragma("unroll") for (int k = 0; k < 2; ++k) dst[n][k] = *(const PG8_LAS bf16x8*)(lds + PG8_SB(b, h) + boff + n * 2048 + k * 1024); } while (0)
#define PG8_MMA(ai, bj, At, Bt) do { __builtin_amdgcn_s_setprio(1); _Pragma("unroll") for (int m = 0; m < 4; ++m) _Pragma("unroll") for (int n = 0; n < 2; ++n) _Pragma("unroll") for (int k = 0; k < 2; ++k) \
        acc[ai][bj][m][n] = __builtin_amdgcn_mfma_f32_16x16x32_bf16(Bt[n][k], At[m][k], acc[ai][bj][m][n], 0, 0, 0); __builtin_amdgcn_s_setprio(0); } while (0)
#define PG8_WAIT_V(n) asm volatile("s_waitcnt vmcnt(" #n ")" ::: "memory")
#define PG8_WAIT_L(n) asm volatile("s_waitcnt lgkmcnt(" #n ")" ::: "memory")
#define PG8_BAR __builtin_amdgcn_s_barrier()
#define PG8_SCHED __builtin_amdgcn_sched_barrier(0)
    Unit cur, nxt; int ui = 0;
    if (!S.next(0, cur)) return;
    f32x4 acc[2][2][4][2];
#pragma unroll
    for (int a = 0; a < 2; ++a)
#pragma unroll
        for (int b = 0; b < 2; ++b)
#pragma unroll
            for (int m = 0; m < 4; ++m)
#pragma unroll
                for (int n = 0; n < 2; ++n) acc[a][b][m][n] = (f32x4){0.f, 0.f, 0.f, 0.f};
    bf16x8 At[4][2], B0[2][2], B1[2][2];
    const char* cA = (const char*)g.A + (size_t)S.arow(cur) * g.lda * 2; const char* cB = (const char*)g.Bt + (size_t)cur.pn * tstep;
    S.a_ready(cur);
    if constexpr (SP2) {
        PG8_STAGE(PG8_SB(0, 0), cB, voffB); PG8_STAGE(PG8_SB(0, 1), cB + hstep, voffB); PG8_STAGE(PG8_SA(0, 0), cA, voffA); PG8_STAGE(PG8_SA(0, 1), cA + hstepA, voffA);
        if (wr == 1) PG8_BAR;
        PG8_WAIT_V(2); PG8_BAR;
        PG8_STAGE(PG8_SB(1, 0), cB + kstep, voffB); PG8_STAGE(PG8_SA(1, 0), cA + kstep, voffA); PG8_STAGE(PG8_SB(1, 1), cB + hstep + kstep, voffB);
        PG8_WAIT_V(6); PG8_BAR;
    } else {
        PG8_STAGE(PG8_SB(0, 0), cB, voffB); PG8_STAGE(PG8_SA(0, 0), cA, voffA); PG8_STAGE(PG8_SB(0, 1), cB + hstep, voffB); PG8_STAGE(PG8_SA(0, 1), cA + hstepA, voffA);
        if (wr == 1) PG8_BAR;
        PG8_WAIT_V(4); PG8_BAR;
        PG8_STAGE(PG8_SB(1, 0), cB + kstep, voffB); PG8_STAGE(PG8_SA(1, 0), cA + kstep, voffA); PG8_STAGE(PG8_SB(1, 1), cB + hstep + kstep, voffB);
        PG8_WAIT_V(6); PG8_BAR;
    }
    for (;;) {
        const bool has_next = S.next(ui + 1, nxt);
        const char* nA = has_next ? (const char*)g.A + (size_t)S.arow(nxt) * g.lda * 2 : cA; const char* nB = has_next ? (const char*)g.Bt + (size_t)nxt.pn * tstep : cB;
        for (int t = 0; t < nt; t += 2) {
            const bool last = (t == nt - 2);
            const char* a1 = cA + (size_t)(t + 1) * kstep;
            const char* a2 = last ? nA : cA + (size_t)(t + 2) * kstep; const char* b2 = last ? nB : cB + (size_t)(t + 2) * kstep;
            const char* a3 = a2 + kstep; const char* b3 = b2 + kstep;
            if (last && has_next) S.a_ready(nxt);
            if constexpr (SP2) {
            PG8_LDB(B0, 0, 0); PG8_LDB(B1, 0, 1); PG8_SCHED; PG8_LDA(At, 0, 0); PG8_STAGE(PG8_SA(1, 1), a1 + hstepA, voffA);
            PG8_WAIT_V(8); PG8_WAIT_L(0); PG8_BAR; PG8_MMA(0, 0, At, B0); PG8_MMA(0, 1, At, B1); PG8_BAR; PG8_SCHED;
            PG8_LDA(At, 0, 1); PG8_STAGE(PG8_SB(0, 0), b2, voffB); PG8_STAGE(PG8_SB(0, 1), b2 + hstep, voffB); PG8_STAGE(PG8_SA(0, 0), a2, voffA);
            PG8_WAIT_V(8); PG8_WAIT_L(0); PG8_BAR; PG8_MMA(1, 0, At, B0); PG8_MMA(1, 1, At, B1); PG8_BAR; PG8_SCHED;
            PG8_LDB(B0, 1, 0); PG8_LDB(B1, 1, 1); PG8_SCHED; PG8_LDA(At, 1, 0); PG8_STAGE(PG8_SA(0, 1), a2 + hstepA, voffA);
            PG8_WAIT_V(8); PG8_WAIT_L(0); PG8_BAR; PG8_MMA(0, 0, At, B0); PG8_MMA(0, 1, At, B1); PG8_BAR; PG8_SCHED;
            PG8_LDA(At, 1, 1); PG8_STAGE(PG8_SB(1, 0), b3, voffB); PG8_STAGE(PG8_SB(1, 1), b3 + hstep, voffB); PG8_STAGE(PG8_SA(1, 0), a3, voffA);
            PG8_WAIT_V(8); PG8_WAIT_L(0); PG8_BAR; PG8_MMA(1, 0, At, B0); PG8_MMA(1, 1, At, B1); PG8_BAR; PG8_SCHED;
            } else {
            PG8_LDB(B0, 0, 0); PG8_SCHED; PG8_LDA(At, 0, 0); PG8_STAGE(PG8_SA(1, 1), a1 + hstepA, voffA);
            PG8_WAIT_L(8); PG8_BAR; PG8_WAIT_L(0); PG8_MMA(0, 0, At, B0); PG8_BAR; PG8_SCHED;
            PG8_LDB(B1, 0, 1); PG8_STAGE(PG8_SB(0, 0), b2, voffB);
            PG8_BAR; PG8_WAIT_L(0); PG8_MMA(0, 1, At, B1); PG8_BAR;
            PG8_LDA(At, 0, 1); PG8_STAGE(PG8_SA(0, 0), a2, voffA);
            PG8_BAR; PG8_WAIT_L(0); PG8_MMA(1, 0, At, B0); PG8_BAR; PG8_SCHED;
            PG8_STAGE(PG8_SB(0, 1), b2 + hstep, voffB);
            PG8_WAIT_V(6); PG8_BAR; PG8_MMA(1, 1, At, B1); PG8_BAR;
            PG8_LDB(B0, 1, 0); PG8_SCHED; PG8_LDA(At, 1, 0); PG8_STAGE(PG8_SA(0, 1), a2 + hstepA, voffA);
            PG8_WAIT_L(8); PG8_BAR; PG8_WAIT_L(0); PG8_MMA(0, 0, At, B0); PG8_BAR; PG8_SCHED;
            PG8_LDB(B1, 1, 1); PG8_STAGE(PG8_SB(1, 0), b3, voffB);
            PG8_BAR; PG8_WAIT_L(0); PG8_MMA(0, 1, At, B1); PG8_BAR;
            PG8_LDA(At, 1, 1); PG8_STAGE(PG8_SA(1, 0), a3, voffA);
            PG8_BAR; PG8_WAIT_L(0); PG8_MMA(1, 0, At, B0); PG8_BAR; PG8_SCHED;
            PG8_STAGE(PG8_SB(1, 1), b3 + hstep, voffB);
            PG8_WAIT_V(6); PG8_BAR; PG8_MMA(1, 1, At, B1); PG8_BAR;
            }
        }
        if constexpr (ALIGN_EPI) { if (wr == 0) PG8_BAR; }
        if constexpr (!Epi::AFTER_DRAIN) { E(acc, cur, wr, wc, fr, fq); S.done(cur); }
        if (!has_next) break;
#pragma unroll
        for (int a = 0; a < 2; ++a)
#pragma unroll
            for (int b = 0; b < 2; ++b)
#pragma unroll
                for (int m = 0; m < 4; ++m)
#pragma unroll
                    for (int n = 0; n < 2; ++n) acc[a][b][m][n] = (f32x4){0.f, 0.f, 0.f, 0.f};
        cur = nxt; cA = nA; cB = nB; ++ui;
        if constexpr (ALIGN_EPI) { if (wr == 1) PG8_BAR; }
    }
    PG8_WAIT_V(0);
    if constexpr (!ALIGN_EPI) { if (wr == 0) PG8_BAR; }
    PG8_BAR;
    if constexpr (Epi::AFTER_DRAIN) { E.fused(acc, cur, wr, wc, fr, fq, lds, wid, lane); S.done(cur); }
#undef PG8_SA
#undef PG8_SB
#undef PG8_STAGE
#undef PG8_LDA
#undef PG8_LDB
#undef PG8_MMA
#undef PG8_WAIT_V
#undef PG8_WAIT_L
#undef PG8_BAR
#undef PG8_SCHED
}
}
constexpr int NWAVES = 8, NTHREADS = 512;
constexpr int RING_BYTES = 131072, LDS_BYTES = 163840;
struct Args { const float* in[20]; float* out; unsigned char* ws; int ph_lo, ph_hi, layer, pad; };
enum { I_X = 0, I_LN1G, I_WIN, I_FB, I_LQ1, I_LK1, I_LQ2, I_LK2, I_DNG, I_QNG, I_WUQ, I_KVNG, I_WUKV, I_WO, I_LN2G, I_WUP, I_CW, I_CB, I_WDN, I_FG };

__device__ __forceinline__ float wave_sum(float v) {
#pragma unroll
    for (int o = 1; o < 64; o <<= 1) v += __shfl_xor(v, o);
    return v;
}
struct MapIn {
    static constexpr bool VEC = true;
    __device__ __forceinline__ int src(int n) const { return n < 768 ? n : (n < 2720 ? n + 4 : (n < 2724 ? n - 2720 + 768 : -1)); }
    __device__ __forceinline__ float scale(int n) const { return (n < 256 || (n >= H_DQ && n < H_DK)) ? 0.125f * LOG2E : 1.0f; }
};
struct MapUq {
    static constexpr bool VEC = false;
    __device__ __forceinline__ int src(int n) const { if (n >= 384) return -1; const int h = n / 96, d = n % 96; if (d < 64) return n; const int jj = d - 64; return h * 96 + 64 + (jj >> 1) + 16 * (jj & 1); }
    __device__ __forceinline__ float scale(int) const { return 0.10206207261596577f * LOG2E; }
};
struct MapId {
    static constexpr bool VEC = true;
    __device__ __forceinline__ int src(int n) const { return n; }
    __device__ __forceinline__ float scale(int) const { return 1.0f; }
};
struct MapUp {
    static constexpr bool VEC = true;
    __device__ __forceinline__ int src(int n) const { return ((n >> 7) & 1) * DFF + 128 * (n >> 8) + (n & 127); }
    __device__ __forceinline__ float scale(int) const { return 1.0f; }
};
template <class Map>
__device__ __forceinline__ void wprep_item(const float* W, int ldw, int K, bf16* WT, int nblk, LAS float* scr, int item, int lane, const float* gk, const Map map) {
    const int kb = item / nblk, nb = item % nblk, k0 = 64 * kb, n0 = 32 * nb;
    if constexpr (Map::VEC) {
        typedef float f4w_ __attribute__((ext_vector_type(4)));
        const int q4 = 4 * (lane & 7), nd = n0 + q4, sc = map.src(nd); const float cs = map.scale(nd);
        f4w_ wv[8];
#pragma unroll
        for (int i = 0; i < 8; ++i) { const int kk = (lane >> 3) + 8 * i; wv[i] = (sc >= 0) ? __builtin_nontemporal_load((const f4w_*)(W + (size_t)(k0 + kk) * ldw + sc)) : (f4w_){0.f, 0.f, 0.f, 0.f}; }
#pragma unroll
        for (int i = 0; i < 8; ++i) { const int kk = (lane >> 3) + 8 * i; float g_ = cs; if (gk) g_ *= gk[k0 + kk];
#pragma unroll
            for (int e = 0; e < 4; ++e) scr[kk * 33 + q4 + e] = wv[i][e] * g_; }
    } else {
    const int nd = n0 + (lane & 31), sc = map.src(nd); const float cs = map.scale(nd);
    float wv[32];
#pragma unroll
    for (int i = 0; i < 32; ++i) { const int kk = 2 * i + (lane >> 5); wv[i] = (sc >= 0) ? __builtin_nontemporal_load(W + (size_t)(k0 + kk) * ldw + sc) : 0.f; }
#pragma unroll
    for (int i = 0; i < 32; ++i) { const int kk = 2 * i + (lane >> 5); float v = wv[i]; if (gk) v *= gk[k0 + kk]; scr[kk * 33 + (lane & 31)] = v * cs; }
    }
    asm volatile("s_waitcnt lgkmcnt(0)" ::: "memory");
    const int c = lane & 7;
#pragma unroll
    for (int j = 0; j < 4; ++j) { const int n = (lane >> 3) + 8 * j; const LAS float* s = scr + (8 * c) * 33 + n;
        v4u o; o.x = pk2(s[0 * 33], s[1 * 33]); o.y = pk2(s[2 * 33], s[3 * 33]); o.z = pk2(s[4 * 33], s[5 * 33]); o.w = pk2(s[6 * 33], s[7 * 33]);
        *(v4u*)(WT + (size_t)(n0 + n) * K + k0 + 8 * c) = o; }
    asm volatile("s_waitcnt lgkmcnt(0)" ::: "memory");
}
__device__ __forceinline__ void xprep_row(const float* xrow, bf16* orow, float* rstd, int lane) {
    const float4* xr = (const float4*)xrow + lane;
    float4 v[4]; float s = 0.f;
#pragma unroll
    for (int j = 0; j < 4; ++j) { v[j] = xr[64 * j]; s += (v[j].x * v[j].x + v[j].y * v[j].y) + (v[j].z * v[j].z + v[j].w * v[j].w); }
    s = wave_sum(s);
    if (lane == 0) *rstd = s;
    v2u* o8 = (v2u*)orow + lane;
#pragma unroll
    for (int j = 0; j < 4; ++j) { v2u w; w.x = pk2(v[j].x, v[j].y); w.y = pk2(v[j].z, v[j].w); o8[64 * j] = w; }
}
constexpr int WI_IN = 16 * 88, WI_UQ = 4 * 16, WI_UKV = 2 * 16, WI_O = 16 * 32, WI_UP = 16 * 176, WI_DN = 44 * 32, WI_L = WI_IN + WI_UQ + WI_UKV + WI_O + WI_UP + WI_DN;
constexpr int WI_P0 = WI_IN + WI_UQ + WI_UKV;
constexpr int WI_EARLY = WI_IN + WI_UQ + WI_UKV + WI_O;
constexpr int WI_A = WI_EARLY + WI_UP;
constexpr int WI_B = WI_L + WI_IN + WI_UQ + WI_UKV;
constexpr int WI_C = WI_B + WI_O + WI_UP;
__device__ __forceinline__ void wprep_range(const __attribute__((address_space(4))) Args* ap_, LAS unsigned char* lds, int it_lo, int it_hi, int wv, int nwv, int lane, int wave) {
    LAS float* scr = (LAS float*)(lds + wave * 16384);
    unsigned char* ws = ap_->ws;
    for (int it = it_lo + wv; it < it_hi; it += nwv) {
        const int l = it / WI_L; int r = it % WI_L;
        unsigned char* wl = ws + WS_W + (size_t)l * WS_WL;
        if (r < WI_IN) { wprep_item(ap_->in[I_WIN] + (size_t)l * DM * IN_COLS, IN_COLS, DM, (bf16*)(wl + W_IN), 88, scr, r, lane, ap_->in[I_LN1G] + l * DM, MapIn()); continue; } r -= WI_IN;
        if (r < WI_UQ) { wprep_item(ap_->in[I_WUQ] + (size_t)l * 256 * 384, 384, 256, (bf16*)(wl + W_UQ), 16, scr, r, lane, ap_->in[I_QNG] + l * 256, MapUq()); continue; } r -= WI_UQ;
        if (r < WI_UKV) { wprep_item(ap_->in[I_WUKV] + (size_t)l * 128 * 512, 512, 128, (bf16*)(wl + W_UKV), 16, scr, r, lane, ap_->in[I_KVNG] + l * 128, MapId()); continue; } r -= WI_UKV;
        if (r < WI_O) { wprep_item(ap_->in[I_WO] + (size_t)l * DM * DM, DM, DM, (bf16*)(wl + W_O), 32, scr, r, lane, (const float*)nullptr, MapId()); continue; } r -= WI_O;
        if (r < WI_UP) { wprep_item(ap_->in[I_WUP] + (size_t)l * DM * NUP, NUP, DM, (bf16*)(wl + W_UP), 176, scr, r, lane, ap_->in[I_LN2G] + l * DM, MapUp()); continue; } r -= WI_UP;
        wprep_item(ap_->in[I_WDN] + (size_t)l * DFF * DM, DM, DFF, (bf16*)(wl + W_DN), 32, scr, r, lane, (const float*)nullptr, MapId());
    }
}
__device__ __forceinline__ void p0_prologue(const __attribute__((address_space(4))) Args* ap_, LAS unsigned char* lds, int gw, int ngw, int lane, int wave, bool defer) {
    unsigned char* ws = ap_->ws;
    float* rstd1 = (float*)(ws + WS_SM + SM_RSTD1);
    typedef float f4_ __attribute__((ext_vector_type(4)));
    f4_ v[4][4]; int m = 4 * gw;
#define P0_XLOAD() do { if (m < MTOK) { const f4_* xr_ = (const f4_*)(ap_->in[I_X] + (size_t)m * DM) + 2 * lane; _Pragma("unroll") for (int r = 0; r < 4; ++r) _Pragma("unroll") for (int j = 0; j < 4; ++j) v[r][j] = __builtin_nontemporal_load(xr_ + r * (DM / 4) + 128 * (j >> 1) + (j & 1)); } } while (0)
#define P0_XSTORE() do { if (m < MTOK) { float s_[4]; \
        _Pragma("unroll") for (int r = 0; r < 4; ++r) { s_[r] = 0.f; _Pragma("unroll") for (int j = 0; j < 4; ++j) s_[r] += (v[r][j][0] * v[r][j][0] + v[r][j][1] * v[r][j][1]) + (v[r][j][2] * v[r][j][2] + v[r][j][3] * v[r][j][3]); s_[r] = wave_sum(s_[r]); } \
        if (lane == 0) { rstd1[m] = s_[0]; rstd1[m + 1] = s_[1]; rstd1[m + 2] = s_[2]; rstd1[m + 3] = s_[3]; } \
        v4u* o0_ = (v4u*)((bf16*)(ws + WS_XB) + (size_t)m * DM) + lane; \
        _Pragma("unroll") for (int r = 0; r < 4; ++r) _Pragma("unroll") for (int j2 = 0; j2 < 2; ++j2) { v4u w_; w_.x = pk2(v[r][2 * j2][0], v[r][2 * j2][1]); w_.y = pk2(v[r][2 * j2][2], v[r][2 * j2][3]); w_.z = pk2(v[r][2 * j2 + 1][0], v[r][2 * j2 + 1][1]); w_.w = pk2(v[r][2 * j2 + 1][2], v[r][2 * j2 + 1][3]); o0_[r * (DM / 8) + 64 * j2] = w_; } } } while (0)
    P0_XLOAD();
    wprep_range(ap_, lds, 0, defer ? WI_P0 : 2 * WI_L, gw, ngw, lane, wave);
    P0_XSTORE();
    for (m += 4 * ngw; m < MTOK; m += 4 * ngw) { P0_XLOAD(); P0_XSTORE(); }
#undef P0_XLOAD
#undef P0_XSTORE
    float* z = (float*)(ws + WS_SM + SM_ZERO_BEG); const int nz = (int)((SM_ZERO_END - SM_ZERO_BEG) / 4);
    for (int i = gw * 64 + lane; i < nz; i += ngw * 64) z[i] = 0.f;
    if (gw == 0) { ((float*)(ws + WS_SM + SM_KMAX))[lane] = 0.f; ((float*)(ws + WS_SM + SM_KMAX))[64 + lane] = 0.f; }
    if (gw == 1) { float* pp = (float*)(ws + WS_SM + SM_PARAMS);
        for (int l = 0; l < DEPTH; ++l) { pp[l * 384 + lane] = ap_->in[I_LQ1][l * 64 + lane]; pp[l * 384 + 64 + lane] = ap_->in[I_LK1][l * 64 + lane]; pp[l * 384 + 128 + lane] = ap_->in[I_LQ2][l * 64 + lane];
            pp[l * 384 + 192 + lane] = ap_->in[I_LK2][l * 64 + lane]; pp[l * 384 + 256 + lane] = ap_->in[I_DNG][l * 128 + lane]; pp[l * 384 + 320 + lane] = ap_->in[I_DNG][l * 128 + 64 + lane]; } }
}
namespace pg8 {
__device__ __forceinline__ u32x4 pack8(const f32x4 v0, const f32x4 v1) { u32x4 w; w.x = cvt_pk_bf16(v0[0], v0[1]); w.y = cvt_pk_bf16(v0[2], v0[3]); w.z = cvt_pk_bf16(v1[0], v1[1]); w.w = cvt_pk_bf16(v1[2], v1[3]); return w; }
__device__ __forceinline__ float sq8(const f32x4 a, const f32x4 b) { return (a[0] * a[0] + a[1] * a[1]) + (a[2] * a[2] + a[3] * a[3]) + (b[0] * b[0] + b[1] * b[1]) + (b[2] * b[2] + b[3] * b[3]); }
__device__ __forceinline__ float log_sigmoid_d(float z) { return fminf(z, 0.f) - 0.6931471805599453f * __builtin_amdgcn_logf(1.0f + __builtin_amdgcn_exp2f(-1.4426950408889634f * fabsf(z))); }
__device__ __forceinline__ void store16_sc1(void* p, const u32x4 v) { asm volatile("global_store_dwordx4 %0, %1, off sc1\n\ts_nop 1" :: "v"(p), "v"(v) : "memory"); }
struct EpiH {
    static constexpr bool PERM = true, AFTER_DRAIN = false;
    unsigned char* ws; const float* fb; int l;
    __device__ __forceinline__ void operator()(const f32x4 (&acc)[2][2][4][2], const Unit& u, int wr, int wc, int fr, int fq) const {
        { int t_ = threadIdx.x; asm volatile("" : "+v"(t_)); fr = t_ & 15; fq = (t_ >> 4) & 3; const int w_ = __builtin_amdgcn_readfirstlane(t_ >> 6); wr = w_ >> 2; wc = w_ & 3; }
        bf16_t* Hb = (bf16_t*)(ws + WS_HB); float* sm = (float*)(ws + WS_SM);
        const float* ssin = l == 0 ? sm + SM_RSTD1 / 4 : sm + SM_SS1N / 4 + (l - 1) * MTOK;
        float* logf = sm + SM_LOGF / 4; float* ssq = sm + SM_SSQ / 4 + l * MTOK; float* sskv = sm + SM_SSKV / 4 + l * MTOK;
        const bool isk = (u.pn == 1 || u.pn == 5 || u.pn == 6);
        float kmx0 = 0.f, kmx1 = 0.f;
        const int row0 = u.pm * BM + wr * 64 + fr, colw = wc * 32 + 8 * fq;
        float rsv[8];
#pragma unroll
        for (int g = 0; g < 8; ++g) rsv[g] = ssin[row0 + (g >> 2) * HALF + (g & 3) * 16];
#pragma unroll
        for (int ai = 0; ai < 2; ++ai)
#pragma unroll
            for (int m = 0; m < 4; ++m) {
                const int row = row0 + ai * HALF + m * 16; const float rs = __builtin_amdgcn_rsqf(rsv[ai * 4 + m] * (1.0f / DM) + EPS);
                float s = 0.f;
#pragma unroll
                for (int bj = 0; bj < 2; ++bj) {
                    const f32x4 v0 = acc[ai][bj][m][0] * rs, v1 = acc[ai][bj][m][1] * rs;
                    if (u.pn == 9 || (u.pn == 10 && bj == 0)) { store16_sc1(Hb + (size_t)row * HN + u.pn * BM + bj * HALF + colw, pack8(v0, v1)); s += sq8(v0, v1); }
                    else *(u32x4*)(Hb + (size_t)row * HN + u.pn * BM + bj * HALF + colw) = pack8(v0, v1);
                    if (u.pn == 10 && bj == 1 && wc == 0) {
                        f32x4 w0, w1;
#pragma unroll
                        for (int i = 0; i < 4; ++i) { w0[i] = __shfl_xor(v0[i], 32); w1[i] = __shfl_xor(v1[i], 32); }
                        if (fq < 2) { const float2* rt = (const float2*)(ws + WS_ROPE) + (size_t)(row & (SEQ - 1)) * 16 + 8 * fq; u32x4 ka, kb;
                            const float2 c0 = rt[0], c1 = rt[1], c2 = rt[2], c3 = rt[3], c4 = rt[4], c5 = rt[5], c6 = rt[6], c7 = rt[7];
                            ka.x = cvt_pk_bf16(v0[0] * c0.x - w0[0] * c0.y, v0[0] * c0.y + w0[0] * c0.x); ka.y = cvt_pk_bf16(v0[1] * c1.x - w0[1] * c1.y, v0[1] * c1.y + w0[1] * c1.x);
                            ka.z = cvt_pk_bf16(v0[2] * c2.x - w0[2] * c2.y, v0[2] * c2.y + w0[2] * c2.x); ka.w = cvt_pk_bf16(v0[3] * c3.x - w0[3] * c3.y, v0[3] * c3.y + w0[3] * c3.x);
                            kb.x = cvt_pk_bf16(v1[0] * c4.x - w1[0] * c4.y, v1[0] * c4.y + w1[0] * c4.x); kb.y = cvt_pk_bf16(v1[1] * c5.x - w1[1] * c5.y, v1[1] * c5.y + w1[1] * c5.x);
                            kb.z = cvt_pk_bf16(v1[2] * c6.x - w1[2] * c6.y, v1[2] * c6.y + w1[2] * c6.x); kb.w = cvt_pk_bf16(v1[3] * c7.x - w1[3] * c7.y, v1[3] * c7.y + w1[3] * c7.x);
                            bf16_t* kr = (bf16_t*)(ws + WS_KR) + (size_t)row * 32 + 16 * fq; *(u32x4*)kr = ka; *(u32x4*)(kr + 8) = kb; }
                    }
                    if (isk) { float p2 = sq8(v0, v1); p2 += __shfl_xor(p2, 16); p2 += __shfl_xor(p2, 32); if (bj == 0) kmx0 = __builtin_fmaxf(kmx0, p2); else kmx1 = __builtin_fmaxf(kmx1, p2); }
                    if (u.pn == 10 && bj == 1 && wc == 1 && fq == 0) { f32x4 lf; lf[0] = log_sigmoid_d(v0[0] + fb[0]); lf[1] = log_sigmoid_d(v0[1] + fb[1]); lf[2] = log_sigmoid_d(v0[2] + fb[2]); lf[3] = log_sigmoid_d(v0[3] + fb[3]); store16_sc1(logf + (size_t)row * 4, __builtin_bit_cast(u32x4, lf)); }
                }
                if (u.pn == 9 || u.pn == 10) { s += __shfl_xor(s, 16); s += __shfl_xor(s, 32); if (fq == 0) atomicAdd((u.pn == 9 ? ssq : sskv) + row, s); }
                asm volatile("" ::: "memory");
            }
        if (isk) {
            unsigned* kmax = (unsigned*)(sm + SM_KMAX / 4) + l * 64 + (u.pm / 32) * 32;
#pragma unroll
            for (int o = 1; o < 64; o <<= 1) { kmx0 = __builtin_fmaxf(kmx0, __shfl_xor(kmx0, o)); kmx1 = __builtin_fmaxf(kmx1, __shfl_xor(kmx1, o)); }
            if (fr == 0 && fq == 0) {
                const int i0 = u.pn == 1 ? (wc >> 1) : 4 + (2 * (u.pn - 5)) * 2 + (wc >> 1), i1 = u.pn == 1 ? 2 + (wc >> 1) : 4 + (2 * (u.pn - 5) + 1) * 2 + (wc >> 1);
                atomicMax(kmax + 2 * i0 + (wc & 1), __float_as_uint(kmx0)); atomicMax(kmax + 2 * i1 + (wc & 1), __float_as_uint(kmx1));
            }
        }
        if (u.pn == 9 || u.pn == 10) {
            asm volatile("s_waitcnt vmcnt(0)" ::: "memory");
            if (fr == 0 && fq == 0) __hip_atomic_fetch_add((unsigned*)(ws + WS_CTL) + CW_READY + l * 64 * 64 + 64 * u.pm, 1u, __ATOMIC_RELAXED, __HIP_MEMORY_SCOPE_AGENT);
        }
    }
};
struct EpiQ {
    static constexpr bool PERM = true, AFTER_DRAIN = false;
    bf16_t* QM; const float* ssq; const float2* rope;
    __device__ __forceinline__ void operator()(const f32x4 (&acc)[2][2][4][2], const Unit& u, int wr, int wc, int fr, int fq) const {
        { int t_ = threadIdx.x; asm volatile("" : "+v"(t_)); fr = t_ & 15; fq = (t_ >> 4) & 3; const int w_ = __builtin_amdgcn_readfirstlane(t_ >> 6); wr = w_ >> 2; wc = w_ & 3; }
        const int row0 = u.pm * BM + wr * 64 + fr, colw = wc * 32 + 8 * fq;
        float rsv[8];
#pragma unroll
        for (int g = 0; g < 8; ++g) rsv[g] = ssq[row0 + (g >> 2) * HALF + (g & 3) * 16];
#pragma unroll
        for (int ai = 0; ai < 2; ++ai) {
            f32x4 cr[4][2][2];
#pragma unroll
            for (int m = 0; m < 4; ++m) {
                const int row = row0 + ai * HALF + m * 16; const float2* rt = rope + (size_t)(row & (SEQ - 1)) * 16;
#pragma unroll
                for (int bj = 0; bj < 2; ++bj) { const int col = u.pn * BM + bj * HALF + colw, d = col % 96, j0 = d >= 64 ? (d - 64) >> 1 : 0;
                    cr[m][bj][0] = *(const f32x4*)(rt + j0); cr[m][bj][1] = *(const f32x4*)(rt + j0 + 2); }
            }
#pragma unroll
            for (int m = 0; m < 4; ++m) {
                const int row = row0 + ai * HALF + m * 16; const float rs = __builtin_amdgcn_rsqf(rsv[ai * 4 + m] * (1.0f / 256.0f) + EPS);
#pragma unroll
                for (int bj = 0; bj < 2; ++bj) {
                    const int col = u.pn * BM + bj * HALF + colw;
                    if (col < 384) {
                        f32x4 v0 = acc[ai][bj][m][0] * rs, v1 = acc[ai][bj][m][1] * rs;
                        const bool rp = (col % 96) >= 64; const f32x4 ca = cr[m][bj][0], cb = cr[m][bj][1];
                        f32x4 r0, r1;
                        r0[0] = v0[0] * ca[0] - v0[1] * ca[1]; r0[1] = v0[0] * ca[1] + v0[1] * ca[0]; r0[2] = v0[2] * ca[2] - v0[3] * ca[3]; r0[3] = v0[2] * ca[3] + v0[3] * ca[2];
                        r1[0] = v1[0] * cb[0] - v1[1] * cb[1]; r1[1] = v1[0] * cb[1] + v1[1] * cb[0]; r1[2] = v1[2] * cb[2] - v1[3] * cb[3]; r1[3] = v1[2] * cb[3] + v1[3] * cb[2];
#pragma unroll
                        for (int e = 0; e < 4; ++e) { v0[e] = rp ? r0[e] : v0[e]; v1[e] = rp ? r1[e] : v1[e]; }
                        *(u32x4*)(QM + (size_t)row * 384 + col) = pack8(v0, v1);
                    }
                }
            }
            asm volatile("" ::: "memory");
        }
    }
};
struct EpiKV {
    static constexpr bool PERM = true, AFTER_DRAIN = false;
    bf16_t* KVM; const float* sskv;
    __device__ __forceinline__ void operator()(const f32x4 (&acc)[2][2][4][2], const Unit& u, int wr, int wc, int fr, int fq) const {
        { int t_ = threadIdx.x; asm volatile("" : "+v"(t_)); fr = t_ & 15; fq = (t_ >> 4) & 3; const int w_ = __builtin_amdgcn_readfirstlane(t_ >> 6); wr = w_ >> 2; wc = w_ & 3; }
        const int row0 = u.pm * BM + wr * 64 + fr, colw = wc * 32 + 8 * fq;
        float rsv[8];
#pragma unroll
        for (int g = 0; g < 8; ++g) rsv[g] = sskv[row0 + (g >> 2) * HALF + (g & 3) * 16];
#pragma unroll
        for (int ai = 0; ai < 2; ++ai)
#pragma unroll
            for (int m = 0; m < 4; ++m) {
                const int row = row0 + ai * HALF + m * 16; const float rs = __builtin_amdgcn_rsqf(rsv[ai * 4 + m] * (1.0f / 128.0f) + EPS);
#pragma unroll
                for (int bj = 0; bj < 2; ++bj) *(u32x4*)(KVM + (size_t)row * 512 + u.pn * BM + bj * HALF + colw) = pack8(acc[ai][bj][m][0] * rs, acc[ai][bj][m][1] * rs);
                asm volatile("" ::: "memory");
            }
    }
};
struct EpiRes {
    static constexpr bool PERM = true, AFTER_DRAIN = false;
    const bf16_t* xold; bf16_t* xb; float* ss;
    __device__ __forceinline__ void operator()(const f32x4 (&acc)[2][2][4][2], const Unit& u, int wr, int wc, int fr, int fq) const {
        { int t_ = threadIdx.x; asm volatile("" : "+v"(t_)); fr = t_ & 15; fq = (t_ >> 4) & 3; const int w_ = __builtin_amdgcn_readfirstlane(t_ >> 6); wr = w_ >> 2; wc = w_ & 3; }
        const int row0 = u.pm * BM + wr * 64 + fr, colw = wc * 32 + 8 * fq;
        u32x4 ro[2][4][2];
#pragma unroll
        for (int ai = 0; ai < 2; ++ai)
#pragma unroll
            for (int m = 0; m < 4; ++m)
#pragma unroll
                for (int bj = 0; bj < 2; ++bj) ro[ai][m][bj] = *(const u32x4*)(xold + (size_t)(row0 + ai * HALF + m * 16) * DM + u.pn * BM + bj * HALF + colw);
#pragma unroll
        for (int ai = 0; ai < 2; ++ai)
#pragma unroll
            for (int m = 0; m < 4; ++m) {
                const int row = row0 + ai * HALF + m * 16; float s = 0.f;
#pragma unroll
                for (int bj = 0; bj < 2; ++bj) {
                    const size_t off = (size_t)row * DM + u.pn * BM + bj * HALF + colw;
                    const u32x4 r_ = ro[ai][m][bj];
                    const f32x4 v0 = (f32x4){bflo(r_[0]), bfhi(r_[0]), bflo(r_[1]), bfhi(r_[1])} + acc[ai][bj][m][0], v1 = (f32x4){bflo(r_[2]), bfhi(r_[2]), bflo(r_[3]), bfhi(r_[3])} + acc[ai][bj][m][1];
                    *(u32x4*)(xb + off) = pack8(v0, v1);
                    s += sq8(v0, v1);
                }
                s += __shfl_xor(s, 16); s += __shfl_xor(s, 32); if (fq == 0) atomicAdd(ss + row, s);
            }
    }
};
struct EpiResFinal {
    static constexpr bool PERM = true, AFTER_DRAIN = true;
    const bf16_t* xold; float* out; float* ss; const float* g; unsigned* cnt;
    __device__ __forceinline__ void fused(f32x4 (&acc)[2][2][4][2], const Unit& u, int wr, int wc, int fr, int fq, PG8_LAS unsigned char* lds, int wid, int lane) const {
        { int t_ = threadIdx.x; asm volatile("" : "+v"(t_)); fr = t_ & 15; fq = (t_ >> 4) & 3; const int w_ = __builtin_amdgcn_readfirstlane(t_ >> 6); wr = w_ >> 2; wc = w_ & 3; }
        const int row0 = u.pm * BM + wr * 64 + fr, colw = wc * 32 + 8 * fq;
        u32x4 ro[2][4][2];
#pragma unroll
        for (int ai = 0; ai < 2; ++ai)
#pragma unroll
            for (int m = 0; m < 4; ++m)
#pragma unroll
                for (int bj = 0; bj < 2; ++bj) ro[ai][m][bj] = *(const u32x4*)(xold + (size_t)(row0 + ai * HALF + m * 16) * DM + u.pn * BM + bj * HALF + colw);
#pragma unroll
        for (int ai = 0; ai < 2; ++ai)
#pragma unroll
            for (int m = 0; m < 4; ++m) {
                const int row = row0 + ai * HALF + m * 16; float s = 0.f;
#pragma unroll
                for (int bj = 0; bj < 2; ++bj) {
                    const u32x4 r_ = ro[ai][m][bj];
                    acc[ai][bj][m][0] += (f32x4){bflo(r_[0]), bfhi(r_[0]), bflo(r_[1]), bfhi(r_[1])}; acc[ai][bj][m][1] += (f32x4){bflo(r_[2]), bfhi(r_[2]), bflo(r_[3]), bfhi(r_[3])};
                    s += sq8(acc[ai][bj][m][0], acc[ai][bj][m][1]);
                }
                s += __shfl_xor(s, 16); s += __shfl_xor(s, 32); if (fq == 0) atomicAdd(ss + row, s);
            }
        asm volatile("s_waitcnt vmcnt(0)" ::: "memory");
        __syncthreads();
        if (threadIdx.x == 0) {
            unsigned* c = cnt + 16 * u.pm;
            __hip_atomic_fetch_add(c, 1u, __ATOMIC_RELAXED, __HIP_MEMORY_SCOPE_AGENT);
            unsigned spins = 0;
            while (__hip_atomic_load(c, __ATOMIC_RELAXED, __HIP_MEMORY_SCOPE_AGENT) < 4u && ++spins < (1u << 22)) __builtin_amdgcn_s_sleep(2);
        }
        __syncthreads();
#pragma unroll
        for (int ai = 0; ai < 2; ++ai)
#pragma unroll
            for (int m = 0; m < 4; ++m) {
                const int row = row0 + ai * HALF + m * 16;
                const float rs = __builtin_amdgcn_rsqf(__hip_atomic_load(ss + row, __ATOMIC_RELAXED, __HIP_MEMORY_SCOPE_AGENT) * (1.0f / DM) + EPS);
#pragma unroll
                for (int bj = 0; bj < 2; ++bj) {
                    const int col = u.pn * BM + bj * HALF + colw; const size_t off = (size_t)row * DM + col;
                    const f32x4 g0 = *(const f32x4*)(g + col), g1 = *(const f32x4*)(g + col + 4);
                    __builtin_nontemporal_store(acc[ai][bj][m][0] * rs * g0, (f32x4*)(out + off)); __builtin_nontemporal_store(acc[ai][bj][m][1] * rs * g1, (f32x4*)(out + off + 4));
                }
            }
    }
};
struct HOrder : StaticOrder {
    __device__ void init_h(int G_, int c_) { nM = MTOK / BM; nN = 9; nwg = nM * nN; G = G_; c = c_; }
    __device__ bool next(int i, Unit& u) const {
        const int L = i * G + c; if (L >= 128 + nwg) return false;
        if (L < 128) { u.pm = L >> 1; u.pn = 9 + (L & 1); return true; }
        int wgid = L - 128; { const int q = nwg / NXCD, r = nwg % NXCD, xcd = wgid % NXCD, off = wgid / NXCD; wgid = (xcd < r ? xcd * (q + 1) : r * (q + 1) + (xcd - r) * q) + off; }
        const int nig = WGM * nN, gid = wgid / nig, fm = gid * WGM, gsz = (nM - fm) < WGM ? (nM - fm) : WGM;
        u.pm = fm + ((wgid % nig) % gsz); u.pn = (wgid % nig) / gsz; return true;
    }
};
struct MOrder {
    int nwg, Gm, cm; bool active; const unsigned* ready; unsigned need;
    __device__ void init(int G, int c, int c0, int span, const unsigned* ready_, unsigned need_) { nwg = 128; Gm = span; cm = (c + G - c0) % G; active = cm < span; ready = ready_; need = need_; }
    __device__ bool next(int i, Unit& u) const { if (!active) return false; const int per = nwg / Gm; if (i >= per) return false; const int L = cm * per + i; u.pm = L >> 1; u.pn = L & 1; return true; }
    __device__ __forceinline__ int arow(const Unit& u) const { return u.pm * BM; }
    __device__ __forceinline__ int arperm(int R) const { return R; }
    __device__ __forceinline__ int ahalf() const { return HALF; }
    __device__ __forceinline__ void a_ready(const Unit& u) const {
        if (threadIdx.x < 64) {
            unsigned polls = 0;
            while ((unsigned)__builtin_amdgcn_readfirstlane(__hip_atomic_load(ready + 64 * u.pm, __ATOMIC_RELAXED, __HIP_MEMORY_SCOPE_AGENT)) < need && ++polls < (1u << 22)) __builtin_amdgcn_s_sleep(2);
            __builtin_amdgcn_fence(__ATOMIC_ACQUIRE, "agent");
            asm volatile("s_waitcnt vmcnt(0)" ::: "memory");
        }
        asm volatile("" ::: "memory"); __builtin_amdgcn_s_barrier(); asm volatile("" ::: "memory");
    }
    __device__ __forceinline__ void done(const Unit&) const {}
};
struct HalfOrder {
    int nN, nwg, G2, c2; bool active;
    __device__ void init(int M, int N, int G, int c, int half) { nN = N / BM; nwg = (M / BM) * nN; G2 = G / 2; active = (c / G2) == half; c2 = c % G2; }
    __device__ bool next(int i, Unit& u) const { if (!active) return false; const int L = i * G2 + c2; if (L >= nwg) return false; u.pm = L / nN; u.pn = L % nN; return true; }
    __device__ __forceinline__ int arow(const Unit& u) const { return u.pm * BM; }
    __device__ __forceinline__ int arperm(int R) const { return R; }
    __device__ __forceinline__ int ahalf() const { return HALF; }
    __device__ __forceinline__ void a_ready(const Unit&) const {}
    __device__ __forceinline__ void done(const Unit&) const {}
};
constexpr int UP_TILES_PER_B = 33, UP_NM = 2 * UP_TILES_PER_B, UP_NN = NUP / 256;
__device__ __forceinline__ int up_tile_start(int pm) { const int b = pm / UP_TILES_PER_B, i = pm % UP_TILES_PER_B; int s = 252 * i; s = s > SEQ - 254 ? SEQ - 254 : s; return b * SEQ + s; }
struct UpOrder : StaticOrder {
    __device__ void init_up(int G_, int c_) { nM = UP_NM; nN = UP_NN; nwg = nM * nN; G = G_; c = c_; }
    __device__ __forceinline__ int arow(const Unit& u) const { return up_tile_start(u.pm); }
    __device__ __forceinline__ int arperm(int R) const { return R < 64 ? R : R + 62; }
    __device__ __forceinline__ int ahalf() const { return 64; }
};
template <int CTRL> __device__ __forceinline__ float dppz(float src) {
    return __builtin_bit_cast(float, __builtin_amdgcn_update_dpp(0, __builtin_bit_cast(int, src), CTRL, 0xf, 0xf, false));
}
struct EpiUp {
    static constexpr bool PERM = true, AFTER_DRAIN = false;
    unsigned char* ws; const float* cw; const float* cb; int l;
    __device__ __forceinline__ void operator()(f32x4 (&acc)[2][2][4][2], const Unit& u, int wr, int wc, int fr, int fq) const {
        { int t_ = threadIdx.x; asm volatile("" : "+v"(t_)); fr = t_ & 15; fq = (t_ >> 4) & 3; const int w_ = __builtin_amdgcn_readfirstlane(t_ >> 6); wr = w_ >> 2; wc = w_ & 3; }
        const float* ss2 = (const float*)(ws + WS_SM) + SM_SS2 / 4 + l * MTOK; bf16_t* act = (bf16_t*)(ws + WS_HB);
        const int t0 = up_tile_start(u.pm) + 126 * wr + fr;
        const bool keep_head = (u.pm % UP_TILES_PER_B) == 0 && wr == 0;
#pragma unroll
        for (int ai = 0; ai < 2; ++ai)
#pragma unroll
            for (int m = 0; m < 4; ++m) { const float rs = __builtin_amdgcn_rsqf(ss2[t0 + ai * 64 + m * 16] * (1.0f / DM) + EPS);
#pragma unroll
                for (int bj = 0; bj < 2; ++bj) { acc[ai][bj][m][0] *= rs; acc[ai][bj][m][1] *= rs; } }
        const int cg0 = u.pn * 128 + wc * 32 + 8 * fq;
        unsigned st[2][4][2];
        f32x4 cwv[2][8];
#pragma unroll
        for (int n = 0; n < 2; ++n) { const int cg = cg0 + 4 * n;
            cwv[n][0] = *(const f32x4*)(cw + cg); cwv[n][1] = *(const f32x4*)(cw + NUP + cg); cwv[n][2] = *(const f32x4*)(cw + 2 * NUP + cg); cwv[n][3] = *(const f32x4*)(cb + cg);
            cwv[n][4] = *(const f32x4*)(cw + DFF + cg); cwv[n][5] = *(const f32x4*)(cw + NUP + DFF + cg); cwv[n][6] = *(const f32x4*)(cw + 2 * NUP + DFF + cg); cwv[n][7] = *(const f32x4*)(cb + DFF + cg); }
#pragma unroll
        for (int n = 0; n < 2; ++n) {
            const f32x4 wg0 = cwv[n][0], wg1 = cwv[n][1], wg2 = cwv[n][2], bg = cwv[n][3], wu0 = cwv[n][4], wu1 = cwv[n][5], wu2 = cwv[n][6], bu = cwv[n][7];
#pragma unroll
            for (int ai = 0; ai < 2; ++ai)
#pragma unroll
                for (int m = 0; m < 4; ++m) {
                    const f32x4 xg = acc[ai][0][m][n], xu = acc[ai][1][m][n];
                    f32x4 pg, pu;
                    if (m > 0) { pg = acc[ai][0][m - 1][n]; pu = acc[ai][1][m - 1][n]; }
                    else if (ai > 0) { pg = acc[0][0][3][n]; pu = acc[0][1][3][n]; }
                    else { pg = (f32x4){0.f, 0.f, 0.f, 0.f}; pu = pg; }
                    float a[4];
#pragma unroll
                    for (int c = 0; c < 4; ++c) {
                        float G = bg[c], U = bu[c];
                        asm volatile("v_fmac_f32 %0, %6, %2\n\tv_fmac_f32 %1, %9, %4\n\t"
                                     "v_fmac_f32_dpp %0, %2, %7 row_shr:1 row_mask:0xf bank_mask:0xf bound_ctrl:1\n\tv_fmac_f32_dpp %0, %3, %7 row_shl:15 row_mask:0xf bank_mask:0xf bound_ctrl:1\n\t"
                                     "v_fmac_f32_dpp %1, %4, %10 row_shr:1 row_mask:0xf bank_mask:0xf bound_ctrl:1\n\tv_fmac_f32_dpp %1, %5, %10 row_shl:15 row_mask:0xf bank_mask:0xf bound_ctrl:1\n\t"
                                     "v_fmac_f32_dpp %0, %2, %8 row_shr:2 row_mask:0xf bank_mask:0xf bound_ctrl:1\n\tv_fmac_f32_dpp %0, %3, %8 row_shl:14 row_mask:0xf bank_mask:0xf bound_ctrl:1\n\t"
                                     "v_fmac_f32_dpp %1, %4, %11 row_shr:2 row_mask:0xf bank_mask:0xf bound_ctrl:1\n\tv_fmac_f32_dpp %1, %5, %11 row_shl:14 row_mask:0xf bank_mask:0xf bound_ctrl:1"
                                     : "+v"(G), "+v"(U) : "v"(xg[c]), "v"(pg[c]), "v"(xu[c]), "v"(pu[c]), "v"(wg2[c]), "v"(wg1[c]), "v"(wg0[c]), "v"(wu2[c]), "v"(wu1[c]), "v"(wu0[c]));
                        a[c] = G * __builtin_amdgcn_rcpf(1.0f + __builtin_amdgcn_exp2f(-1.4426950408889634f * G)) * U;
                    }
                    if (n == 0) { st[ai][m][0] = cvt_pk_bf16(a[0], a[1]); st[ai][m][1] = cvt_pk_bf16(a[2], a[3]); }
                    else { u32x4 w; w[0] = st[ai][m][0]; w[1] = st[ai][m][1]; w[2] = cvt_pk_bf16(a[0], a[1]); w[3] = cvt_pk_bf16(a[2], a[3]);
                        const bool halo = (ai == 0 && m == 0 && fr < 2 && !keep_head);
                        if (!halo) *(u32x4*)(act + (size_t)(t0 + ai * 64 + m * 16) * DFF + cg0) = w; }
                }
            asm volatile("" ::: "memory");
        }
    }
};
}
namespace att {
typedef short bf16x8 __attribute__((ext_vector_type(8)));
typedef short s16x4 __attribute__((ext_vector_type(4)));
typedef float f32x4 __attribute__((ext_vector_type(4)));
constexpr int ST_K = 0, ST_V = 16384, ST_CK = 32768, ST_BYTES = 33280;
constexpr int NSTAGE = 4, SC_OFF = NSTAGE * ST_BYTES;
constexpr float SKIP_MARGIN = 152.0f;
constexpr float THR = 8.0f;
constexpr float MASKV = -1.0e30f;
constexpr int N_FOX = 256, N_MLA = 256, N_DIFF = 512, N_ITEMS = N_FOX + N_MLA + N_DIFF;

__device__ __forceinline__ s16x4 vtr(LAS const unsigned char* p) { typedef short v4i16_t __attribute__((ext_vector_type(4))); return __builtin_bit_cast(s16x4, __builtin_amdgcn_ds_read_tr16_b64_v4i16((LAS v4i16_t*)p)); }
__device__ __forceinline__ unsigned cvtpk(float lo, float hi) { typedef float f32x2_t __attribute__((ext_vector_type(2))); typedef __bf16 bf16x2_t __attribute__((ext_vector_type(2))); f32x2_t v = {lo, hi}; bf16x2_t b = __builtin_convertvector(v, bf16x2_t); return __builtin_bit_cast(unsigned, b); }
__device__ __forceinline__ float max3f(float a, float b, float c) { return __builtin_fmaxf(__builtin_fmaxf(a, b), c); }
__device__ __forceinline__ float halfmax(float v) { auto rr = __builtin_amdgcn_permlane32_swap(__float_as_uint(v), __float_as_uint(v), false, false); return __builtin_fmaxf(__uint_as_float(rr[0]), __uint_as_float(rr[1])); }
__device__ __forceinline__ float halfsum(float v) { auto rr = __builtin_amdgcn_permlane32_swap(__float_as_uint(v), __float_as_uint(v), false, false); return __uint_as_float(rr[0]) + __uint_as_float(rr[1]); }

template <bool ISMAX> __device__ __forceinline__ float wave_red32(float v) {
#define RED_(x, y) (ISMAX ? __builtin_fmaxf((x), (y)) : __builtin_fminf((x), (y)))
    v = RED_(v, __builtin_bit_cast(float, __builtin_amdgcn_update_dpp(0, __builtin_bit_cast(int, v), 0xB1, 0xf, 0xf, false)));
    v = RED_(v, __builtin_bit_cast(float, __builtin_amdgcn_update_dpp(0, __builtin_bit_cast(int, v), 0x4E, 0xf, 0xf, false)));
    v = RED_(v, __builtin_bit_cast(float, __builtin_amdgcn_update_dpp(0, __builtin_bit_cast(int, v), 0x141, 0xf, 0xf, false)));
    v = RED_(v, __builtin_bit_cast(float, __builtin_amdgcn_update_dpp(0, __builtin_bit_cast(int, v), 0x140, 0xf, 0xf, false)));
    const float a = __builtin_bit_cast(float, __builtin_amdgcn_readlane(__builtin_bit_cast(int, v), 0)), b = __builtin_bit_cast(float, __builtin_amdgcn_readlane(__builtin_bit_cast(int, v), 16));
    return RED_(a, b);
#undef RED_
}
__device__ __forceinline__ void item_decode(int i, int& type, int& rem) { if (i < N_FOX) { type = 0; rem = i; } else if (i < N_FOX + N_DIFF) { type = 1; rem = i - N_FOX; } else { type = 2; rem = i - N_FOX - N_DIFF; } }
__device__ __forceinline__ int item_est(int i) {
    int type, rem; item_decode(i, type, rem);
    if (type == 0) { const int nt = 4 * (rem % 32) + 4; return 16 * (nt < 20 ? nt : 20); }
    if (type == 2) return 20 * (4 * (rem % 32) + 4);
    const int head = (rem / 64) & 3, nt = 2 * (rem % 64) + 2, w = head == 0 ? 10 : (head == 1 ? 32 : 128);
    return 24 * (nt < w ? nt : w);
}
__device__ __forceinline__ void build_items(int* list, LAS int* red, int bx, int tid, int G) {
    const int e0 = item_est(tid), e1 = item_est(tid + 512);
    for (int i = bx; i < N_ITEMS; i += G) {
        __syncthreads();
        const int ci = item_est(i);
        const int c = __builtin_popcountll(__ballot(e0 > ci || (e0 == ci && tid < i))) + __builtin_popcountll(__ballot(e1 > ci || (e1 == ci && tid + 512 < i)));
        if ((tid & 63) == 0) red[tid >> 6] = c;
        __syncthreads();
        if (tid == 0) { int type, rem; item_decode(i, type, rem); list[red[0] + red[1] + red[2] + red[3] + red[4] + red[5] + red[6] + red[7]] = type | (rem << 2); }
    }
    __syncthreads();
}

struct Params { unsigned char* ws; int l; float lam_init; };

#ifndef PROBE_FLAGS
#define PROBE_FLAGS 0
#endif
template <int MODE, int PRB = 0>
__device__ __forceinline__ void attn_unit(const Params& P, LAS unsigned char* lds, const int b, const int head, const int qblk, unsigned* qctr) {
    constexpr int DK = MODE == 2 ? 96 : 64, DV = MODE == 1 ? 128 : 64, NS = DK / 16, NDB = DV / 32;
    constexpr int KPITCH = MODE == 2 ? 256 : 128, VPITCH = DV * 2;
    int tid = threadIdx.x; asm volatile("" : "+v"(tid));
    const int lane = tid & 63, wave = __builtin_amdgcn_readfirstlane(tid >> 6), r = lane & 31, h = lane >> 5;
    const size_t rb = (size_t)b * SEQ;
    const int wq = MODE == 1 ? (wave & 3) : wave;
    const int map = MODE == 1 ? (wave >> 2) : 0;
    const int q0 = (MODE == 1 ? 128 : 256) * qblk, qrow = q0 + 32 * wq;
    const int NT = (MODE == 1 ? 2 : 4) * qblk + (MODE == 1 ? 2 : 4);
    const int jv = (MODE == 1 ? 2 : 4) * qblk + (wq >> 1);
    const bf16 *Qp, *Kp, *K2p = nullptr, *Vp; int qpitch, kpitch, vpitch; bf16* Op;
    const bf16* P_HB = (const bf16*)(P.ws + WS_HB); bf16* P_AO = (bf16*)(P.ws + WS_AO); const float* P_cum = (const float*)(P.ws + WS_SM + SM_CUM);
    const unsigned* P_kmax = (const unsigned*)(P.ws + WS_SM + SM_KMAX) + P.l * 64;
    constexpr int PFL = PRB ? PROBE_FLAGS : 0;
    if (PRB) P_AO = (bf16*)(P.ws + WS_XB);
    if (MODE == 0) { Qp = P_HB + H_FQ + head * 64; Kp = P_HB + H_FK + head * 64; Vp = P_HB + H_FV + head * 64; qpitch = kpitch = vpitch = HN; Op = P_AO + head * 64; }
    else if (MODE == 1) { Qp = P_HB + H_DQ + head * 128 + map * 64; Kp = P_HB + H_DK + head * 128; Vp = P_HB + H_DV + head * 128; qpitch = kpitch = vpitch = HN; Op = P_AO + 256 + head * 128; }
    else { const bf16* P_KVM = (const bf16*)(P.ws + WS_KVM); Qp = (const bf16*)(P.ws + WS_QM) + head * 96; Kp = P_KVM + head * 128; K2p = (const bf16*)(P.ws + WS_KR); Vp = P_KVM + head * 128 + 64; qpitch = 384; kpitch = vpitch = 512; Op = P_AO + 768 + head * 64; }
    bf16x8 qf[NS];
    if (MODE != 2) {
#pragma unroll
        for (int s = 0; s < NS; ++s) qf[s] = *(const bf16x8*)(Qp + (rb + qrow + r) * qpitch + 16 * s + 8 * h);
    }
    unsigned dv0 = 0, dv1 = 0, dv2 = 0, dv3 = 0, ds0 = 0, ds1 = 0;
    const void* dbaseK = Kp; const void* dbaseV = Vp;
    if (MODE != 2) {
        const int row = 8 * wave + (lane >> 3), ch = (lane & 7) ^ ((row >> 1) & 7);
        dv0 = (unsigned)((rb + row) * kpitch * 2 + ch * 16); dv1 = dv0 + 128; ds0 = ds1 = 64 * kpitch * 2;
    } else {
#pragma unroll
        for (int i = 0; i < 2; ++i) { const int row = 4 * (2 * wave + i) + (lane >> 4), c = (lane & 15) ^ (row & 15);
            const unsigned off = (c >= 8 && c < 12) ? (unsigned)((const char*)K2p - (const char*)Kp) + (unsigned)((rb + row) * 64 + (c - 8) * 16) : (unsigned)((rb + row) * kpitch * 2 + (c < 8 ? c : 0) * 16);
            const unsigned st = (c >= 8 && c < 12) ? 64 * 64 : 64 * kpitch * 2;
            if (i == 0) { dv0 = off; ds0 = st; } else { dv1 = off; ds1 = st; } }
    }
    if (DV == 64) { const int row = 8 * wave + (lane >> 3), p = lane & 7; dv2 = (unsigned)((rb + row) * vpitch * 2 + ((((p >> 2) ^ ((row >> 1) & 1)) << 2) | (p & 3)) * 16); }
    else {
#pragma unroll
        for (int i = 0; i < 2; ++i) { const int row = 4 * (2 * wave + i) + (lane >> 4), p = lane & 15; const unsigned off = (unsigned)((rb + row) * vpitch * 2 + ((((p >> 2) ^ (row & 3)) << 2) | (p & 3)) * 16); if (i == 0) dv2 = off; else dv3 = off; }
    }
    const unsigned dck = (MODE == 0) ? (unsigned)(((rb + lane) * 4 + head) * 4) : 0u;
    const unsigned ldsb = (unsigned)(uintptr_t)lds;
#define ATT_DMA(j, st) do { const unsigned sb_ = ldsb + (st) * ST_BYTES; const unsigned jc_ = (unsigned)(j); const unsigned jj_ = (PFL & 64) ? 0u : jc_; \
        if (MODE == 2) { pg8::glds16_s(dv0 + jj_ * ds0, dbaseK, sb_ + ST_K + (2 * wave) * 1024); pg8::glds16_s(dv1 + jj_ * ds1, dbaseK, sb_ + ST_K + (2 * wave + 1) * 1024); } \
        else { pg8::glds16_s(dv0 + jj_ * ds0, dbaseK, sb_ + ST_K + wave * 1024); if (MODE == 1) pg8::glds16_s(dv1 + jj_ * ds1, dbaseK, sb_ + ST_K + 8192 + wave * 1024); } \
        if (DV == 64) pg8::glds16_s(dv2 + jj_ * (64 * vpitch * 2), dbaseV, sb_ + ST_V + wave * 1024); \
        else { pg8::glds16_s(dv2 + jj_ * (64 * vpitch * 2), dbaseV, sb_ + ST_V + (2 * wave) * 1024); pg8::glds16_s(dv3 + jj_ * (64 * vpitch * 2), dbaseV, sb_ + ST_V + (2 * wave + 1) * 1024); } \
        if (MODE == 0 && wave == 0) pg8::glds4_s(dck + jc_ * (64 * 16), (const void*)P_cum, sb_ + ST_CK); } while (0)
#define ATT_WAIT_1() do { if (MODE == 1) asm volatile("s_waitcnt vmcnt(4)" ::: "memory"); else if (MODE == 2 || wave == 0) asm volatile("s_waitcnt vmcnt(3)" ::: "memory"); else asm volatile("s_waitcnt vmcnt(2)" ::: "memory"); } while (0)
#define ATT_WAIT_0() asm volatile("s_waitcnt vmcnt(0)" ::: "memory")
    LAS float* scf = (LAS float*)(lds + SC_OFF);
    ATT_DMA(NT - 1, 0); ATT_DMA(NT - 2, 1);
    if (MODE == 2) {
        const void* Wb = (const void*)(P.ws + WS_W + (size_t)P.l * WS_WL + W_UQ);
#pragma unroll
        for (int i = 0; i < 6; ++i) { const int piece = wave * 6 + i, row = 2 * piece + (lane >> 5), c = (lane & 31) ^ (row & 15);
            pg8::glds16_s((unsigned)((head * 96 + row) * 512 + c * 16), Wb, ldsb + 2 * ST_BYTES + piece * 1024); }
        const bf16* Cq = P_HB + H_CQ + (rb + qrow + r) * HN + 8 * h;
        bf16x8 cf[16];
#pragma unroll
        for (int ks = 0; ks < 16; ++ks) cf[ks] = *(const bf16x8*)(Cq + 16 * ks);
        const float rsq = __builtin_amdgcn_rsqf(((const float*)(P.ws + WS_SM + SM_SSQ))[(size_t)P.l * MTOK + rb + qrow + r] * (1.0f / 256.0f) + EPS);
        const float2* rt = (const float2*)(P.ws + WS_ROPE) + (size_t)(qrow + r) * 16 + 2 * h;
        f32x4 cs[4];
#pragma unroll
        for (int g = 0; g < 4; ++g) cs[g] = *(const f32x4*)(rt + 4 * g);
        ATT_WAIT_0(); __syncthreads();
        LAS const unsigned char* wl_ = lds + 2 * ST_BYTES + r * 512;
        f32x16 qa[3];
#pragma unroll
        for (int db = 0; db < 3; ++db) {
#pragma unroll
            for (int i = 0; i < 16; ++i) qa[db][i] = 0.f;
#pragma unroll
            for (int ks = 0; ks < 16; ++ks) { const bf16x8 wf = *(LAS const bf16x8*)(wl_ + db * (32 * 512) + (((2 * ks + h) ^ (r & 15)) << 4)); qa[db] = __builtin_amdgcn_mfma_f32_32x32x16_bf16(wf, cf[ks], qa[db], 0, 0, 0); }
        }
#pragma unroll
        for (int db = 0; db < 3; ++db)
#pragma unroll
            for (int i = 0; i < 16; ++i) qa[db][i] *= rsq;
#pragma unroll
        for (int g = 0; g < 4; ++g) {
            const float x0 = qa[2][4 * g], x1 = qa[2][4 * g + 1], y0 = qa[2][4 * g + 2], y1 = qa[2][4 * g + 3];
            qa[2][4 * g] = x0 * cs[g][0] - x1 * cs[g][1]; qa[2][4 * g + 1] = x0 * cs[g][1] + x1 * cs[g][0]; qa[2][4 * g + 2] = y0 * cs[g][2] - y1 * cs[g][3]; qa[2][4 * g + 3] = y0 * cs[g][3] + y1 * cs[g][2];
        }
#pragma unroll
        for (int db = 0; db < 3; ++db)
#pragma unroll
            for (int hf = 0; hf < 2; ++hf) {
                const unsigned a0 = cvtpk(qa[db][8 * hf], qa[db][8 * hf + 1]), a1 = cvtpk(qa[db][8 * hf + 2], qa[db][8 * hf + 3]), b0 = cvtpk(qa[db][8 * hf + 4], qa[db][8 * hf + 5]), b1 = cvtpk(qa[db][8 * hf + 6], qa[db][8 * hf + 7]);
                const auto s0 = __builtin_amdgcn_permlane32_swap(a0, b0, false, false), s1 = __builtin_amdgcn_permlane32_swap(a1, b1, false, false);
                v4u w_; w_.x = s0[0]; w_.y = s1[0]; w_.z = s0[1]; w_.w = s1[1];
                qf[2 * db + hf] = __builtin_bit_cast(bf16x8, w_);
            }
    }
    if (MODE != 2) {
        float qA = 0.f, qB = 0.f;
#pragma unroll
        for (int s = 0; s < NS; ++s)
#pragma unroll
            for (int e = 0; e < 8; ++e) { const float x = bf2f((unsigned short)qf[s][e]); if (s < NS / 2) qA += x * x; else qB += x * x; }
        qA = halfsum(qA); qB = halfsum(qB);
        const int ki = 2 * (MODE == 0 ? head : 4 + 2 * head + map);
        const float kA = __uint_as_float(P_kmax[b * 32 + ki]), kB = __uint_as_float(P_kmax[b * 32 + ki + 1]);
        const float ub = wave_red32<true>(__builtin_sqrtf(qA * kA) + __builtin_sqrtf(qB * kB));
        if (lane == 0) { scf[8 + wave] = ub; scf[wave] = MASKV; scf[32 + wave] = MASKV; }
    }
    unsigned ka[NS];
#pragma unroll
    for (int s = 0; s < NS; ++s) ka[s] = ST_K + (MODE == 1 ? map * 8192 : 0) + r * KPITCH + (MODE == 2 ? (((2 * s + h) ^ (r & 15)) << 4) : (((2 * s + h) ^ ((r >> 1) & 7)) << 4));
    unsigned va[NDB];
    { const int qp = (lane & 15) >> 2, kb_ = 4 * h + qp, dby = 32 * ((lane >> 4) & 1) + 8 * (lane & 3);
#pragma unroll
      for (int d = 0; d < NDB; ++d) va[d] = ST_V + kb_ * VPITCH + (DV == 64 ? ((d ^ ((qp >> 1) & 1)) << 6) : ((d ^ qp) << 6)) + dby; }
    f32x16 o[NDB];
#pragma unroll
    for (int d = 0; d < NDB; ++d)
#pragma unroll
        for (int i = 0; i < 16; ++i) o[d][i] = 0.f;
    float mref = 0.f, l_run = 0.f;
    const float slope2 = (MODE == 1) ? exp2f(-2.0f * (float)(head + 1)) * LOG2E : 0.f;
    const bool may_exit = (MODE == 0) || (MODE == 1 && slope2 * (float)q0 > SKIP_MARGIN);
    f32x16 cini;
#pragma unroll
    for (int i = 0; i < 16; ++i) cini[i] = (MODE == 1) ? slope2 * (float)(64 * (NT - 1) + 4 * h - (qrow + r) + (i & 3) + 8 * (i >> 2)) : 0.f;
    ATT_WAIT_0(); __syncthreads();
    float qk_ub = 0.f;
    if (MODE != 2) {
        const f32x4 qa0 = *(LAS const f32x4*)(scf + 8), qa1 = *(LAS const f32x4*)(scf + 12);
        const float qmx = __builtin_fmaxf(__builtin_fmaxf(__builtin_fmaxf(qa0[0], qa0[1]), __builtin_fmaxf(qa0[2], qa0[3])), __builtin_fmaxf(__builtin_fmaxf(qa1[0], qa1[1]), __builtin_fmaxf(qa1[2], qa1[3])));
        qk_ub = qmx * 1.02f;
    }
    for (int tp = 0; tp < NT / 2; ++tp) {
        const int sg = (tp & 1) * 2;
        if (2 * tp + 2 < NT) { ATT_DMA(NT - 3 - 2 * tp, 2 - sg); ATT_DMA(NT - 4 - 2 * tp, 3 - sg); }
        const float cmp_ = (MODE == 1) ? slope2 * (float)(64 * (NT - 1 - 2 * tp) + 63 - q0) : 0.f;
        const bool tst = may_exit && (MODE == 0 || cmp_ < -(SKIP_MARGIN - 16.0f)), pub = may_exit && (MODE == 0 || cmp_ - 128.0f * slope2 < -(SKIP_MARGIN - 16.0f));
        if (MODE != 2 && tst) {
            const int mr = (tp & 1) ? 0 : 32; const f32x4 m0 = *(LAS const f32x4*)(scf + mr), m1 = *(LAS const f32x4*)(scf + mr + 4);
            const float mmin = __builtin_fminf(__builtin_fminf(__builtin_fminf(m0[0], m0[1]), __builtin_fminf(m0[2], m0[3])), __builtin_fminf(__builtin_fminf(m1[0], m1[1]), __builtin_fminf(m1[2], m1[3])));
            const float cm = MODE == 0 ? *(LAS const float*)(lds + sg * ST_BYTES + ST_CK + 63 * 4) : slope2 * (float)(64 * (NT - 1 - 2 * tp) + 63 - q0);
            if (qk_ub + cm < mmin - SKIP_MARGIN) break;
        }
      bool pair_done = false;
      if (true) {
        if (NT - 1 - 2 * tp < jv) {
            LAS const unsigned char* sa = lds + sg * ST_BYTES; LAS const unsigned char* sb2 = sa + ST_BYTES;
            f32x16 a0, a1, b0, b1;
#define FP_CINIT(SB, P0, P1, OFS) do { if (MODE == 0) { _Pragma("unroll") for (int g = 0; g < 4; ++g) { const f32x4 c0_ = *(LAS const f32x4*)((SB) + ST_CK + 16 * h + 32 * g), c1_ = *(LAS const f32x4*)((SB) + ST_CK + 128 + 16 * h + 32 * g); \
                _Pragma("unroll") for (int i = 0; i < 4; ++i) { P0[4 * g + i] = c0_[i]; P1[4 * g + i] = c1_[i]; } } } else if (MODE == 1) { _Pragma("unroll") for (int i = 0; i < 16; ++i) { P0[i] = cini[i] + (OFS) * slope2; P1[i] = cini[i] + ((OFS) + 32.0f) * slope2; } } else { P0 = cini; P1 = cini; } } while (0)
#define FP_QK(SB, P0, P1) do { bf16x8 kf0_[NS], kf1_[NS]; _Pragma("unroll") for (int s = 0; s < NS; ++s) { kf0_[s] = *(LAS const bf16x8*)((SB) + ka[s]); kf1_[s] = *(LAS const bf16x8*)((SB) + ka[s] + 32 * KPITCH); } \
                _Pragma("unroll") for (int s = 0; s < NS; ++s) P0 = __builtin_amdgcn_mfma_f32_32x32x16_bf16(kf0_[s], qf[s], P0, 0, 0, 0); \
                _Pragma("unroll") for (int s = 0; s < NS; ++s) P1 = __builtin_amdgcn_mfma_f32_32x32x16_bf16(kf1_[s], qf[s], P1, 0, 0, 0); } while (0)
#define FP_HALF(PX, PF, T0) do { \
                _Pragma("unroll") for (int i = 0; i < 16; ++i) { PX[i] = __builtin_amdgcn_exp2f(MODE == 0 ? PX[i] - mref : PX[i]); ls += PX[i]; } \
                _Pragma("unroll") for (int t2 = 0; t2 < 2; ++t2) { v4u w_; w_.x = cvtpk(PX[8 * t2 + 0], PX[8 * t2 + 1]); w_.y = cvtpk(PX[8 * t2 + 2], PX[8 * t2 + 3]); w_.z = cvtpk(PX[8 * t2 + 4], PX[8 * t2 + 5]); w_.w = cvtpk(PX[8 * t2 + 6], PX[8 * t2 + 7]); \
                    PF[(T0) + t2] = __builtin_bit_cast(bf16x8, w_); } } while (0)
#define FP_PV(SB, PF, KS0) do { _Pragma("unroll") for (int d = 0; d < NDB; ++d) _Pragma("unroll") for (int k2 = 0; k2 < 2; ++k2) { \
                const s16x4 lo_ = vtr((SB) + va[d] + ((KS0) + k2) * 16 * VPITCH), hi_ = vtr((SB) + va[d] + ((KS0) + k2) * 16 * VPITCH + 8 * VPITCH); \
                const bf16x8 vf_ = (bf16x8){lo_[0], lo_[1], lo_[2], lo_[3], hi_[0], hi_[1], hi_[2], hi_[3]}; \
                o[d] = __builtin_amdgcn_mfma_f32_32x32x16_bf16(vf_, PF[(KS0) + k2], o[d], 0, 0, 0); } } while (0)
            float ls = 0.f; bf16x8 pfa[4], pfb[4];
            FP_CINIT(sa, a0, a1, 0.0f); FP_QK(sa, a0, a1);
            FP_CINIT(sb2, b0, b1, -64.0f); FP_QK(sb2, b0, b1);
            FP_HALF(a0, pfa, 0); FP_PV(sa, pfa, 0); FP_HALF(a1, pfa, 2); FP_PV(sa, pfa, 2);
            FP_HALF(b0, pfb, 0); FP_PV(sb2, pfb, 0); FP_HALF(b1, pfb, 2); FP_PV(sb2, pfb, 2);
#undef FP_CINIT
#undef FP_QK
#undef FP_HALF
#undef FP_PV
            l_run += ls;
            if (__any(ls > 1.0e30f)) {
                const float f = 7.888609052210118e-31f;
                l_run *= f; mref += 100.0f;
#pragma unroll
                for (int d = 0; d < NDB; ++d)
#pragma unroll
                    for (int i = 0; i < 16; ++i) o[d][i] *= f;
                if (MODE != 0) {
#pragma unroll
                    for (int i = 0; i < 16; ++i) cini[i] -= 100.0f;
                }
            }
            if (MODE != 2 && pub) { const float wmin = wave_red32<false>(mref + __builtin_amdgcn_logf(halfsum(l_run))); if (lane == 0) scf[((tp & 1) ? 32 : 0) + wave] = wmin; }
            if (MODE == 1) {
#pragma unroll
                for (int i = 0; i < 16; ++i) cini[i] -= 128.0f * slope2;
            }
            pair_done = true;
        }
      }
      if (!pair_done)
#pragma nounroll
      for (int u2 = 0; u2 < 2; ++u2) {
        const int t = 2 * tp + u2, j = NT - 1 - t;
        if (j <= jv) {
            LAS const unsigned char* sb = lds + (sg + u2) * ST_BYTES;
            f32x16 p0, p1;
            if (MODE == 0) {
#pragma unroll
                for (int g = 0; g < 4; ++g) { const f32x4 c0 = *(LAS const f32x4*)(sb + ST_CK + 16 * h + 32 * g), c1 = *(LAS const f32x4*)(sb + ST_CK + 128 + 16 * h + 32 * g);
#pragma unroll
                    for (int i = 0; i < 4; ++i) { p0[4 * g + i] = c0[i]; p1[4 * g + i] = c1[i]; } }
            } else {
                p0 = cini;
#pragma unroll
                for (int i = 0; i < 16; ++i) p1[i] = (MODE == 1) ? cini[i] + 32.0f * slope2 : cini[i];
            }
            bf16x8 kf0[NS], kf1[NS];
#pragma unroll
            for (int s = 0; s < NS; ++s) { kf0[s] = *(LAS const bf16x8*)(sb + ka[s]); kf1[s] = *(LAS const bf16x8*)(sb + ka[s] + 32 * KPITCH); }
            s16x4 vloA[NDB][2], vhiA[NDB][2], vloB[NDB][2], vhiB[NDB][2];
#define ATT_VREAD(LO, HI, KS0) do { _Pragma("unroll") for (int d = 0; d < NDB; ++d) _Pragma("unroll") for (int k2 = 0; k2 < 2; ++k2) { \
                LO[d][k2] = vtr(sb + va[d] + ((KS0) + k2) * 16 * VPITCH); HI[d][k2] = vtr(sb + va[d] + ((KS0) + k2) * 16 * VPITCH + 8 * VPITCH); } } while (0)
            if (NDB == 2) { ATT_VREAD(vloA, vhiA, 0); ATT_VREAD(vloB, vhiB, 2); }
            __builtin_amdgcn_sched_barrier(0);
#pragma unroll
            for (int s = 0; s < NS; ++s) p0 = __builtin_amdgcn_mfma_f32_32x32x16_bf16(kf0[s], qf[s], p0, 0, 0, 0);
#pragma unroll
            for (int s = 0; s < NS; ++s) p1 = __builtin_amdgcn_mfma_f32_32x32x16_bf16(kf1[s], qf[s], p1, 0, 0, 0);
            if (NDB == 4) { __builtin_amdgcn_sched_barrier(0); ATT_VREAD(vloA, vhiA, 0); __builtin_amdgcn_sched_barrier(0); }
            if (j == jv) {
                if (MODE == 0) {
                    const int qrel = (qrow + r) - 64 * j - 4 * h;
#pragma unroll
                    for (int i = 0; i < 16; ++i) { const int kr_ = (i & 3) + 8 * (i >> 2); if (kr_ > qrel) p0[i] = MASKV; if (kr_ + 32 > qrel) p1[i] = MASKV; }
                } else if (MODE == 1) {
#pragma unroll
                    for (int i = 0; i < 16; ++i) { p0[i] -= 2.0f * __builtin_fmaxf(cini[i], 0.f); p1[i] -= 2.0f * __builtin_fmaxf(cini[i] + 32.0f * slope2, 0.f); }
                }
                float a = max3f(p0[0], p0[1], p1[0]), bq = max3f(p0[2], p0[3], p1[1]); a = max3f(a, p1[2], p1[3]);
#pragma unroll
                for (int i = 4; i < 16; i += 4) { a = max3f(a, p0[i], p0[i + 1]); bq = max3f(bq, p0[i + 2], p0[i + 3]); a = max3f(a, p1[i], p1[i + 1]); bq = max3f(bq, p1[i + 2], p1[i + 3]); }
                mref = halfmax(__builtin_fmaxf(a, bq));
                if (MODE != 0) {
#pragma unroll
                    for (int i = 0; i < 16; ++i) { p0[i] -= mref; p1[i] -= mref; cini[i] -= mref; }
                }
            }
            bf16x8 pf[4]; float ls = 0.f;
#define ATT_HALF(PX, T0) do { \
                _Pragma("unroll") for (int i = 0; i < 16; ++i) { PX[i] = __builtin_amdgcn_exp2f(MODE == 0 ? PX[i] - mref : PX[i]); ls += PX[i]; } \
                _Pragma("unroll") for (int t2 = 0; t2 < 2; ++t2) { v4u w_; w_.x = cvtpk(PX[8 * t2 + 0], PX[8 * t2 + 1]); w_.y = cvtpk(PX[8 * t2 + 2], PX[8 * t2 + 3]); w_.z = cvtpk(PX[8 * t2 + 4], PX[8 * t2 + 5]); w_.w = cvtpk(PX[8 * t2 + 6], PX[8 * t2 + 7]); \
                    pf[(T0) + t2] = __builtin_bit_cast(bf16x8, w_); } } while (0)
#define ATT_PV(LO, HI, KS0) do { _Pragma("unroll") for (int d = 0; d < NDB; ++d) _Pragma("unroll") for (int k2 = 0; k2 < 2; ++k2) { \
                const bf16x8 vf_ = (bf16x8){LO[d][k2][0], LO[d][k2][1], LO[d][k2][2], LO[d][k2][3], HI[d][k2][0], HI[d][k2][1], HI[d][k2][2], HI[d][k2][3]}; \
                o[d] = __builtin_amdgcn_mfma_f32_32x32x16_bf16(vf_, pf[(KS0) + k2], o[d], 0, 0, 0); } } while (0)
            ATT_HALF(p0, 0);
            ATT_PV(vloA, vhiA, 0);
            if (NDB == 4) { __builtin_amdgcn_sched_barrier(0); ATT_VREAD(vloB, vhiB, 2); __builtin_amdgcn_sched_barrier(0); }
            ATT_HALF(p1, 2);
            ATT_PV(vloB, vhiB, 2);
#undef ATT_VREAD
#undef ATT_HALF
#undef ATT_PV
            l_run += ls;
            if (__any(ls > 1.0e30f)) {
                const float f = 7.888609052210118e-31f;
                l_run *= f; mref += 100.0f;
#pragma unroll
                for (int d = 0; d < NDB; ++d)
#pragma unroll
                    for (int i = 0; i < 16; ++i) o[d][i] *= f;
                if (MODE != 0) {
#pragma unroll
                    for (int i = 0; i < 16; ++i) cini[i] -= 100.0f;
                }
            }
            if (MODE != 2 && pub && u2 == 1) { const float wmin = wave_red32<false>(mref + __builtin_amdgcn_logf(halfsum(l_run))); if (lane == 0) scf[((tp & 1) ? 32 : 0) + wave] = wmin; }
        }
        if (MODE == 1) {
#pragma unroll
            for (int i = 0; i < 16; ++i) cini[i] -= 64.0f * slope2;
        }
      }
        ATT_WAIT_0();
        __syncthreads();
    }
#undef ATT_DMA
#undef ATT_WAIT_1
#undef ATT_WAIT_0
    asm volatile("s_waitcnt vmcnt(0)" ::: "memory");
    int nxt = 0; if (tid == 0) nxt = (int)atomicAdd(qctr, 1u);
    LAS int* word = (LAS int*)(lds + SC_OFF + 96);
    const float linv = 1.0f / halfsum(l_run);
    if (MODE != 1) {
        bf16* orow = Op + (rb + qrow + r) * DM + 8 * h;
#pragma unroll
        for (int d = 0; d < NDB; ++d)
#pragma unroll
            for (int p2 = 0; p2 < 2; ++p2) {
                const int g0 = 2 * p2, g1 = g0 + 1;
                const auto sx = __builtin_amdgcn_permlane32_swap(cvtpk(o[d][4 * g0] * linv, o[d][4 * g0 + 1] * linv), cvtpk(o[d][4 * g1] * linv, o[d][4 * g1 + 1] * linv), false, false);
                const auto sy = __builtin_amdgcn_permlane32_swap(cvtpk(o[d][4 * g0 + 2] * linv, o[d][4 * g0 + 3] * linv), cvtpk(o[d][4 * g1 + 2] * linv, o[d][4 * g1 + 3] * linv), false, false);
                v4u w; w.x = sx[0]; w.y = sy[0]; w.z = sx[1]; w.w = sy[1]; *(v4u*)(orow + 32 * d + 16 * p2) = w; }
        if (tid == 0) *word = nxt;
        __syncthreads();
    } else {
        LAS float* ex = (LAS float*)lds;
        const float* pp = (const float*)(P.ws + WS_SM + SM_PARAMS) + P.l * 384;
        float s1 = 0.f, s2 = 0.f;
        if (map == 0) { s1 = pp[lane] * pp[64 + lane]; s2 = pp[128 + lane] * pp[192 + lane]; }
        asm volatile("s_waitcnt vmcnt(0)" ::: "memory"); __syncthreads();
        if (map == 1) {
#pragma unroll
            for (int d = 0; d < NDB; ++d)
#pragma unroll
                for (int i = 0; i < 16; ++i) ex[((wq * 4 + d) * 16 + i) * 64 + lane] = o[d][i] * linv;
        }
        __syncthreads();
        if (map == 0) {
            s1 = wave_sum(s1); s2 = wave_sum(s2);
            const float lam = __expf(s1) - __expf(s2) + P.lam_init;
            float ss = 0.f;
#pragma unroll
            for (int d = 0; d < NDB; ++d)
#pragma unroll
                for (int i = 0; i < 16; ++i) { o[d][i] = o[d][i] * linv - lam * ex[((wq * 4 + d) * 16 + i) * 64 + lane]; ss += o[d][i] * o[d][i]; }
            ss = halfsum(ss);
            const float rn = __builtin_amdgcn_rsqf(ss * (1.0f / 128.0f) + EPS) * (1.0f - P.lam_init);
            bf16* orow = Op + (rb + qrow + r) * DM + 8 * h;
#pragma unroll
            for (int d = 0; d < NDB; ++d)
#pragma unroll
                for (int p2 = 0; p2 < 2; ++p2) { const int g0 = 2 * p2, g1 = g0 + 1;
                    const f32x4 ga = *(const f32x4*)(pp + 256 + 32 * d + 8 * g0 + 4 * h), gb = *(const f32x4*)(pp + 256 + 32 * d + 8 * g1 + 4 * h);
                    const auto sx = __builtin_amdgcn_permlane32_swap(cvtpk(o[d][4 * g0] * rn * ga[0], o[d][4 * g0 + 1] * rn * ga[1]), cvtpk(o[d][4 * g1] * rn * gb[0], o[d][4 * g1 + 1] * rn * gb[1]), false, false);
                    const auto sy = __builtin_amdgcn_permlane32_swap(cvtpk(o[d][4 * g0 + 2] * rn * ga[2], o[d][4 * g0 + 3] * rn * ga[3]), cvtpk(o[d][4 * g1 + 2] * rn * gb[2], o[d][4 * g1 + 3] * rn * gb[3]), false, false);
                    v4u w; w.x = sx[0]; w.y = sy[0]; w.z = sx[1]; w.w = sy[1]; *(v4u*)(orow + 32 * d + 16 * p2) = w; }
        }
        if (tid == 0) *word = nxt;
        __syncthreads();
    }
}

template <int PRB = 0>
__device__ __forceinline__ void attn_phase(const Params& P, LAS unsigned char* lds, const int* list, const int ctr_off = 0, const int cv_lo = 0, const int cv_hi = 0) {
    LAS int* word = (LAS int*)(lds + SC_OFF + 96); LAS int* ll = (LAS int*)(lds + SC_OFF + 2048);
    unsigned* qctr = (unsigned*)(P.ws + WS_CTL) + 64 + 64 * P.l + ctr_off;
    { int t_ = threadIdx.x; asm volatile("" : "+v"(t_)); ll[t_] = list[t_]; ll[t_ + 512] = list[t_ + 512]; if (t_ == 0) *word = (int)atomicAdd(qctr, 1u); }
    asm volatile("s_waitcnt vmcnt(0)" ::: "memory"); __syncthreads();
    for (;;) {
        const int idx = __builtin_amdgcn_readfirstlane(*word);
        if (idx >= N_ITEMS) {
            const int c0 = cv_lo + (idx - N_ITEMS) * 16;
            if (c0 >= cv_hi) break;
            int t_ = threadIdx.x; asm volatile("" : "+v"(t_)); const int wv_ = __builtin_amdgcn_readfirstlane(t_ >> 6);
            int nxt = 0; if (t_ == 0) nxt = (int)atomicAdd(qctr, 1u);
            wprep_range((const __attribute__((address_space(4))) Args*)__builtin_amdgcn_kernarg_segment_ptr(), lds, c0, c0 + 16 < cv_hi ? c0 + 16 : cv_hi, wv_, NWAVES, t_ & 63, wv_);
            __syncthreads();
            if (t_ == 0) *word = nxt;
            __syncthreads();
            continue;
        }
        const int code = __builtin_amdgcn_readfirstlane(ll[idx]), type = code & 3, rem = code >> 2;
        if (type == 0) attn_unit<0, PRB>(P, lds, (rem / 32) >> 2, (rem / 32) & 3, rem % 32, qctr);
        else if (type == 1) attn_unit<1, PRB>(P, lds, (rem / 64) >> 2, (rem / 64) & 3, rem % 64, qctr);
        else attn_unit<2, PRB>(P, lds, (rem / 32) >> 2, (rem / 32) & 3, rem % 32, qctr);
    }
}
}
#define XB_TMO      128
#define XB_XCNT(j)  (256  + 64 * (j))
#define XB_XSUB(j)  (1280 + 64 * (j))
#define XB_XGEN(j)  (2304 + 64 * (j))
#define XB_TOP      3328
#define XB_TOPGEN   3392
#define XCD_BAR_WORDS 3456
#define XB_SPIN_CAP (1u << 18)

__device__ __forceinline__ unsigned xb_ld(unsigned* p)              { return __hip_atomic_load(p, __ATOMIC_RELAXED, __HIP_MEMORY_SCOPE_AGENT); }
__device__ __forceinline__ unsigned xb_add(unsigned* p, unsigned v) { return __hip_atomic_fetch_add(p, v, __ATOMIC_RELAXED, __HIP_MEMORY_SCOPE_AGENT); }
__device__ __forceinline__ unsigned xb_xcc_id() { return (unsigned)__builtin_amdgcn_s_getreg((3 << 11) | 20) & 0xFu; }
#define XB_SPIN(cond, bar) do { unsigned _sp = 0; while (cond) { __builtin_amdgcn_s_sleep(1); \
    if ((++_sp & 255u) == 0u) { if (xb_ld(&(bar)[XB_TMO])) break; if (_sp > XB_SPIN_CAP) { atomicAdd(&(bar)[XB_TMO], 1u); break; } } } } while (0)

struct XcdBarrier {
    unsigned* bar; unsigned x;
    volatile LAS unsigned* st;
};

__device__ __forceinline__ XcdBarrier xcd_barrier_post(unsigned* bar, volatile LAS unsigned* st) {
    XcdBarrier b; b.bar = bar; b.x = xb_xcc_id(); b.st = st;
    if (threadIdx.x == 0) (void)xb_add(&bar[XB_XCNT(b.x)], 1u);
    return b;
}
__device__ __forceinline__ void xcd_barrier_complete(unsigned* bar, unsigned x, unsigned& nloc, unsigned& nx) {
    const unsigned G = gridDim.x * gridDim.y * gridDim.z;
    unsigned sum, cnt, mine, sp = 0u;
    for (;;) {
        sum = 0u; cnt = 0u; mine = 0u;
#pragma unroll
        for (unsigned j = 0; j < 16; ++j) { const unsigned c = xb_ld(&bar[XB_XCNT(j)]); sum += c; cnt += (c > 0u) ? 1u : 0u; mine = (j == x) ? c : mine; }
        if (sum == G) break;
        __builtin_amdgcn_s_sleep(1);
        if ((++sp & 255u) == 0u) { if (xb_ld(&bar[XB_TMO])) break; if (sp > XB_SPIN_CAP) { atomicAdd(&bar[XB_TMO], 1u); break; } }
    }
    nloc = mine > 0u ? mine : 1u; nx = cnt > 0u ? cnt : 1u;
}

__device__ __forceinline__ void xcd_barrier(const XcdBarrier& b) {
    asm volatile("s_waitcnt vmcnt(0)" ::: "memory");
    __syncthreads();
    if (threadIdx.x == 0) {
        unsigned* bar = b.bar;
        __builtin_amdgcn_s_waitcnt(0);
        unsigned nloc = b.st[0], nx = b.st[1];
        if (nloc == 0u) { xcd_barrier_complete(bar, b.x, nloc, nx); b.st[0] = nloc; b.st[1] = nx; }
        const unsigned old = xb_add(&bar[XB_XSUB(b.x)], 1u);
        const unsigned gen = old / nloc;
        if (old + 1u == (gen + 1u) * nloc) {
            __builtin_amdgcn_fence(__ATOMIC_RELEASE, "agent");
            asm volatile("s_waitcnt vmcnt(0)" ::: "memory");
            const unsigned og = xb_add(&bar[XB_TOP], 1u);
            const unsigned tg = og / nx;
            if (og + 1u == (tg + 1u) * nx) xb_add(&bar[XB_TOPGEN], 1u);
            else XB_SPIN(xb_ld(&bar[XB_TOPGEN]) == tg, bar);
            __builtin_amdgcn_fence(__ATOMIC_ACQUIRE, "agent");
            xb_add(&bar[XB_XGEN(b.x)], 1u);
            asm volatile("s_waitcnt vmcnt(0)" ::: "memory");
        } else {
            XB_SPIN(xb_ld(&bar[XB_XGEN(b.x)]) == gen, bar);
            __builtin_amdgcn_fence(__ATOMIC_ACQUIRE, "agent");
            asm volatile("s_waitcnt vmcnt(0)" ::: "memory");
        }
    }
    __syncthreads();
}

constexpr int CW_BAR = 4096;
constexpr int MISC_OFF = LDS_BYTES - 512;
constexpr size_t WS_ITEMS = 235 * MiB;
constexpr size_t WS_END2 = 236 * MiB;
constexpr int PH_H = 0, PH_M = 1, PH_A = 2, PH_O = 3, PH_U = 4, PH_D = 5, PH_FINAL = 13, NPHASES = 14;

static __device__ const float ROPE_INV[16] = {1.0f, 0.5623413324356079f, 0.3162277638912201f, 0.17782793939113617f, 0.10000000149011612f, 0.05623413249850273f, 0.03162277489900589f, 0.017782794311642647f,
    0.009999999776482582f, 0.005623413249850273f, 0.003162277629598975f, 0.0017782794311642647f, 0.0010000000474974513f, 0.000562341301701963f, 0.0003162277571391314f, 0.00017782794020604342f};
__device__ __forceinline__ void rope_cs(int t, int j, float& c, float& s) {
    const float ang = (float)t * ROPE_INV[j];
    c = (float)cos((double)ang); s = (float)sin((double)ang);
}
__device__ __forceinline__ void rope_table(float2* tab, int gtid, int ngt) {
    for (int i = gtid; i < SEQ * 16; i += ngt) { float c, s; rope_cs(i >> 4, i & 15, c, s); tab[i] = make_float2(c, s); }
}
__device__ __forceinline__ void cum_scan(const float* logf, float* cum, int b, int h, LAS double* part, int tid) {
    double loc[16]; double s = 0.0;
#pragma unroll
    for (int i = 0; i < 16; ++i) { s += (double)logf[(size_t)(b * SEQ + tid * 16 + i) * 4 + h]; loc[i] = s; }
    const int lane = tid & 63, wave = tid >> 6;
    double sc = s;
#pragma unroll
    for (int o = 1; o < 64; o <<= 1) { const double t = __shfl_up(sc, o); if (lane >= o) sc += t; }
    if (lane == 63) part[wave] = sc;
    __syncthreads();
    double pre = sc - s;
    for (int w = 0; w < wave; ++w) pre += part[w];
#pragma unroll
    for (int i = 0; i < 16; ++i) cum[(size_t)(b * SEQ + tid * 16 + i) * 4 + h] = (float)((pre + loc[i]) * -1.4426950408889634);
    __syncthreads();
}

#define CAS __attribute__((address_space(4)))
__global__ void __launch_bounds__(NTHREADS, 2) fwd(Args args) {
    extern __shared__ __attribute__((aligned(16))) unsigned char lds_raw[];
    LAS unsigned char* lds = (LAS unsigned char*)lds_raw;
    { volatile LAS unsigned* misc = (volatile LAS unsigned*)(lds + MISC_OFF); if (threadIdx.x < 32) misc[threadIdx.x] = 0u; __syncthreads(); }
    XcdBarrier bar; { CAS const Args* apb = (CAS const Args*)__builtin_amdgcn_kernarg_segment_ptr(); bar = xcd_barrier_post((unsigned*)(apb->ws + WS_CTL) + CW_BAR, (volatile LAS unsigned*)(lds + MISC_OFF) + 8); }
    int lo, hi; { CAS const Args* ap0 = (CAS const Args*)__builtin_amdgcn_kernarg_segment_ptr(); lo = ap0->ph_lo; hi = ap0->ph_hi; }
#define IN(k) (lo <= (k) && (k) < hi)
#ifdef PROBE_STAMP
#define STAMP(k) do { if (blockIdx.x == 0 && threadIdx.x == 0) { CAS const Args* aps = (CAS const Args*)__builtin_amdgcn_kernarg_segment_ptr(); ((unsigned long long*)(aps->ws + WS_CTL + 512 * 1024))[k] = __builtin_amdgcn_s_memrealtime(); } } while (0)
#else
#define STAMP(k) do {} while (0)
#endif
#ifdef PROBE_SLEEP
#ifndef PROBE_MUL
#define PROBE_MUL 1
#endif
#define PSLEEP(k) do { if (threadIdx.x == 0) { volatile LAS unsigned long long* ts_ = (volatile LAS unsigned long long*)(lds + MISC_OFF + 256); unsigned long long t1_ = __builtin_amdgcn_s_memrealtime(); \
        if ((k) == PROBE_SLEEP) { const unsigned long long t0_ = *ts_; while (__builtin_amdgcn_s_memrealtime() < t1_ + PROBE_MUL * (t1_ - t0_)) __builtin_amdgcn_s_sleep(8); t1_ = __builtin_amdgcn_s_memrealtime(); } *ts_ = t1_; } \
        if ((k) == PROBE_SLEEP) __syncthreads(); } while (0)
#else
#define PSLEEP(k) do {} while (0)
#endif
#define SEAM(k) do { if (IN(k) && IN((k) + 1)) xcd_barrier(bar); PSLEEP(k); STAMP((k) + 1); } while (0)
#define FRAME() \
    int tid = threadIdx.x; asm volatile("" : "+v"(tid)); \
    CAS const Args* ap = (CAS const Args*)__builtin_amdgcn_kernarg_segment_ptr(); asm volatile("" : "+s"(ap)); unsigned char* ws = ap->ws; \
    const int lane = tid & 63, wave = __builtin_amdgcn_readfirstlane(tid >> 6); \
    int G_ = gridDim.x, bx_ = blockIdx.x; asm volatile("" : "+s"(G_), "+s"(bx_)); const int G = __builtin_amdgcn_readfirstlane(G_), bx = __builtin_amdgcn_readfirstlane(bx_); \
    const int vcu = (G % 8 == 0) ? (bx % 8) * (G / 8) + bx / 8 : bx; \
    const int gw = vcu * NWAVES + wave, ngw = G * NWAVES; \
    float* sm = (float*)(ws + WS_SM); (void)lane; (void)gw; (void)ngw; (void)sm;
    STAMP(0);
#ifdef PROBE_SLEEP
    if (threadIdx.x == 0) *(volatile LAS unsigned long long*)(lds + MISC_OFF + 256) = __builtin_amdgcn_s_memrealtime();
#endif
    if (IN(0)) { FRAME(); p0_prologue(ap, lds, gw, ngw, lane, wave, G == 256); rope_table((float2*)(ws + WS_ROPE), gw * 64 + lane, ngw * 64); att::build_items((int*)(ws + WS_ITEMS), (LAS int*)lds, bx, tid, G); }
    SEAM(0);
    for (int l = 0; l < DEPTH; ++l) {
        const int pb = 1 + 6 * l;
        if (IN(pb + PH_H)) {
            FRAME();
            unsigned char* wl = ws + WS_W + (size_t)l * WS_WL;
            { pg8::Gemm g{(const bf16*)(ws + WS_XB), (const bf16*)(wl + W_IN), MTOK, HN, DM, DM}; pg8::HOrder S; S.init_h(G, bx);
              pg8::EpiH E{ws, ap->in[I_FB] + l * 4, l};
              pg8::gemm_phase<pg8::EpiH, pg8::HOrder, true, true>(lds, g, S, E); }
        }
        if (IN(pb + PH_H)) {
            const int c0 = 704 % 256;
            { FRAME(); unsigned char* wl = ws + WS_W + (size_t)l * WS_WL; const unsigned* ready = (const unsigned*)(ws + WS_CTL) + CW_READY + l * 64 * 64;
              pg8::Gemm g{(const bf16*)(ws + WS_HB) + H_CKV, (const bf16*)(wl + W_UKV), MTOK, 512, 128, HN}; pg8::MOrder S; if (G == 256) S.init(G, bx, 192, 64, ready, 16u); else S.init(G, bx, 0, 128, ready, 16u);
              pg8::EpiKV E{(bf16*)(ws + WS_KVM), sm + SM_SSKV / 4 + l * MTOK}; pg8::gemm_phase<pg8::EpiKV, pg8::MOrder, true, true>(lds, g, S, E); }
            { FRAME();
              if (bx >= c0 && bx < c0 + 8) { const int sb = (bx - c0) >> 2, sh = (bx - c0) & 3; const unsigned* ready = (const unsigned*)(ws + WS_CTL) + CW_READY + l * 64 * 64;
                if (tid < 64) { unsigned polls = 0; const unsigned* w_ = ready + 64 * (32 * sb + (tid & 31));
                    while (!__all((int)(__hip_atomic_load(w_, __ATOMIC_RELAXED, __HIP_MEMORY_SCOPE_AGENT) >= 16u)) && ++polls < (1u << 22)) __builtin_amdgcn_s_sleep(2);
                    __builtin_amdgcn_fence(__ATOMIC_ACQUIRE, "agent"); asm volatile("s_waitcnt vmcnt(0)" ::: "memory"); }
                __syncthreads();
                cum_scan(sm + SM_LOGF / 4, sm + SM_CUM / 4, sb, sh, (LAS double*)lds, tid); } }
        }
        SEAM(pb + PH_H);
        if (IN(pb + PH_A)) {
            FRAME();
            const float lam_init = l == 0 ? 0.2f : 0.35550906759096934f;
            att::Params P{ws, l, lam_init};
            att::attn_phase(P, lds, (const int*)(ws + WS_ITEMS), 0, G == 256 ? (l == 0 ? WI_P0 : WI_B + WI_O) : 0, G == 256 ? (l == 0 ? WI_L - WI_DN : WI_C) : 0);
#ifdef PROBE_PHASE
            if (l == 0) { xcd_barrier(bar); att::attn_phase<1>(P, lds, (const int*)(ws + WS_ITEMS), 32); }
#endif
        }
        SEAM(pb + PH_A);
        if (IN(pb + PH_O)) {
            FRAME(); unsigned char* wl = ws + WS_W + (size_t)l * WS_WL;
            pg8::Gemm g{(const bf16*)(ws + WS_AO), (const bf16*)(wl + W_O), MTOK, DM, DM, DM}; pg8::StaticOrder S; S.init(MTOK, DM, G, bx);
            pg8::EpiRes E{(const bf16*)(ws + WS_XB), (bf16*)(ws + WS_XB), sm + SM_SS2 / 4 + l * MTOK};
            pg8::gemm_phase<pg8::EpiRes, pg8::StaticOrder, true, true>(lds, g, S, E);
        }
        SEAM(pb + PH_O);
        if (IN(pb + PH_U)) {
            FRAME(); unsigned char* wl = ws + WS_W + (size_t)l * WS_WL;
            pg8::Gemm g{(const bf16*)(ws + WS_XB), (const bf16*)(wl + W_UP), MTOK, NUP, DM, DM}; pg8::UpOrder S; S.init_up(G, bx);
            pg8::EpiUp E{ws, ap->in[I_CW] + (size_t)l * 3 * NUP, ap->in[I_CB] + (size_t)l * NUP, l};
            pg8::gemm_phase<pg8::EpiUp, pg8::UpOrder, true, true>(lds, g, S, E);
            if (G == 256) { const int cu = (pg8::UP_NM * pg8::UP_NN) % 256;
                if (bx >= cu) { __syncthreads(); wprep_range(ap, lds, l == 0 ? WI_L - WI_DN : WI_C, l == 0 ? WI_B + WI_O : 2 * WI_L, (bx - cu) * NWAVES + wave, (G - cu) * NWAVES, lane, wave); } }
        }
        SEAM(pb + PH_U);
        if (IN(pb + PH_D)) {
            FRAME(); unsigned char* wl = ws + WS_W + (size_t)l * WS_WL;
            pg8::Gemm g{(const bf16*)(ws + WS_HB), (const bf16*)(wl + W_DN), MTOK, DM, DFF, DFF}; pg8::StaticOrder S; S.init(MTOK, DM, G, bx);
            if (l == DEPTH - 1 && G == 256) {
                pg8::EpiResFinal E{(const bf16*)(ws + WS_XB), ap->out, sm + SM_SS1N / 4 + l * MTOK, ap->in[I_FG], (unsigned*)(ws + WS_CTL) + 1024};
                pg8::gemm_phase<pg8::EpiResFinal, pg8::StaticOrder, false, true>(lds, g, S, E);
            } else {
                pg8::EpiRes E{(const bf16*)(ws + WS_XB), (bf16*)(ws + WS_XB), sm + SM_SS1N / 4 + l * MTOK};
                pg8::gemm_phase<pg8::EpiRes, pg8::StaticOrder, true, true>(lds, g, S, E);
            }
        }
        if (!(l == DEPTH - 1 && gridDim.x == 256)) SEAM(pb + PH_D); else PSLEEP(pb + PH_D);
    }
    if (IN(PH_FINAL) && gridDim.x != 256) {
        FRAME();
        const float* ss = sm + SM_SS1N / 4 + (DEPTH - 1) * MTOK; const float4* gr = (const float4*)ap->in[I_FG] + 4 * lane;
        for (int row = gw; row < MTOK; row += ngw) {
            const float r0 = __builtin_amdgcn_rsqf(ss[row] * (1.0f / DM) + EPS);
            const v4u* xr = (const v4u*)((const bf16*)(ws + WS_XB) + (size_t)row * DM) + 2 * lane; float4* o = (float4*)(ap->out + (size_t)row * DM) + 4 * lane;
            const v4u a = xr[0], b = xr[1];
            const float4 g0 = gr[0], g1 = gr[1], g2 = gr[2], g3 = gr[3];
            o[0] = make_float4(bflo(a.x) * r0 * g0.x, bfhi(a.x) * r0 * g0.y, bflo(a.y) * r0 * g0.z, bfhi(a.y) * r0 * g0.w);
            o[1] = make_float4(bflo(a.z) * r0 * g1.x, bfhi(a.z) * r0 * g1.y, bflo(a.w) * r0 * g1.z, bfhi(a.w) * r0 * g1.w);
            o[2] = make_float4(bflo(b.x) * r0 * g2.x, bfhi(b.x) * r0 * g2.y, bflo(b.y) * r0 * g2.z, bfhi(b.y) * r0 * g2.w);
            o[3] = make_float4(bflo(b.z) * r0 * g3.x, bfhi(b.z) * r0 * g3.y, bflo(b.w) * r0 * g3.z, bfhi(b.w) * r0 * g3.w);
        }
    }
#ifdef PROBE_STAMP
    if (IN(PH_FINAL)) { xcd_barrier(bar); STAMP(PH_FINAL + 1);
        FRAME(); if (bx == 0) { __syncthreads(); const unsigned long long* st = (const unsigned long long*)(ws + WS_CTL + 512 * 1024);
            const float da = (float)(st[PROBE_A + 1] - st[PROBE_A]) * 0.01f, db = (float)(st[PROBE_B + 1] - st[PROBE_B]) * 0.01f;
            if (tid == 0) ap->out[0] = da;
            for (int i = tid; i < 16384; i += NTHREADS) ap->out[1024 + i] = db; } }
#endif
#undef IN
#undef SEAM
#undef FRAME
}

#ifndef N_LAUNCHES
#define N_LAUNCHES 1
#endif
extern "C" void kernel_launch(void* const* d_in, const int* in_sizes, int n_in, void* d_out, int out_size, void* d_ws, size_t ws_size, hipStream_t stream) {
    static int grid = 0;
    if (!grid) {
        if (n_in != 20 || ws_size < WS_END2 || out_size != MTOK * DM) { fprintf(stderr, "kernel_launch: unexpected n_in %d / out_size %d / ws_size %zu\n", n_in, out_size, ws_size); grid = -1; return; }
        if (hipFuncSetAttribute((const void*)fwd, hipFuncAttributeMaxDynamicSharedMemorySize, LDS_BYTES) != hipSuccess) { fprintf(stderr, "hipFuncSetAttribute failed\n"); grid = -1; return; }
        int dev = 0, cus = 0, per_cu = 0;
        if (hipGetDevice(&dev) != hipSuccess || hipDeviceGetAttribute(&cus, hipDeviceAttributeMultiprocessorCount, dev) != hipSuccess) { grid = -1; return; }
        if (hipOccupancyMaxActiveBlocksPerMultiprocessor(&per_cu, (const void*)fwd, NTHREADS, LDS_BYTES) != hipSuccess || per_cu < 1) { fprintf(stderr, "occupancy query failed (%d)\n", per_cu); grid = -1; return; }
        grid = cus;
        if (grid != 256) fprintf(stderr, "kernel_launch: note: %d CUs\n", grid);
    }
    if (grid < 0) return;
    Args a{};
    for (int i = 0; i < 20; ++i) a.in[i] = (const float*)d_in[i];
    a.out = (float*)d_out; a.ws = (unsigned char*)d_ws;
    (void)hipMemsetAsync((unsigned char*)d_ws + WS_CTL, 0, 1 * MiB, stream);
    if (N_LAUNCHES == 1) {
        a.ph_lo = 0; a.ph_hi = NPHASES;
        hipLaunchKernelGGL(fwd, dim3(grid), dim3(NTHREADS), LDS_BYTES, stream, a);
#ifdef PROBE_UNIT
        { static int once = 0; if (!once) { (void)hipFuncSetAttribute((const void*)probe_k, hipFuncAttributeMaxDynamicSharedMemorySize, LDS_BYTES); once = 1; }
          hipLaunchKernelGGL(probe_k, dim3(8), dim3(NTHREADS), LDS_BYTES, stream, a); }
#endif
    } else {
        for (int p = 0; p < NPHASES; ++p) { a.ph_lo = p; a.ph_hi = p + 1; hipLaunchKernelGGL(fwd, dim3(grid), dim3(NTHREADS), LDS_BYTES, stream, a);
#ifdef DUP_P0
            if (p == 0 || p == PH_FINAL) { if (p == 0) hipLaunchKernelGGL(fwd, dim3(grid), dim3(NTHREADS), LDS_BYTES, stream, a); }
#endif
#ifdef DUP_PHASE
            if (p >= 1 && p < PH_FINAL && (p - 1) % 6 == DUP_PHASE) hipLaunchKernelGGL(fwd, dim3(grid), dim3(NTHREADS), LDS_BYTES, stream, a);
#endif
        }
    }
}
```
